# Optimizing an MI355X kernel written in HIP

```python
import math
import jax, jax.numpy as jnp
from jax import lax
import numpy as np

D_MODEL = 1024
BATCH = 8
SEQ = 8192
DEPTH = 2

N_MIXERS = 2
D_FF = 2816
FFN_RES = 0.5
POOL_WINDOWS = (2, 4, 8, 16)
POOL_GROUPS = len(POOL_WINDOWS)
POOL_GW = D_MODEL // POOL_GROUPS
N_HEADS = 8
HEAD_DIM = D_MODEL // (2 * N_HEADS)
V_DIM = 2 * HEAD_DIM
QK_W = N_HEADS * HEAD_DIM
QKV_W = 4 * QK_W + N_HEADS * V_DIM
ATTN_SCALE = HEAD_DIM ** -0.5
Q_BLOCK = 128
LN_EPS = 1e-5
RMS_EPS = 1e-5
DEEPNORM_ALPHA = (2.0 * DEPTH) ** 0.25
DEEPNORM_BETA = (8.0 * DEPTH) ** -0.25

kernel_name = "hybrid_pool_diffattn_macaron_deepnorm"


def layer_norm(x, g, b):
    xf = x.astype(jnp.float32)
    mu = jnp.mean(xf, axis=-1, keepdims=True)
    var = jnp.mean(jnp.square(xf - mu), axis=-1, keepdims=True)
    y = (xf - mu) * lax.rsqrt(var + LN_EPS) * g.astype(jnp.float32) + b.astype(jnp.float32)
    return y.astype(x.dtype)


def deepnorm(x, y, g, b):
    return layer_norm(DEEPNORM_ALPHA * x + y, g, b)


def swiglu(x, w_in, w_out):
    gate, up = jnp.split(x @ w_in, 2, axis=-1)
    return (jax.nn.silu(gate) * up) @ w_out


def pool_mixer(x, w_pool, scale):
    B, S, D = x.shape
    xf = x.astype(jnp.float32)
    c = jnp.cumsum(xf, axis=1)
    pos = jnp.arange(S)
    outs = []
    for g, w in enumerate(POOL_WINDOWS):
        sl = slice(g * POOL_GW, (g + 1) * POOL_GW)
        cg = c[..., sl]
        shifted = jnp.pad(cg[:, :S - w], ((0, 0), (w, 0), (0, 0)))
        count = jnp.minimum(pos + 1, w).astype(jnp.float32)[None, :, None]
        d = ((cg - shifted) / count - xf[..., sl]).astype(x.dtype)
        outs.append(d @ w_pool[g])
    return jnp.concatenate(outs, axis=-1) * scale


def diff_attention(x, w_qkv, lam_q1, lam_k1, lam_q2, lam_k2, subln_g, w_o, lambda_init):
    B, S, _ = x.shape
    qkv = x @ w_qkv
    q1, q2, k1, k2, v = jnp.split(qkv, [QK_W, 2 * QK_W, 3 * QK_W, 4 * QK_W], axis=-1)

    def heads(t, d):
        return t.reshape(B, S, N_HEADS, d).transpose(0, 2, 1, 3)

    q1, q2, k1, k2 = (heads(t, HEAD_DIM) for t in (q1, q2, k1, k2))
    vf = heads(v, V_DIM).astype(jnp.float32)

    lam = (jnp.exp(jnp.sum(lam_q1.astype(jnp.float32) * lam_k1.astype(jnp.float32)))
           - jnp.exp(jnp.sum(lam_q2.astype(jnp.float32) * lam_k2.astype(jnp.float32)))
           + lambda_init)

    slopes = jnp.exp2(-8.0 * jnp.arange(1, N_HEADS + 1, dtype=jnp.float32) / N_HEADS)
    n_blocks = S // Q_BLOCK
    k_pos = jnp.arange(S)

    def to_blocks(t):
        return t.reshape(B, N_HEADS, n_blocks, Q_BLOCK, HEAD_DIM).transpose(2, 0, 1, 3, 4)

    def one_block(args):
        q1b, q2b, blk = args
        q_pos = blk * Q_BLOCK + jnp.arange(Q_BLOCK)
        dist = (q_pos[:, None] - k_pos[None, :]).astype(jnp.float32)
        causal = dist >= 0
        bias = -slopes[:, None, None] * dist

        def probs(qb, k):
            s = jnp.einsum('bhqd,bhkd->bhqk', qb, k).astype(jnp.float32) * ATTN_SCALE + bias
            return jax.nn.softmax(jnp.where(causal, s, -jnp.inf), axis=-1)

        a = probs(q1b, k1) - lam * probs(q2b, k2)
        return jnp.einsum('bhqk,bhke->bhqe', a, vf)

    o = lax.map(one_block, (to_blocks(q1), to_blocks(q2), jnp.arange(n_blocks)))
    o = o.transpose(1, 0, 3, 2, 4).reshape(B, S, N_HEADS, V_DIM)
    o = o * lax.rsqrt(jnp.mean(jnp.square(o), axis=-1, keepdims=True) + RMS_EPS)
    o = o * subln_g.astype(jnp.float32) * (1.0 - lambda_init)
    return o.reshape(B, S, N_HEADS * V_DIM).astype(x.dtype) @ w_o


def setup_inputs(seed: int = 0) -> dict:
    key = jax.random.key(seed)
    ks = iter(jax.random.split(key, 64))
    f32 = jnp.float32

    def nrm(shape, scale):
        return jax.random.normal(next(ks), shape, f32) * scale

    def gain(n):
        return 1.0 + 0.02 * jax.random.normal(next(ks), (n,), f32)

    def bias(n):
        return 0.02 * jax.random.normal(next(ks), (n,), f32)

    def ffn():
        return (nrm((D_MODEL, 2 * D_FF), D_MODEL ** -0.5),
                nrm((D_FF, D_MODEL), D_FF ** -0.5 * DEEPNORM_BETA))

    inp = {"x": jax.random.normal(next(ks), (BATCH, SEQ, D_MODEL), f32)}
    inp["l0_ffn1_w_in"], inp["l0_ffn1_w_out"] = ffn()
    inp["l0_ln1_g"], inp["l0_ln1_b"] = gain(D_MODEL), bias(D_MODEL)
    inp["l0_pool_w"] = nrm((POOL_GROUPS, POOL_GW, POOL_GW), POOL_GW ** -0.5 * DEEPNORM_BETA)
    inp["l0_pool_scale"] = gain(D_MODEL)
    inp["l0_ln2_g"], inp["l0_ln2_b"] = gain(D_MODEL), bias(D_MODEL)
    inp["l0_ffn2_w_in"], inp["l0_ffn2_w_out"] = ffn()
    inp["l0_ln3_g"], inp["l0_ln3_b"] = gain(D_MODEL), bias(D_MODEL)
    inp["l1_ffn1_w_in"], inp["l1_ffn1_w_out"] = ffn()
    inp["l1_ln1_g"], inp["l1_ln1_b"] = gain(D_MODEL), bias(D_MODEL)
    inp["l1_w_qkv"] = nrm((D_MODEL, QKV_W), D_MODEL ** -0.5)
    inp["l1_lam_q1"] = nrm((HEAD_DIM,), 0.1)
    inp["l1_lam_k1"] = nrm((HEAD_DIM,), 0.1)
    inp["l1_lam_q2"] = nrm((HEAD_DIM,), 0.1)
    inp["l1_lam_k2"] = nrm((HEAD_DIM,), 0.1)
    inp["l1_subln_g"] = gain(V_DIM)
    inp["l1_w_o"] = nrm((N_HEADS * V_DIM, D_MODEL), (N_HEADS * V_DIM) ** -0.5 * DEEPNORM_BETA)
    inp["l1_ln2_g"], inp["l1_ln2_b"] = gain(D_MODEL), bias(D_MODEL)
    inp["l1_ffn2_w_in"], inp["l1_ffn2_w_out"] = ffn()
    inp["l1_ln3_g"], inp["l1_ln3_b"] = gain(D_MODEL), bias(D_MODEL)
    return inp


def reference(x,
              l0_ffn1_w_in, l0_ffn1_w_out, l0_ln1_g, l0_ln1_b,
              l0_pool_w, l0_pool_scale, l0_ln2_g, l0_ln2_b,
              l0_ffn2_w_in, l0_ffn2_w_out, l0_ln3_g, l0_ln3_b,
              l1_ffn1_w_in, l1_ffn1_w_out, l1_ln1_g, l1_ln1_b,
              l1_w_qkv, l1_lam_q1, l1_lam_k1, l1_lam_q2, l1_lam_k2, l1_subln_g, l1_w_o,
              l1_ln2_g, l1_ln2_b,
              l1_ffn2_w_in, l1_ffn2_w_out, l1_ln3_g, l1_ln3_b):
    layers = [
        dict(ffn1=(l0_ffn1_w_in, l0_ffn1_w_out), ln1=(l0_ln1_g, l0_ln1_b),
             mix=(l0_pool_w, l0_pool_scale), ln2=(l0_ln2_g, l0_ln2_b),
             ffn2=(l0_ffn2_w_in, l0_ffn2_w_out), ln3=(l0_ln3_g, l0_ln3_b)),
        dict(ffn1=(l1_ffn1_w_in, l1_ffn1_w_out), ln1=(l1_ln1_g, l1_ln1_b),
             mix=(l1_w_qkv, l1_lam_q1, l1_lam_k1, l1_lam_q2, l1_lam_k2, l1_subln_g, l1_w_o),
             ln2=(l1_ln2_g, l1_ln2_b),
             ffn2=(l1_ffn2_w_in, l1_ffn2_w_out), ln3=(l1_ln3_g, l1_ln3_b)),
    ]
    for i in range(DEPTH):
        p = layers[i]
        x = deepnorm(x, FFN_RES * swiglu(x, *p["ffn1"]), *p["ln1"])
        if i % N_MIXERS == 0:
            y = pool_mixer(x, *p["mix"])
        else:
            lambda_init = 0.8 - 0.6 * math.exp(-0.3 * i)
            y = diff_attention(x, *p["mix"], lambda_init)
        x = deepnorm(x, y, *p["ln2"])
        x = deepnorm(x, FFN_RES * swiglu(x, *p["ffn2"]), *p["ln3"])
    return x
```

```cpp
#include <hip/hip_runtime.h>
#include <hip/hip_cooperative_groups.h>
#include <cstdio>
#include <cstdint>
namespace cg = cooperative_groups;
namespace pg8 {
#define PG8_LAS __attribute__((address_space(3)))
typedef unsigned short bf16_t;
typedef short bf16x8 __attribute__((ext_vector_type(8)));
typedef float f32x4 __attribute__((ext_vector_type(4)));
typedef unsigned u32x4 __attribute__((ext_vector_type(4)));
constexpr int BM = 256, BK = 64, HALF = 128, HTB = HALF * BK * 2  , STAGE_BYTES = 8 * HTB, NXCD = 8, WGM = 8;

__host__ __device__ __forceinline__ int lds_byte(int r, int c) { const int st = (r >> 4) * 2 + (c >> 5), rr = r & 15, cc = c & 31, ob = rr * 64 + cc * 2; return st * 1024 + (ob ^ (((ob >> 9) & 1) << 5)); }
__host__ __device__ __forceinline__ void stage_rc(int b, int& R, int& C) { const int st = b / 1024, sb = b % 1024, swz = sb ^ (((sb >> 9) & 1) << 5); R = (st >> 1) * 16 + swz / 64; C = (st & 1) * 32 + (swz % 64) / 2; }
__host__ __device__ __forceinline__ int perm32(int rho) { const int n = rho >> 4, i = rho & 15; return 8 * (i >> 2) + 4 * n + (i & 3); }

struct Unit { int pm, pn; };
struct Gemm { const bf16_t* A; const bf16_t* Bt; int M, N, K, lda, ldb, apn; };

struct StaticOrder {
    int nM, nN, nwg, G, c, rev;
    __host__ __device__ void init(int M, int N, int G_, int c_, int rev_ = 0) { nM = M / BM; nN = N / BM; nwg = nM * nN; G = G_; c = c_; rev = rev_; }
    __host__ __device__ bool next(int i, Unit& u) const {
        const long L = (long)i * G + c; if (L >= nwg) return false;
        int wgid = rev ? nwg - 1 - (int)L : (int)L; { const int q = nwg / NXCD, r = nwg % NXCD, xcd = wgid % NXCD, off = wgid / NXCD; wgid = (xcd < r ? xcd * (q + 1) : r * (q + 1) + (xcd - r) * q) + off; }
        const int nig = WGM * nN, gid = wgid / nig, fm = gid * WGM, gsz = (nM - fm) < WGM ? (nM - fm) : WGM;
        u.pm = fm + ((wgid % nig) % gsz); u.pn = (wgid % nig) / gsz; return true;
    }
    __device__ __forceinline__ void a_ready(const Unit&) const {}
    __device__ __forceinline__ void done(const Unit&) const {}
};

__device__ __forceinline__ unsigned cvt_pk_bf16(float lo, float hi) { unsigned r; asm volatile("v_cvt_pk_bf16_f32 %0, %1, %2" : "=v"(r) : "v"(lo), "v"(hi)); return r; }
typedef float f32x2 __attribute__((ext_vector_type(2)));
__device__ __forceinline__ f32x2 gelu_pk(f32x2 v) {
    const f32x2 av = __builtin_elementwise_abs(v), d = av * 0.2316418882f + 1.0f;
    f32x2 t; t.x = __builtin_amdgcn_rcpf(d.x); t.y = __builtin_amdgcn_rcpf(d.y);
    f32x2 q = t * 0.5307027145f + (-0.7265760135f); q = q * t + 0.7107068705f; q = q * t + (-0.142248368f); q = q * t + 0.127414796f; q = q * t;
    const f32x2 s = (v * v) * (-0.72134752044f);
    f32x2 e; e.x = __builtin_amdgcn_exp2f(s.x); e.y = __builtin_amdgcn_exp2f(s.y);
    const f32x2 m = v * (q * e), r = v - m;
    f32x2 o; o.x = v.x < 0.f ? m.x : r.x; o.y = v.y < 0.f ? m.y : r.y; return o;
}

template <int ACT  > struct EpiBf16 {
    static constexpr bool PERM = true, AFTER_DRAIN = false; static_assert(ACT == 0 || ACT == 1, "EpiBf16: ACT is 0 (none) or 1 (gelu_pk)");
    bf16_t* O; int ldc; const float* bias; int split_cols; size_t split_stride; float scale0;
    __device__ __forceinline__ void operator()(const f32x4 (&acc)[2][2][4][2], const Unit& u, int wr, int wc, int fr, int fq) const {
        const int row0 = u.pm * BM + wr * 64 + fr; int colt = u.pn * BM; bf16_t* base = O;
        float sc = 1.f; if (split_cols) { const int t = colt / split_cols; base += (size_t)t * split_stride; colt -= t * split_cols; if (t == 0) sc = scale0; }
        const int col0 = colt + wc * 32 + 8 * fq, bcol0 = u.pn * BM + wc * 32 + 8 * fq;
        f32x4 bv[2][2];
#pragma unroll
        for (int bj = 0; bj < 2; ++bj)
#pragma unroll
            for (int n = 0; n < 2; ++n) bv[bj][n] = bias ? *(const f32x4*)(bias + bcol0 + bj * HALF + 4 * n) : (f32x4){0.f, 0.f, 0.f, 0.f};
#pragma unroll
        for (int ai = 0; ai < 2; ++ai)
#pragma unroll
            for (int m = 0; m < 4; ++m) { bf16_t* rowp = base + (size_t)(row0 + ai * HALF + m * 16) * ldc + col0;
#pragma unroll
                for (int bj = 0; bj < 2; ++bj) { f32x4 v0 = acc[ai][bj][m][0] + bv[bj][0], v1 = acc[ai][bj][m][1] + bv[bj][1];
                    if (ACT == 1) { f32x2 a = gelu_pk((f32x2){v0[0], v0[1]}), b = gelu_pk((f32x2){v0[2], v0[3]}), c = gelu_pk((f32x2){v1[0], v1[1]}), d = gelu_pk((f32x2){v1[2], v1[3]});
                        v0 = (f32x4){a.x, a.y, b.x, b.y}; v1 = (f32x4){c.x, c.y, d.x, d.y}; }
                    v0 = v0 * sc; v1 = v1 * sc; u32x4 w; w.x = cvt_pk_bf16(v0[0], v0[1]); w.y = cvt_pk_bf16(v0[2], v0[3]); w.z = cvt_pk_bf16(v1[0], v1[1]); w.w = cvt_pk_bf16(v1[2], v1[3]);
                    *(u32x4*)(rowp + bj * HALF) = w; } }
    }
};
template <class Epi, class Sched, bool ALIGN_EPI = false, bool SP2 = false>
__device__ __forceinline__ void gemm_phase(PG8_LAS unsigned char* lds, const Gemm g, const Sched& S, const Epi& E) {
    int tid_ = threadIdx.x; asm volatile("" : "+v"(tid_));
    const int tid = tid_, wid = __builtin_amdgcn_readfirstlane(tid >> 6), lane = tid & 63, wr = wid >> 2, wc = wid & 3, fr = lane & 15, fq = lane >> 4;
    const int K = g.K, nt = K / BK;
    unsigned voffA[2], voffB[2];
#pragma unroll
    for (int i = 0; i < 2; ++i) { int R, C; stage_rc(tid * 16 + i * 8192, R, C); const int Rb = Epi::PERM ? ((R & ~31) + perm32(R & 31)) : R;
        voffA[i] = (unsigned)(R * g.lda + C) * 2u; voffB[i] = (unsigned)(Rb * g.ldb + C) * 2u; }
    const size_t kstep = (size_t)(BK * 2);
    const size_t hstepA = (size_t)HALF * g.lda * 2, hstepB = (size_t)HALF * g.ldb * 2;
    const size_t tstepA = 2 * hstepA, tstepB = 2 * hstepB;
    const unsigned ldsw = (unsigned)wid * 1024u;
    const int aoff = lds_byte(wr * 64 + fr, fq * 8), boff = lds_byte(wc * 32 + fr, fq * 8);
#define PG8_SA(b, h) (((b) * 2 + (h)) * HTB)
#define PG8_SB(b, h) ((4 + (b) * 2 + (h)) * HTB)
#define PG8_STAGE(bufoff, gbase, voff) do { _Pragma("unroll") for (int _i = 0; _i < 2; ++_i) \
        __builtin_amdgcn_global_load_lds((const unsigned*)((const char*)(gbase) + (voff)[_i]), (PG8_LAS unsigned*)(lds + (bufoff) + ldsw + _i * 8192), 16, 0, 0); } while (0)
#define PG8_LDA(dst, b, h) do { _Pragma("unroll") for (int m = 0; m < 4; ++m) _Pragma("unroll") for (int k = 0; k < 2; ++k) dst[m][k] = *(const PG8_LAS bf16x8*)(lds + PG8_SA(b, h) + aoff + m * 2048 + k * 1024); } while (0)
#define PG8_LDB(dst, b, h) do { _Pragma("unroll") for (int n = 0; n < 2; ++n) _Pragma("unroll") for (int k = 0; k < 2; ++k) dst[n][k] = *(const PG8_LAS bf16x8*)(lds + PG8_SB(b, h) + boff + n * 2048 + k * 1024); } while (0)
#define PG8_MMA(ai, bj, At, Bt) do { __builtin_amdgcn_s_setprio(1); _Pragma("unroll") for (int m = 0; m < 4; ++m) _Pragma("unroll") for (int n = 0; n < 2; ++n) _Pragma("unroll") for (int k = 0; k < 2; ++k) \
        acc[ai][bj][m][n] = __builtin_amdgcn_mfma_f32_16x16x32_bf16(Bt[n][k], At[m][k], acc[ai][bj][m][n], 0, 0, 0); __builtin_amdgcn_s_setprio(0); } while (0)
#define PG8_WAIT_V(n) asm volatile("s_waitcnt vmcnt(" #n ")" ::: "memory")
#define PG8_WAIT_L(n) asm volatile("s_waitcnt lgkmcnt(" #n ")" ::: "memory")
#define PG8_BAR __builtin_amdgcn_s_barrier()
#define PG8_SCHED __builtin_amdgcn_sched_barrier(0)
    Unit cur, nxt; int ui = 0;
    if (!S.next(0, cur)) return;
    f32x4 acc[2][2][4][2];
#pragma unroll
    for (int a = 0; a < 2; ++a)
#pragma unroll
        for (int b = 0; b < 2; ++b)
#pragma unroll
            for (int m = 0; m < 4; ++m)
#pragma unroll
                for (int n = 0; n < 2; ++n) acc[a][b][m][n] = (f32x4){0.f, 0.f, 0.f, 0.f};
    bf16x8 At[4][2], B0[2][2], B1[2][2];
    const char* cA = (const char*)g.A + (size_t)cur.pm * tstepA + (size_t)cur.pn * g.apn; const char* cB = (const char*)g.Bt + (size_t)cur.pn * tstepB;
    S.a_ready(cur);
    if constexpr (SP2) {
        PG8_STAGE(PG8_SB(0, 0), cB, voffB); PG8_STAGE(PG8_SB(0, 1), cB + hstepB, voffB); PG8_STAGE(PG8_SA(0, 0), cA, voffA); PG8_STAGE(PG8_SA(0, 1), cA + hstepA, voffA);
        if (wr == 1) PG8_BAR;
        PG8_WAIT_V(2); PG8_BAR;
        PG8_STAGE(PG8_SB(1, 0), cB + kstep, voffB); PG8_STAGE(PG8_SA(1, 0), cA + kstep, voffA); PG8_STAGE(PG8_SB(1, 1), cB + hstepB + kstep, voffB);
        PG8_WAIT_V(6); PG8_BAR;
    } else {
        PG8_STAGE(PG8_SB(0, 0), cB, voffB); PG8_STAGE(PG8_SA(0, 0), cA, voffA); PG8_STAGE(PG8_SB(0, 1), cB + hstepB, voffB); PG8_STAGE(PG8_SA(0, 1), cA + hstepA, voffA);
        if (wr == 1) PG8_BAR;
        PG8_WAIT_V(4); PG8_BAR;
        PG8_STAGE(PG8_SB(1, 0), cB + kstep, voffB); PG8_STAGE(PG8_SA(1, 0), cA + kstep, voffA); PG8_STAGE(PG8_SB(1, 1), cB + hstepB + kstep, voffB);
        PG8_WAIT_V(6); PG8_BAR;
    }
    for (;;) {
        const bool has_next = S.next(ui + 1, nxt);
        const char* nA = has_next ? (const char*)g.A + (size_t)nxt.pm * tstepA + (size_t)nxt.pn * g.apn : cA; const char* nB = has_next ? (const char*)g.Bt + (size_t)nxt.pn * tstepB : cB;
        for (int t = 0; t < nt; t += 2) {
            const bool last = (t == nt - 2);
            const char* a1 = cA + (size_t)(t + 1) * kstep;
            const char* a2 = last ? nA : cA + (size_t)(t + 2) * kstep; const char* b2 = last ? nB : cB + (size_t)(t + 2) * kstep;
            const char* a3 = a2 + kstep; const char* b3 = b2 + kstep;
            if (last && has_next) S.a_ready(nxt);
            if constexpr (SP2) {
            PG8_LDB(B0, 0, 0); PG8_LDB(B1, 0, 1); PG8_SCHED; PG8_LDA(At, 0, 0); PG8_STAGE(PG8_SA(1, 1), a1 + hstepA, voffA);
            PG8_WAIT_V(8); PG8_WAIT_L(0); PG8_BAR; PG8_MMA(0, 0, At, B0); PG8_MMA(0, 1, At, B1); PG8_BAR; PG8_SCHED;
            PG8_LDA(At, 0, 1); PG8_STAGE(PG8_SB(0, 0), b2, voffB); PG8_STAGE(PG8_SB(0, 1), b2 + hstepB, voffB); PG8_STAGE(PG8_SA(0, 0), a2, voffA);
            PG8_WAIT_V(8); PG8_WAIT_L(0); PG8_BAR; PG8_MMA(1, 0, At, B0); PG8_MMA(1, 1, At, B1); PG8_BAR; PG8_SCHED;
            PG8_LDB(B0, 1, 0); PG8_LDB(B1, 1, 1); PG8_SCHED; PG8_LDA(At, 1, 0); PG8_STAGE(PG8_SA(0, 1), a2 + hstepA, voffA);
            PG8_WAIT_V(8); PG8_WAIT_L(0); PG8_BAR; PG8_MMA(0, 0, At, B0); PG8_MMA(0, 1, At, B1); PG8_BAR; PG8_SCHED;
            PG8_LDA(At, 1, 1); PG8_STAGE(PG8_SB(1, 0), b3, voffB); PG8_STAGE(PG8_SB(1, 1), b3 + hstepB, voffB); PG8_STAGE(PG8_SA(1, 0), a3, voffA);
            PG8_WAIT_V(8); PG8_WAIT_L(0); PG8_BAR; PG8_MMA(1, 0, At, B0); PG8_MMA(1, 1, At, B1); PG8_BAR; PG8_SCHED;
            } else {
            PG8_LDB(B0, 0, 0); PG8_SCHED; PG8_LDA(At, 0, 0); PG8_STAGE(PG8_SA(1, 1), a1 + hstepA, voffA);
            PG8_WAIT_L(8); PG8_BAR; PG8_WAIT_L(0); PG8_MMA(0, 0, At, B0); PG8_BAR; PG8_SCHED;
            PG8_LDB(B1, 0, 1); PG8_STAGE(PG8_SB(0, 0), b2, voffB);
            PG8_BAR; PG8_WAIT_L(0); PG8_MMA(0, 1, At, B1); PG8_BAR;
            PG8_LDA(At, 0, 1); PG8_STAGE(PG8_SA(0, 0), a2, voffA);
            PG8_BAR; PG8_WAIT_L(0); PG8_MMA(1, 0, At, B0); PG8_BAR; PG8_SCHED;
            PG8_STAGE(PG8_SB(0, 1), b2 + hstepB, voffB);
            PG8_WAIT_V(6); PG8_BAR; PG8_MMA(1, 1, At, B1); PG8_BAR;
            PG8_LDB(B0, 1, 0); PG8_SCHED; PG8_LDA(At, 1, 0); PG8_STAGE(PG8_SA(0, 1), a2 + hstepA, voffA);
            PG8_WAIT_L(8); PG8_BAR; PG8_WAIT_L(0); PG8_MMA(0, 0, At, B0); PG8_BAR; PG8_SCHED;
            PG8_LDB(B1, 1, 1); PG8_STAGE(PG8_SB(1, 0), b3, voffB);
            PG8_BAR; PG8_WAIT_L(0); PG8_MMA(0, 1, At, B1); PG8_BAR;
            PG8_LDA(At, 1, 1); PG8_STAGE(PG8_SA(1, 0), a3, voffA);
            PG8_BAR; PG8_WAIT_L(0); PG8_MMA(1, 0, At, B0); PG8_BAR; PG8_SCHED;
            PG8_STAGE(PG8_SB(1, 1), b3 + hstepB, voffB);
            PG8_WAIT_V(6); PG8_BAR; PG8_MMA(1, 1, At, B1); PG8_BAR;
            }
        }
        if constexpr (ALIGN_EPI) { if (wr == 0) PG8_BAR; }
        if constexpr (!Epi::AFTER_DRAIN) { E(acc, cur, wr, wc, fr, fq); S.done(cur); }
        if (!has_next) break;
#pragma unroll
        for (int a = 0; a < 2; ++a)
#pragma unroll
            for (int b = 0; b < 2; ++b)
#pragma unroll
                for (int m = 0; m < 4; ++m)
#pragma unroll
                    for (int n = 0; n < 2; ++n) acc[a][b][m][n] = (f32x4){0.f, 0.f, 0.f, 0.f};
        cur = nxt; cA = nA; cB = nB; ++ui;
        if constexpr (ALIGN_EPI) { if (wr == 1) PG8_BAR; }
    }
    PG8_WAIT_V(0);
    if constexpr (!ALIGN_EPI) { if (wr == 0) PG8_BAR; }
    PG8_BAR;
    if constexpr (Epi::AFTER_DRAIN) { E.fused(acc, cur, wr, wc, fr, fq, lds, wid, lane); S.done(cur); }
#undef PG8_SA
#undef PG8_SB
#undef PG8_STAGE
#undef PG8_LDA
#undef PG8_LDB
#undef PG8_MMA
#undef PG8_WAIT_V
#undef PG8_WAIT_L
#undef PG8_BAR
#undef PG8_SCHED
}
}
namespace pg8 {
struct EpiSwiglu {
    static constexpr bool PERM = true, AFTER_DRAIN = false;
    bf16_t* H; int ldh;
    __device__ __forceinline__ void operator()(const f32x4 (&acc)[2][2][4][2], const Unit& u, int wr, int wc, int fr, int fq) const {
        const int row0 = u.pm * BM + wr * 64 + fr, col0 = u.pn * HALF + wc * 32 + 8 * fq;
#pragma unroll
        for (int ai = 0; ai < 2; ++ai)
#pragma unroll
            for (int m = 0; m < 4; ++m) { bf16_t* rowp = H + (size_t)(row0 + ai * HALF + m * 16) * ldh + col0;
                float hv[8];
#pragma unroll
                for (int n = 0; n < 2; ++n)
#pragma unroll
                    for (int i = 0; i < 4; ++i) { const float g = acc[ai][0][m][n][i], up = acc[ai][1][m][n][i];
                        const float e = __builtin_amdgcn_exp2f(g * -1.4426950408889634f); hv[n * 4 + i] = g * __builtin_amdgcn_rcpf(1.0f + e) * up; }
                u32x4 w; w.x = cvt_pk_bf16(hv[0], hv[1]); w.y = cvt_pk_bf16(hv[2], hv[3]); w.z = cvt_pk_bf16(hv[4], hv[5]); w.w = cvt_pk_bf16(hv[6], hv[7]);
                *(u32x4*)rowp = w; }
    }
};
struct EpiScaleBf16 {
    static constexpr bool PERM = true, AFTER_DRAIN = false;
    bf16_t* Y; const float* cscale; float cs;
    __device__ __forceinline__ void operator()(const f32x4 (&acc)[2][2][4][2], const Unit& u, int wr, int wc, int fr, int fq) const {
        const int row0 = u.pm * BM + wr * 64 + fr, col0 = u.pn * BM + wc * 32 + 8 * fq;
        f32x4 sc[2][2];
#pragma unroll
        for (int bj = 0; bj < 2; ++bj)
#pragma unroll
            for (int n = 0; n < 2; ++n) sc[bj][n] = cscale ? *(const f32x4*)(cscale + col0 + bj * HALF + 4 * n) : (f32x4){cs, cs, cs, cs};
#pragma unroll
        for (int ai = 0; ai < 2; ++ai)
#pragma unroll
            for (int m = 0; m < 4; ++m) { bf16_t* rowp = Y + (size_t)(row0 + ai * HALF + m * 16) * 1024 + col0;
#pragma unroll
                for (int bj = 0; bj < 2; ++bj) { const f32x4 v0 = acc[ai][bj][m][0] * sc[bj][0], v1 = acc[ai][bj][m][1] * sc[bj][1];
                    u32x4 w; w.x = cvt_pk_bf16(v0[0], v0[1]); w.y = cvt_pk_bf16(v0[2], v0[3]); w.z = cvt_pk_bf16(v1[0], v1[1]); w.w = cvt_pk_bf16(v1[2], v1[3]);
                    *(u32x4*)(rowp + bj * HALF) = w; } }
    }
};
}
#define PG8_SP2 true
#define PG8_ALIGN true
#include <hip/hip_bf16.h>
#include <cmath>
#include <hip/hip_bf16.h>
#include <cmath>
namespace attn_body {
using bf16=__hip_bfloat16;
using bf16x8=__attribute__((ext_vector_type(8)))short;
using s16x4=__attribute__((ext_vector_type(4)))short;
using f32x16=__attribute__((ext_vector_type(16)))float;
using u32x4=__attribute__((ext_vector_type(4)))unsigned;
constexpr int SEQ=8192,D=64,PQ=3072,PO=2048;
constexpr int NW=8,QBLK=32,QB=QBLK*NW,KVBLK=64,NQB=SEQ/QB;
constexpr int ATTN_UNIT_ROWS=QB;
__device__ __forceinline__ int crow(int r,int hi){return (r&3)+8*(r>>2)+4*hi;}
#define SBAR() __builtin_amdgcn_sched_barrier(0)
__device__ __forceinline__ void cmask(f32x16&p0,f32x16&p1,int jb,int qrel,int hi){
  const float NEG=-INFINITY; int kb=64*jb+4*hi;
  #pragma unroll
  for(int r=0;r<16;++r){int kv=kb+(r&3)+8*(r>>2); if(kv>qrel)p0[r]=NEG; if(kv+32>qrel)p1[r]=NEG;}
}

constexpr int NSLOT=3, SLOTB=8192;
constexpr int LDS_K=0, LDS_V=NSLOT*SLOTB, LDS_WS=3*NSLOT*SLOTB, LDS_OST=LDS_WS+NW*64*4, LDS_BYTES=LDS_OST+NW*8192;
constexpr float C2=0.125f*1.4426950408889634f;
__device__ __forceinline__ void glds16(const void*gsrc,unsigned lds_dst){unsigned keep;
  asm volatile("s_mov_b32 %0, m0\n\ts_mov_b32 m0, %2\n\ts_nop 0\n\tglobal_load_lds_dwordx4 %1, off\n\ts_mov_b32 m0, %0":"=&s"(keep):"v"(gsrc),"s"(lds_dst):"memory");}
template<int IMM> __device__ __forceinline__ void glds16s(const void*sbase,unsigned voff,unsigned lds_dst){unsigned keep;
  asm volatile("s_mov_b32 %0, m0\n\ts_mov_b32 m0, %3\n\ts_nop 0\n\tglobal_load_lds_dwordx4 %1, %2 offset:%c4\n\ts_mov_b32 m0, %0":"=&s"(keep):"v"(voff),"s"(sbase),"s"(lds_dst),"i"(IMM):"memory");}
__device__ __forceinline__ float max3f(float a,float b,float c){float r;asm("v_max3_f32 %0, %1, %2, %3":"=v"(r):"v"(a),"v"(b),"v"(c));return r;}
__device__ __forceinline__ float max2f(float a,float b){float r;asm("v_max_f32_e32 %0, %1, %2":"=v"(r):"v"(a),"v"(b));return r;}
__device__ __forceinline__ float fadd_s(float a,float b){float r;asm("v_add_f32_e32 %0, %1, %2":"=v"(r):"v"(a),"v"(b));return r;}
__device__ __forceinline__ float fsub_s(float a,float b){float r;asm("v_sub_f32_e32 %0, %1, %2":"=v"(r):"v"(a),"v"(b));return r;}
typedef float f32x2_t __attribute__((ext_vector_type(2))); typedef __bf16 bf16x2_t __attribute__((ext_vector_type(2)));
__device__ __forceinline__ unsigned cvtpk_s(float lo,float hi){f32x2_t v={lo,hi};bf16x2_t b=__builtin_convertvector(v,bf16x2_t);return __builtin_bit_cast(unsigned,b);}
#define WAIT_BAR(N) asm volatile("s_waitcnt vmcnt(" #N ") lgkmcnt(0)\n\ts_barrier":::"memory")

__device__ __forceinline__ void qkt(f32x16&p0,f32x16&p1,const char*Kslot,const bf16x8*qr,const f32x16&negm,int r32,int hi){
  const char*kb=Kslot+hi*1024+r32*16;
  #pragma unroll
  for(int d0=0;d0<4;++d0){
    const bf16x8 b0=*reinterpret_cast<const bf16x8*>(kb+d0*2048);
    const bf16x8 b1=*reinterpret_cast<const bf16x8*>(kb+d0*2048+512);
    if(d0==0){p0=__builtin_amdgcn_mfma_f32_32x32x16_bf16(b0,qr[0],negm,0,0,0);p1=__builtin_amdgcn_mfma_f32_32x32x16_bf16(b1,qr[0],negm,0,0,0);}
    else{p0=__builtin_amdgcn_mfma_f32_32x32x16_bf16(b0,qr[d0],p0,0,0,0);p1=__builtin_amdgcn_mfma_f32_32x32x16_bf16(b1,qr[d0],p1,0,0,0);}}
}
typedef __attribute__((address_space(3))) const char* lds_cptr;
typedef short v4i16_t __attribute__((ext_vector_type(4)));
__device__ __forceinline__ void kload8(bf16x8*kf,lds_cptr kp){
  kf[0]=*(const __attribute__((address_space(3))) bf16x8*)(kp);      kf[1]=*(const __attribute__((address_space(3))) bf16x8*)(kp+512);
  kf[2]=*(const __attribute__((address_space(3))) bf16x8*)(kp+2048); kf[3]=*(const __attribute__((address_space(3))) bf16x8*)(kp+2560);
  kf[4]=*(const __attribute__((address_space(3))) bf16x8*)(kp+4096); kf[5]=*(const __attribute__((address_space(3))) bf16x8*)(kp+4608);
  kf[6]=*(const __attribute__((address_space(3))) bf16x8*)(kp+6144); kf[7]=*(const __attribute__((address_space(3))) bf16x8*)(kp+6656);
}
__device__ __forceinline__ void kload2(bf16x8*kf,lds_cptr kp,int j){ kf[2*j]=*(const __attribute__((address_space(3))) bf16x8*)(kp+j*2048); kf[2*j+1]=*(const __attribute__((address_space(3))) bf16x8*)(kp+j*2048+512); }
__device__ __forceinline__ s16x4 vtr(lds_cptr p){ return __builtin_bit_cast(s16x4,__builtin_amdgcn_ds_read_tr16_b64_v4i16((__attribute__((address_space(3))) v4i16_t*)p)); }
__device__ __forceinline__ float rowmax(const f32x16&p0,const f32x16&p1){
  float a=max3f(p0[0],p0[1],p1[0]),b=max3f(p0[2],p0[3],p1[1]);a=max3f(a,p1[2],p1[3]);
  #pragma unroll
  for(int r=4;r<16;r+=4){a=max3f(a,p0[r],p0[r+1]);b=max3f(b,p0[r+2],p0[r+3]);a=max3f(a,p1[r],p1[r+1]);b=max3f(b,p1[r+2],p1[r+3]);}
  const float m=max2f(a,b);
  auto rr=__builtin_amdgcn_permlane32_swap(__float_as_uint(m),__float_as_uint(m),false,false);
  return max2f(__uint_as_float(rr[0]),__uint_as_float(rr[1]));
}
__device__ __forceinline__ void pv(f32x16*o,int vb,bf16x8 pa0,bf16x8 pa1,bf16x8 pa2,bf16x8 pa3){
  #pragma unroll
  for(int d0=0;d0<4;++d0){s16x4 lo[4],hi[4];
    #pragma unroll
    for(int ks=0;ks<4;++ks){
      asm volatile("ds_read_b64_tr_b16 %0,%1 offset:%c2":"=&v"(lo[ks]):"v"(vb),"i"(d0*4096+ks*1024):"memory");
      asm volatile("ds_read_b64_tr_b16 %0,%1 offset:%c2":"=&v"(hi[ks]):"v"(vb),"i"(d0*4096+ks*1024+512):"memory");}
    asm volatile("s_waitcnt lgkmcnt(0)":::"memory");SBAR();
    #define PK(k) (bf16x8){lo[k][0],lo[k][1],lo[k][2],lo[k][3],hi[k][0],hi[k][1],hi[k][2],hi[k][3]}
    o[d0]=__builtin_amdgcn_mfma_f32_32x32x16_bf16(pa0,PK(0),o[d0],0,0,0);
    o[d0]=__builtin_amdgcn_mfma_f32_32x32x16_bf16(pa1,PK(1),o[d0],0,0,0);
    o[d0]=__builtin_amdgcn_mfma_f32_32x32x16_bf16(pa2,PK(2),o[d0],0,0,0);
    o[d0]=__builtin_amdgcn_mfma_f32_32x32x16_bf16(pa3,PK(3),o[d0],0,0,0);
    #undef PK
  }
}

#ifndef ATTN_STORE16
#define ATTN_STORE16(p,v) (*(u32x4*)(p)=(v))
#endif
template<int THRL> __device__ __forceinline__ void attn_unit(long rowbase,int qb,const bf16*Q,const bf16*__restrict__ K,const bf16*__restrict__ V,bf16*O,float sl,int T0,char*shm){
  int tid_=threadIdx.x; asm volatile("":"+v"(tid_)); const int tid=tid_,lane=tid&63,r32=lane&31,hi=lane>>5; const int wid=__builtin_amdgcn_readfirstlane(tid>>6);
  const int q0=qb*QB; const float sl64=64.f*sl, sl32=32.f*sl;
  const bf16*Qw=Q+(rowbase+q0+wid*QBLK)*PQ;
  const bf16*Kh=K+(rowbase+(long)T0*KVBLK)*PQ,*Vh=V+(rowbase+(long)T0*KVBLK)*PQ;
  const unsigned lds0=(unsigned)(uintptr_t)shm;
  float*wsf=(float*)(shm+LDS_WS)+wid*64;
  const unsigned koff=(unsigned)(lane*PQ+wid*8)*2u, voff=(unsigned)((16*(wid&3)+(lane>>2))*PQ+(wid>>2)*32+(lane&3)*8)*2u;
  const unsigned kdst=lds0+LDS_K+wid*1024, vdst=lds0+LDS_V+wid*1024;
  #define DMA_K(t,slot) glds16s<0>(Kh+(long)(t)*KVBLK*PQ,koff,(unsigned)__builtin_amdgcn_readfirstlane(kdst+(slot)))
  #define DMA_V(t,slot) do{ glds16s<0>(Vh+(long)(t)*KVBLK*PQ,voff,(unsigned)__builtin_amdgcn_readfirstlane(vdst+2*(slot))); glds16s<0>(Vh+(long)(t)*KVBLK*PQ+64,voff,(unsigned)__builtin_amdgcn_readfirstlane(vdst+2*(slot)+8192)); }while(0)
  const int vb0=(int)(lds0+LDS_V)+((lane>>4)&1)*32+(lane&3)*8+(4*hi+((lane&15)>>2))*64;
  const char*Kbase=shm+LDS_K; bf16x8 kf[8];
  const lds_cptr shm3=(lds_cptr)shm; const lds_cptr kp0=shm3+LDS_K+hi*1024+r32*16; const lds_cptr vp0=shm3+LDS_V+((lane>>4)&1)*32+(lane&3)*8+(4*hi+((lane&15)>>2))*64;
  const int NT=(q0+QB)/KVBLK-T0;
  DMA_K(0,0);DMA_V(0,0);DMA_K(1,SLOTB);
  bf16x8 qr[4];
  #pragma unroll
  for(int d0=0;d0<4;++d0)qr[d0]=*reinterpret_cast<const bf16x8*>(&Qw[(long)r32*PQ+d0*16+hi*8]);
  typedef __attribute__((address_space(3))) bf16x8* lds_q8; const lds_q8 qpark=(lds_q8)((__attribute__((address_space(3))) char*)shm+LDS_OST+wid*8192+lane*16);
  #pragma unroll
  for(int d0=0;d0<4;++d0)qpark[d0*64]=qr[d0];
  #define QLD(d0) (qpark[(d0)*64])
  float mhat=0.f,l_reg=0.f;f32x16 o[4];o[0]=f32x16{};o[1]=f32x16{};o[2]=f32x16{};o[3]=f32x16{};const int qrel=wid*QBLK+r32;
  f32x16 negm;
  #pragma unroll
  for(int r=0;r<16;++r)negm[r]=sl*(float)(T0*KVBLK+crow(r,hi)-(q0+qrel));
  asm volatile("":"+v"(negm));
  #define CMASK(P0,P1,t) do{int jb_=(t)-(NT-4); if(jb_>=0)cmask(P0,P1,jb_,qrel,hi);}while(0)
  bool resc=false;
  #define START(P0,P1) do{ const float rm=rowmax(P0,P1); resc=false; \
    { const float dl=rm; mhat=fadd_s(mhat,dl); \
      _Pragma("unroll") for(int r=0;r<16;++r){P0[r]=fsub_s(P0[r],dl);P1[r]=fsub_s(P1[r],dl);} \
      { const float adj_=sl64-dl; _Pragma("unroll") for(int r=0;r<16;++r)negm[r]+=adj_; } asm volatile("":"+v"(negm)); } \
    _Pragma("unroll") for(int r=0;r<16;++r)P0[r]=__builtin_amdgcn_exp2f(P0[r]); }while(0)
  #define RESC() do{ if(resc){ asm volatile("s_waitcnt lgkmcnt(0)":::"memory"); \
      _Pragma("unroll") for(int d_=0;d_<4;++d_) _Pragma("unroll") for(int r=0;r<16;++r)o[d_][r]*=wsf[crow(r,hi)]; } }while(0)
  f32x16 pA0,pA1,pB0,pB1;
  int sl_prev=0,sl_cur=0,sl_next=SLOTB;
  #define ROT() do{sl_prev=sl_cur;sl_cur=sl_next;sl_next=(sl_next==(NSLOT-1)*SLOTB)?0:sl_next+SLOTB;}while(0)
  DMA_K(2,2*SLOTB);
  WAIT_BAR(3);
  qkt(pA0,pA1,Kbase,qr,negm,r32,hi);asm volatile("s_nop 15\n\ts_nop 7":"+v"(pA0),"+v"(pA1));
  _Pragma("unroll") for(int r=0;r<16;++r)pA1[r]+=sl32;
  CMASK(pA0,pA1,0);
  START(pA0,pA1);
  _Pragma("unroll") for(int r=0;r<16;++r)pA1[r]=__builtin_amdgcn_exp2f(pA1[r]);
  WAIT_BAR(0);
  DMA_K(3,0);DMA_V(1,SLOTB);
  ROT();
  kload8(kf,kp0+sl_cur);
  WAIT_BAR(3);
  s16x4 vlo[8],vhi[8]; u32x4 pw0,pw1,pw2,pw3;
  #define PKW(P,B) cvtpk_s(P[B],P[B+1])
  #define PAF(k) __builtin_bit_cast(bf16x8,pw##k)
  #define VFR(i) (bf16x8){vlo[i][0],vlo[i][1],vlo[i][2],vlo[i][3],vhi[i][0],vhi[i][1],vhi[i][2],vhi[i][3]}
  #define PIN(x) asm volatile("":"+v"(x))
  #define MX3(a,b,c) __builtin_fmaxf(__builtin_fmaxf((a),(b)),(c))
  #define GAPA(MF,A0,A1,A2,A3,W0,W1,PW) do{ MF; sacc+=A0; sacc+=A1; sacc+=A2; sacc+=A3; PIN(sacc); W0; W1; PIN(PW); SBAR(); }while(0)
  #define EX(v) __builtin_amdgcn_exp2f(v)
  #define GAPB2(MF,X,B) do{ MF; X[B]=EX(X[B]); X[B+1]=EX(X[B+1]); PIN(X); SBAR(); }while(0)
  #define VRD(i) do{ vlo[i]=vtr(vp_+(((i)>>2)*4096+((i)&3)*1024)); vhi[i]=vtr(vp_+(((i)>>2)*4096+((i)&3)*1024+512)); }while(0)
  #define VRD2(i) do{ vlo[i]=vtr(vp_+((2+((i)>>2))*4096+((i)&3)*1024)); vhi[i]=vtr(vp_+((2+((i)>>2))*4096+((i)&3)*1024+512)); }while(0)
  #define KRD(G,j) do{ if(G){ kload2(kf,kp0+sl_next,j); SBAR(); } }while(0)
  #define STEP(C0,C1,P0,P1,t,GK,GV,GL) do{ SBAR(); \
    const lds_cptr vp_=vp0+2*sl_prev; \
    const bf16x8 q0_=QLD(0),q1_=QLD(1); \
    VRD(0); SBAR(); float sacc=(P0[0]+P0[1]); \
    GAPA(C0=__builtin_amdgcn_mfma_f32_32x32x16_bf16(kf[0],q0_,negm,0,0,0), P0[2],P0[3],P0[4],P0[5],     pw0[0]=PKW(P0,0), pw0[1]=PKW(P0,2), pw0); \
    VRD(4); SBAR(); GAPA(C1=__builtin_amdgcn_mfma_f32_32x32x16_bf16(kf[1],q0_,negm,0,0,0), P0[6],P0[7],P0[8],P0[9],     pw0[2]=PKW(P0,4), pw0[3]=PKW(P0,6), pw0); \
    const bf16x8 q2_=QLD(2); VRD(1); SBAR(); GAPA(C0=__builtin_amdgcn_mfma_f32_32x32x16_bf16(kf[2],q1_,C0,0,0,0),   P0[10],P0[11],P0[12],P0[13], pw1[0]=PKW(P0,8), pw1[1]=PKW(P0,10), pw1); \
    VRD(5); SBAR(); GAPA(C1=__builtin_amdgcn_mfma_f32_32x32x16_bf16(kf[3],q1_,C1,0,0,0),   P0[14],P0[15],P1[0],P1[1],   pw1[2]=PKW(P0,12),pw1[3]=PKW(P0,14), pw1); \
    const bf16x8 q3_=QLD(3); VRD(2); SBAR(); GAPA(C0=__builtin_amdgcn_mfma_f32_32x32x16_bf16(kf[4],q2_,C0,0,0,0),   P1[2],P1[3],P1[4],P1[5],     pw2[0]=PKW(P1,0), pw2[1]=PKW(P1,2), pw2); \
    VRD(6); SBAR(); GAPA(C1=__builtin_amdgcn_mfma_f32_32x32x16_bf16(kf[5],q2_,C1,0,0,0),   P1[6],P1[7],P1[8],P1[9],     pw2[2]=PKW(P1,4), pw2[3]=PKW(P1,6), pw2); \
    VRD(3); SBAR(); GAPA(C0=__builtin_amdgcn_mfma_f32_32x32x16_bf16(kf[6],q3_,C0,0,0,0),   P1[10],P1[11],P1[12],P1[13], pw3[0]=PKW(P1,8), pw3[1]=PKW(P1,10), pw3); \
    VRD(7); SBAR(); GAPA(C1=__builtin_amdgcn_mfma_f32_32x32x16_bf16(kf[7],q3_,C1,0,0,0),   P1[14],P1[15],0.f,0.f,       pw3[2]=PKW(P1,12),pw3[3]=PKW(P1,14), pw3); \
    l_reg+=sacc; \
    if(GK){DMA_K((t)+3,sl_cur);} if(GV){DMA_V((t)+1,sl_next);} \
    _Pragma("unroll") for(int r=0;r<16;++r)C1[r]+=sl32; \
    CMASK(C0,C1,t); \
    { float a=MX3(C0[0],C0[1],C1[0]),b=MX3(C0[2],C0[3],C1[1]); a=MX3(a,C1[2],C1[3]); \
      _Pragma("unroll") for(int r=4;r<16;r+=4){a=MX3(a,C0[r],C0[r+1]);b=MX3(b,C0[r+2],C0[r+3]);a=MX3(a,C1[r],C1[r+1]);b=MX3(b,C1[r+2],C1[r+3]);} \
      float rm=__builtin_fmaxf(a,b); { auto rr=__builtin_amdgcn_permlane32_swap(__float_as_uint(rm),__float_as_uint(rm),false,false); rm=__builtin_fmaxf(__uint_as_float(rr[0]),__uint_as_float(rr[1])); } \
      resc=false; float adj_=sl64; \
      if(__builtin_expect(__any(rm>(float)THRL),0)){ const float dl=__builtin_fmaxf(rm,0.f); mhat+=dl; adj_-=dl; \
        _Pragma("unroll") for(int r=0;r<16;++r){C0[r]-=dl;C1[r]-=dl;} \
        const float f=__builtin_amdgcn_exp2f(-dl); l_reg*=f; if(hi==0)wsf[r32]=f; resc=true; } \
      _Pragma("unroll") for(int r=0;r<16;++r)negm[r]+=adj_; asm volatile("":"+v"(negm)); } \
    SBAR(); \
    GAPB2(o[0]=__builtin_amdgcn_mfma_f32_32x32x16_bf16(PAF(0),VFR(0),o[0],0,0,0), C0,0); VRD2(0); SBAR(); \
    GAPB2(o[1]=__builtin_amdgcn_mfma_f32_32x32x16_bf16(PAF(0),VFR(4),o[1],0,0,0), C0,2); VRD2(4); SBAR(); \
    KRD(GL,0); GAPB2(o[0]=__builtin_amdgcn_mfma_f32_32x32x16_bf16(PAF(1),VFR(1),o[0],0,0,0), C0,4); VRD2(1); SBAR(); \
    KRD(GL,1); GAPB2(o[1]=__builtin_amdgcn_mfma_f32_32x32x16_bf16(PAF(1),VFR(5),o[1],0,0,0), C0,6); VRD2(5); SBAR(); \
    KRD(GL,2); GAPB2(o[0]=__builtin_amdgcn_mfma_f32_32x32x16_bf16(PAF(2),VFR(2),o[0],0,0,0), C0,8); VRD2(2); SBAR(); \
    KRD(GL,3); GAPB2(o[1]=__builtin_amdgcn_mfma_f32_32x32x16_bf16(PAF(2),VFR(6),o[1],0,0,0), C0,10); VRD2(6); SBAR(); \
    GAPB2(o[0]=__builtin_amdgcn_mfma_f32_32x32x16_bf16(PAF(3),VFR(3),o[0],0,0,0), C0,12); VRD2(3); SBAR(); \
    GAPB2(o[1]=__builtin_amdgcn_mfma_f32_32x32x16_bf16(PAF(3),VFR(7),o[1],0,0,0), C0,14); VRD2(7); SBAR(); \
    GAPB2(o[2]=__builtin_amdgcn_mfma_f32_32x32x16_bf16(PAF(0),VFR(0),o[2],0,0,0), C1,0); \
    GAPB2(o[3]=__builtin_amdgcn_mfma_f32_32x32x16_bf16(PAF(0),VFR(4),o[3],0,0,0), C1,2); \
    GAPB2(o[2]=__builtin_amdgcn_mfma_f32_32x32x16_bf16(PAF(1),VFR(1),o[2],0,0,0), C1,4); \
    GAPB2(o[3]=__builtin_amdgcn_mfma_f32_32x32x16_bf16(PAF(1),VFR(5),o[3],0,0,0), C1,6); \
    GAPB2(o[2]=__builtin_amdgcn_mfma_f32_32x32x16_bf16(PAF(2),VFR(2),o[2],0,0,0), C1,8); \
    GAPB2(o[3]=__builtin_amdgcn_mfma_f32_32x32x16_bf16(PAF(2),VFR(6),o[3],0,0,0), C1,10); \
    GAPB2(o[2]=__builtin_amdgcn_mfma_f32_32x32x16_bf16(PAF(3),VFR(3),o[2],0,0,0), C1,12); \
    GAPB2(o[3]=__builtin_amdgcn_mfma_f32_32x32x16_bf16(PAF(3),VFR(7),o[3],0,0,0), C1,14); \
    }while(0)
  int t=1;
  #undef CMASK
  #define CMASK(P0,P1,t) do{}while(0)
  for(;t+5<NT;t+=2){
    STEP(pB0,pB1,pA0,pA1,t,true,true,true);     WAIT_BAR(3); RESC(); ROT();
    STEP(pA0,pA1,pB0,pB1,t+1,true,true,true);   WAIT_BAR(3); RESC(); ROT();
  }
  #undef CMASK
  #define CMASK(P0,P1,t) do{int jb_=(t)-(NT-4); if(jb_>=0)cmask(P0,P1,jb_,qrel,hi);}while(0)
  #define ENDW(tt) do{ if((tt)+3<NT){WAIT_BAR(3);} else if((tt)+2<NT){WAIT_BAR(2);} else {WAIT_BAR(0);} }while(0)
  for(;t+1<NT;t+=2){
    STEP(pB0,pB1,pA0,pA1,t,(t+3<NT),(t+1<NT),(t+1<NT));       ENDW(t);   RESC(); ROT();
    STEP(pA0,pA1,pB0,pB1,t+1,(t+4<NT),(t+2<NT),(t+2<NT));     ENDW(t+1); RESC(); ROT();
  }
  STEP(pB0,pB1,pA0,pA1,NT-1,false,false,false); RESC();
  { float sacc=pB0[0]+pB0[1]; _Pragma("unroll") for(int r=2;r<16;++r)sacc+=pB0[r]; _Pragma("unroll") for(int r=0;r<16;++r)sacc+=pB1[r]; l_reg+=sacc;
    pw0=(u32x4){PKW(pB0,0),PKW(pB0,2),PKW(pB0,4),PKW(pB0,6)};pw1=(u32x4){PKW(pB0,8),PKW(pB0,10),PKW(pB0,12),PKW(pB0,14)};pw2=(u32x4){PKW(pB1,0),PKW(pB1,2),PKW(pB1,4),PKW(pB1,6)};pw3=(u32x4){PKW(pB1,8),PKW(pB1,10),PKW(pB1,12),PKW(pB1,14)};
    SBAR(); pv(o,vb0+2*sl_cur,PAF(0),PAF(1),PAF(2),PAF(3)); }
  #undef PKW
  #undef PAF
  #undef VFR
  #undef PIN
  #undef MX3
  #undef GAPA
  #undef GAPB2
  #undef VRD2
  #undef EX
  #undef VRD
  #undef KRD
  #undef STEP
  #undef ENDW
  {auto rr=__builtin_amdgcn_permlane32_swap(__float_as_uint(l_reg),__float_as_uint(l_reg),false,false);l_reg=__uint_as_float(rr[0])+__uint_as_float(rr[1]);}
  if(hi==0)wsf[32+r32]=l_reg;asm volatile("s_waitcnt lgkmcnt(0)":::"memory");
  float rli[16];
  #pragma unroll
  for(int r=0;r<16;++r)rli[r]=__builtin_amdgcn_rcpf(wsf[32+crow(r,hi)]);
  bf16*Ow=O+(rowbase+q0+wid*QBLK)*PO;
  { bf16*stg=(bf16*)(shm+LDS_OST)+wid*4096;
    #pragma unroll
    for(int r=0;r<16;++r){const int orow=crow(r,hi);
      #pragma unroll
      for(int d0=0;d0<4;++d0)stg[orow*128+d0*32+r32]=__float2bfloat16(o[d0][r]*rli[r]);}
    asm volatile("s_waitcnt lgkmcnt(0)":::"memory");
    #pragma unroll
    for(int i=0;i<8;++i){const int row=i*4+(lane>>4),ch=lane&15; const u32x4 v=*(const u32x4*)(stg+row*128+ch*8); ATTN_STORE16(Ow+(long)row*PO+ch*8,v);} }
  asm volatile("s_waitcnt lgkmcnt(0)\n\ts_barrier":::"memory");
  #undef QLD
  #undef DMA_K
  #undef DMA_V
  #undef CMASK
  #undef START
  #undef RESC
  #undef ROT
}
constexpr int ATTN_LDS_BYTES=LDS_BYTES;
template<int THRL=8> __device__ __forceinline__ void attn_phase(char*lds,const bf16*QKV,bf16*OP,unsigned*ctl){
  volatile __attribute__((address_space(3))) unsigned* qword=(volatile __attribute__((address_space(3))) unsigned*)(__attribute__((address_space(3))) char*)lds+(140*1024/4);
  const int x0=(int)(__builtin_amdgcn_s_getreg((3<<11)|20)&7u);
  for(int qi=0;qi<8;++qi){ const int b=(x0+qi)&7;
  for(;;){
    if(threadIdx.x==0){ const unsigned i=__hip_atomic_fetch_add(ctl+256+16*b,1u,__ATOMIC_RELAXED,__HIP_MEMORY_SCOPE_AGENT); *qword=i; }
    asm volatile("s_waitcnt lgkmcnt(0)\n\ts_barrier":::"memory");
    const int idx=__builtin_amdgcn_readfirstlane((int)*qword);
    asm volatile("s_waitcnt lgkmcnt(0)\n\ts_barrier":::"memory");
    if(idx>=16*NQB)break;
    const int grp=idx>>5,h=7-(grp>>1),mp=grp&1,qb=NQB-1-(idx&31);
    const float sl=__builtin_ldexpf(1.4426950408889634f,-(h+1));
    const float qn2=__uint_as_float(__hip_atomic_load(ctl+b*32+mp*8+h,__ATOMIC_RELAXED,__HIP_MEMORY_SCOPE_AGENT)),kn2=__uint_as_float(__hip_atomic_load(ctl+b*32+16+mp*8+h,__ATOMIC_RELAXED,__HIP_MEMORY_SCOPE_AGENT));
    const float thr=2.04f*sqrtf(qn2*kn2)+152.f, xs=(float)(qb*QB-63)-thr/sl;
    int T0=0; if(xs>=0.f){ T0=((int)(xs*(1.f/64.f))+1)&~1; if(T0>4*qb)T0=4*qb; }
    T0=__builtin_amdgcn_readfirstlane(T0);
    attn_unit<THRL>((long)b*SEQ,qb,QKV+mp*512+h*64,QKV+1024+mp*512+h*64,QKV+2048+h*128,OP+mp*1024+h*128,sl,T0,lds);
  } }
}
#undef SBAR
#undef WAIT_BAR
}
constexpr int NWAVES = 8;
constexpr int BATCH = 8, SEQL = 8192, DMODEL = 1024, DFF = 2816, NQKV = 3072;
constexpr int MROWS = BATCH * SEQL;
constexpr float LN_EPS = 1e-5f, RMS_EPS = 1e-5f;
constexpr float DN_ALPHA = 1.41421356237309515f;
constexpr float LAMBDA_INIT = 0.35550906759096927f;
constexpr size_t MiB = 1u << 20;
constexpr size_t WS_WIN = 2 * MiB, WIN_BYTES = 11 * MiB;
constexpr size_t WS_WOUT = 46 * MiB, WOUT_BYTES = 11 * MiB / 2;
constexpr size_t WS_WQKV = 68 * MiB, WS_WO = 74 * MiB, WS_PW = 76 * MiB;
constexpr size_t WS_Z = 80 * MiB;
constexpr size_t WS_XB = 336 * MiB;
constexpr size_t WS_H = 464 * MiB;
constexpr size_t WS_XL = 848 * MiB;
constexpr size_t WS_END = 912 * MiB;
constexpr int LDS_BYTES = 147456;
#define GAS __attribute__((address_space(1)))
#define LAS __attribute__((address_space(3)))
typedef unsigned short bf16;
typedef unsigned v4u __attribute__((ext_vector_type(4)));
typedef unsigned v2u __attribute__((ext_vector_type(2)));
typedef float f32x4 __attribute__((ext_vector_type(4)));
#define LDS_WAIT() asm volatile("s_waitcnt lgkmcnt(0)" ::: "memory")
__device__ __forceinline__ unsigned pk2(float lo, float hi) { return pg8::cvt_pk_bf16(lo, hi); }
__device__ __forceinline__ float wave_sum(float v) {
#pragma unroll
    for (int o = 1; o < 64; o <<= 1) v += __shfl_xor(v, o);
    return v;
}
__device__ __forceinline__ void p0_transpose_item(const float* W, int K, int N, bf16* WT, int mode, int row_off, LAS float* scr, int item, int lane) {
    const int nblk = N / 32, kb = item / nblk, nb = item % nblk, k0 = 64 * kb, n0 = 32 * nb;
    int r0 = row_off + n0;
    if (mode == 1) { const int j = n0 < DFF ? n0 : n0 - DFF; r0 = (j >> 7) * 256 + (j & 127) + (n0 < DFF ? 0 : 128); }
#pragma unroll 8
    for (int i = 0; i < 32; ++i) { const int kk = 2 * i + (lane >> 5); scr[kk * 33 + (lane & 31)] = W[(size_t)(k0 + kk) * N + n0 + (lane & 31)]; }
    LDS_WAIT(); asm volatile("" ::: "memory");
    const int c = lane & 7;
#pragma unroll
    for (int j = 0; j < 4; ++j) { const int n = (lane >> 3) + 8 * j; const LAS float* s = scr + (8 * c) * 33 + n;
        v4u o; o.x = pk2(s[0 * 33], s[1 * 33]); o.y = pk2(s[2 * 33], s[3 * 33]); o.z = pk2(s[4 * 33], s[5 * 33]); o.w = pk2(s[6 * 33], s[7 * 33]);
        *(GAS v4u*)(WT + (size_t)(r0 + n) * K + k0 + 8 * c) = o; }
    LDS_WAIT(); asm volatile("" ::: "memory");
}
struct Args { const float* in[30]; float* out; unsigned char* ws; };

__device__ __forceinline__ void prologue(const Args& a, LAS unsigned char* lds, int gw, int NGW, int wave, int lane) {
    LAS float* scr = (LAS float*)(lds + wave * 16384);
    unsigned char* ws = a.ws;
    constexpr int I_IN = (DMODEL / 64) * (2 * DFF / 32), I_OUT = (DFF / 64) * (DMODEL / 32), I_QKV = (DMODEL / 64) * (NQKV / 32), I_O = (DMODEL / 64) * (DMODEL / 32), I_P = (256 / 64) * (256 / 32);
    constexpr int NITEMS = 4 * I_IN + 4 * I_OUT + I_QKV + I_O + 4 * I_P;
    for (int it = gw; it < NITEMS; it += NGW) {
        int r = it;
        if (r < 4 * I_IN) { const int f = r / I_IN; const int idx = f == 0 ? 1 : f == 1 ? 9 : f == 2 ? 13 : 26;
            p0_transpose_item(a.in[idx], DMODEL, 2 * DFF, (bf16*)(ws + WS_WIN + f * WIN_BYTES), 1, 0, scr, r % I_IN, lane); continue; } r -= 4 * I_IN;
        if (r < 4 * I_OUT) { const int f = r / I_OUT; const int idx = f == 0 ? 2 : f == 1 ? 10 : f == 2 ? 14 : 27;
            p0_transpose_item(a.in[idx], DFF, DMODEL, (bf16*)(ws + WS_WOUT + f * WOUT_BYTES), 0, 0, scr, r % I_OUT, lane); continue; } r -= 4 * I_OUT;
        if (r < I_QKV) { p0_transpose_item(a.in[17], DMODEL, NQKV, (bf16*)(ws + WS_WQKV), 0, 0, scr, r, lane); continue; } r -= I_QKV;
        if (r < I_O) { p0_transpose_item(a.in[23], DMODEL, DMODEL, (bf16*)(ws + WS_WO), 0, 0, scr, r, lane); continue; } r -= I_O;
        { const int g = r / I_P; p0_transpose_item(a.in[5] + (size_t)g * 65536, 256, 256, (bf16*)(ws + WS_PW), 0, g * 256, scr, r % I_P, lane); }
    }
    const GAS f32x4* x4 = (const GAS f32x4*)a.in[0]; GAS v4u* xb = (GAS v4u*)(ws + WS_XB);
    const size_t n8 = (size_t)MROWS * DMODEL / 8, nthr = (size_t)NGW * 64;
#pragma unroll 4
    for (size_t i = (size_t)gw * 64 + lane; i < n8; i += nthr) { const f32x4 p = x4[2 * i], q = x4[2 * i + 1];
        v4u o; o.x = pk2(p.x, p.y); o.y = pk2(p.z, p.w); o.z = pk2(q.x, q.y); o.w = pk2(q.z, q.w); xb[i] = o; }
}
template <int R, bool IN_F32, bool OUT_F32> __device__ __forceinline__ void ln_pass(const float* xin, const bf16* Y, const float* g, const float* b, float* xout, bf16* XB, unsigned char* XL, int gw, int NGW, int lane) {
    f32x4 gv[4], bv[4];
#pragma unroll
    for (int j = 0; j < 4; ++j) { const int c4 = (j >> 1) * 128 + lane * 2 + (j & 1); gv[j] = ((const GAS f32x4*)g)[c4]; bv[j] = ((const GAS f32x4*)b)[c4]; }
    for (int m0 = gw * R; m0 < MROWS; m0 += NGW * R) {
        f32x4 v[R][4]; v4u yy[R][2]; float s[R], s2[R];
        if (IN_F32) {
#pragma unroll
            for (int r = 0; r < R; ++r) { const GAS f32x4* xr = (const GAS f32x4*)(xin + (size_t)(m0 + r) * DMODEL) + lane * 2; const GAS v4u* yr = (const GAS v4u*)(Y + (size_t)(m0 + r) * DMODEL) + lane;
                v[r][0] = xr[0]; v[r][1] = xr[1]; v[r][2] = xr[128]; v[r][3] = xr[129]; yy[r][0] = yr[0]; yy[r][1] = yr[64]; }
        } else {
            v4u hh[R][2]; v2u ll[R][2];
#pragma unroll
            for (int r = 0; r < R; ++r) { const GAS v4u* hr = (const GAS v4u*)(XB + (size_t)(m0 + r) * DMODEL) + lane; const GAS v2u* lr = (const GAS v2u*)(XL + (size_t)(m0 + r) * DMODEL) + lane; const GAS v4u* yr = (const GAS v4u*)(Y + (size_t)(m0 + r) * DMODEL) + lane;
                hh[r][0] = hr[0]; hh[r][1] = hr[64]; ll[r][0] = lr[0]; ll[r][1] = lr[64]; yy[r][0] = yr[0]; yy[r][1] = yr[64]; }
#pragma unroll
            for (int r = 0; r < R; ++r)
#pragma unroll
                for (int h = 0; h < 2; ++h) { const unsigned hw[4] = {hh[r][h].x, hh[r][h].y, hh[r][h].z, hh[r][h].w}; const int lw[2] = {(int)ll[r][h].x, (int)ll[r][h].y};
#pragma unroll
                    for (int q = 0; q < 2; ++q) { const float c = 1.0f / 512.0f;
                        v[r][2 * h + q] = (f32x4){__uint_as_float(hw[2 * q] << 16) + __builtin_amdgcn_cvt_f32_fp8(lw[q], 0) * c, __uint_as_float(hw[2 * q] & 0xffff0000u) + __builtin_amdgcn_cvt_f32_fp8(lw[q], 1) * c,
                                                  __uint_as_float(hw[2 * q + 1] << 16) + __builtin_amdgcn_cvt_f32_fp8(lw[q], 2) * c, __uint_as_float(hw[2 * q + 1] & 0xffff0000u) + __builtin_amdgcn_cvt_f32_fp8(lw[q], 3) * c}; } }
        }
#pragma unroll
        for (int r = 0; r < R; ++r) { const unsigned yw[8] = {yy[r][0].x, yy[r][0].y, yy[r][0].z, yy[r][0].w, yy[r][1].x, yy[r][1].y, yy[r][1].z, yy[r][1].w}; s[r] = 0.f;
#pragma unroll
            for (int j = 0; j < 4; ++j) { const f32x4 yv = (f32x4){__uint_as_float(yw[2 * j] << 16), __uint_as_float(yw[2 * j] & 0xffff0000u), __uint_as_float(yw[2 * j + 1] << 16), __uint_as_float(yw[2 * j + 1] & 0xffff0000u)};
                v[r][j] = v[r][j] * DN_ALPHA + yv; s[r] += (v[r][j].x + v[r][j].y) + (v[r][j].z + v[r][j].w); } }
#pragma unroll
        for (int o = 1; o < 64; o <<= 1)
#pragma unroll
            for (int r = 0; r < R; ++r) s[r] += __shfl_xor(s[r], o);
#pragma unroll
        for (int r = 0; r < R; ++r) { const float mean = s[r] * (1.f / DMODEL); s2[r] = 0.f;
#pragma unroll
            for (int j = 0; j < 4; ++j) { v[r][j] = v[r][j] - mean; s2[r] += (v[r][j].x * v[r][j].x + v[r][j].y * v[r][j].y) + (v[r][j].z * v[r][j].z + v[r][j].w * v[r][j].w); } }
#pragma unroll
        for (int o = 1; o < 64; o <<= 1)
#pragma unroll
            for (int r = 0; r < R; ++r) s2[r] += __shfl_xor(s2[r], o);
#pragma unroll
        for (int r = 0; r < R; ++r) { const float rstd = 1.f / sqrtf(s2[r] * (1.f / DMODEL) + LN_EPS);
#pragma unroll
            for (int j = 0; j < 4; ++j) v[r][j] = v[r][j] * rstd * gv[j] + bv[j];
            if (OUT_F32) { GAS f32x4* xo = (GAS f32x4*)(xout + (size_t)(m0 + r) * DMODEL) + lane * 2; xo[0] = v[r][0]; xo[1] = v[r][1]; xo[128] = v[r][2]; xo[129] = v[r][3]; }
            else { GAS v4u* o8 = (GAS v4u*)(XB + (size_t)(m0 + r) * DMODEL) + lane; GAS v2u* l8 = (GAS v2u*)(XL + (size_t)(m0 + r) * DMODEL) + lane;
#pragma unroll
                for (int h = 0; h < 2; ++h) { unsigned hw[4]; int lw[2];
#pragma unroll
                    for (int q = 0; q < 2; ++q) { const f32x4 x = v[r][2 * h + q]; hw[2 * q] = pk2(x.x, x.y); hw[2 * q + 1] = pk2(x.z, x.w);
                        const float l0 = (x.x - __uint_as_float(hw[2 * q] << 16)) * 512.f, l1 = (x.y - __uint_as_float(hw[2 * q] & 0xffff0000u)) * 512.f, l2 = (x.z - __uint_as_float(hw[2 * q + 1] << 16)) * 512.f, l3 = (x.w - __uint_as_float(hw[2 * q + 1] & 0xffff0000u)) * 512.f;
                        int p = __builtin_amdgcn_cvt_pk_fp8_f32(l0, l1, 0, false); lw[q] = __builtin_amdgcn_cvt_pk_fp8_f32(l2, l3, p, true); }
                    o8[64 * h] = (v4u){hw[0], hw[1], hw[2], hw[3]}; l8[64 * h] = (v2u){(unsigned)lw[0], (unsigned)lw[1]}; } }
        }
    }
}
__device__ __forceinline__ void pool_diff_pass(const bf16* XB, const unsigned char* XL, bf16* DB, int gw, int NGW, int lane) {
#define XLOAD(roff) ({ const v2u h_ = hc[(long)(roff) * 256]; const int l_ = (int)lc[(long)(roff) * 256]; const float c_ = 1.0f / 512.0f; \
        (f32x4){__uint_as_float(h_.x << 16) + __builtin_amdgcn_cvt_f32_fp8(l_, 0) * c_, __uint_as_float(h_.x & 0xffff0000u) + __builtin_amdgcn_cvt_f32_fp8(l_, 1) * c_, \
                __uint_as_float(h_.y << 16) + __builtin_amdgcn_cvt_f32_fp8(l_, 2) * c_, __uint_as_float(h_.y & 0xffff0000u) + __builtin_amdgcn_cvt_f32_fp8(l_, 3) * c_}; })
    for (int it = gw; it < (MROWS / 32) * 4; it += NGW) {
        const int g = it & 3, r0 = (it >> 2) * 32, t0 = r0 & (SEQL - 1), w = 2 << g;
        const GAS v2u* hc = (const GAS v2u*)(XB + (size_t)r0 * DMODEL + g * 256) + lane;
        const GAS unsigned* lc = (const GAS unsigned*)(XL + (size_t)r0 * DMODEL + g * 256) + lane;
        GAS v2u* dc = (GAS v2u*)(DB + (size_t)r0 * DMODEL + g * 256) + lane;
        f32x4 s = (f32x4){0.f, 0.f, 0.f, 0.f};
        if (t0 > 0) for (int i = 1; i <= w; ++i) s += XLOAD(-i);
        const float rw = 1.0f / (float)w;
        for (int j0 = 0; j0 < 32; j0 += 8) { f32x4 xv[8], xo[8];
#pragma unroll
            for (int k = 0; k < 8; ++k) { const int j = j0 + k, t = t0 + j; xv[k] = XLOAD(j); xo[k] = XLOAD(t >= w ? j - w : j); }
#pragma unroll
            for (int k = 0; k < 8; ++k) { const int j = j0 + k, t = t0 + j; s += xv[k]; if (t >= w) s -= xo[k];
                const float rc = t + 1 < w ? 1.0f / (float)(t + 1) : rw;
                const f32x4 d = s * rc - xv[k]; v2u o; o.x = pk2(d.x, d.y); o.y = pk2(d.z, d.w); dc[(long)j * 256] = o; } }
    }
#undef XLOAD
}
__device__ __forceinline__ void attn_combine_pass(const bf16* OP, const float* lq1, const float* lk1, const float* lq2, const float* lk2, const float* sg, bf16* OB, int gw, int NGW, int lane) {
    const float lam = __expf(wave_sum(lq1[lane] * lk1[lane])) - __expf(wave_sum(lq2[lane] * lk2[lane])) + LAMBDA_INIT;
    float gl[16];
#pragma unroll
    for (int i = 0; i < 16; ++i) gl[i] = sg[(lane & 7) * 16 + i] * (1.0f - LAMBDA_INIT);
    for (int m0 = gw * 4; m0 < MROWS; m0 += NGW * 4) {
        v4u A0[4], A1[4], B0[4], B1[4];
#pragma unroll
        for (int r = 0; r < 4; ++r) { const GAS v4u* p1 = (const GAS v4u*)(OP + (size_t)(m0 + r) * 2048) + lane * 2; const GAS v4u* p2 = p1 + 128; A0[r] = p1[0]; A1[r] = p1[1]; B0[r] = p2[0]; B1[r] = p2[1]; }
#pragma unroll
        for (int r = 0; r < 4; ++r) { const int m = m0 + r; const v4u a0 = A0[r], a1 = A1[r], b0 = B0[r], b1 = B1[r];
        unsigned aw[8] = {a0.x, a0.y, a0.z, a0.w, a1.x, a1.y, a1.z, a1.w}, bw[8] = {b0.x, b0.y, b0.z, b0.w, b1.x, b1.y, b1.z, b1.w};
        float o[16]; float ss = 0.f;
#pragma unroll
        for (int i = 0; i < 8; ++i) { const float x0 = __uint_as_float(aw[i] << 16), x1 = __uint_as_float(aw[i] & 0xffff0000u), y0 = __uint_as_float(bw[i] << 16), y1 = __uint_as_float(bw[i] & 0xffff0000u);
            o[2 * i] = x0 - lam * y0; o[2 * i + 1] = x1 - lam * y1; ss += o[2 * i] * o[2 * i] + o[2 * i + 1] * o[2 * i + 1]; }
        ss += __shfl_xor(ss, 1); ss += __shfl_xor(ss, 2); ss += __shfl_xor(ss, 4);
        const float rs = 1.0f / sqrtf(ss * (1.0f / 128.0f) + RMS_EPS);
        v4u w0, w1;
        w0.x = pk2(o[0] * rs * gl[0], o[1] * rs * gl[1]); w0.y = pk2(o[2] * rs * gl[2], o[3] * rs * gl[3]); w0.z = pk2(o[4] * rs * gl[4], o[5] * rs * gl[5]); w0.w = pk2(o[6] * rs * gl[6], o[7] * rs * gl[7]);
        w1.x = pk2(o[8] * rs * gl[8], o[9] * rs * gl[9]); w1.y = pk2(o[10] * rs * gl[10], o[11] * rs * gl[11]); w1.z = pk2(o[12] * rs * gl[12], o[13] * rs * gl[13]); w1.w = pk2(o[14] * rs * gl[14], o[15] * rs * gl[15]);
        GAS v4u* q = (GAS v4u*)(OB + (size_t)m * DMODEL) + lane * 2; q[0] = w0; q[1] = w1; }
    }
}

#define XB_TMO      128
#define XB_XCNT(j)  (256  + 64 * (j))
#define XB_XSUB(j)  (1280 + 64 * (j))
#define XB_XGEN(j)  (2304 + 64 * (j))
#define XB_TOP      3328
#define XB_TOPGEN   3392
#define XCD_BAR_WORDS 3456
#define XB_SPIN_CAP (1u << 18)

__device__ __forceinline__ unsigned xb_ld(unsigned* p)              { return __hip_atomic_load(p, __ATOMIC_RELAXED, __HIP_MEMORY_SCOPE_AGENT); }
__device__ __forceinline__ unsigned xb_add(unsigned* p, unsigned v) { return __hip_atomic_fetch_add(p, v, __ATOMIC_RELAXED, __HIP_MEMORY_SCOPE_AGENT); }
__device__ __forceinline__ unsigned xb_xcc_id() { return (unsigned)__builtin_amdgcn_s_getreg((3 << 11) | 20) & 0xFu; }
#define XB_SPIN(cond, bar) do { unsigned _sp = 0; while (cond) { __builtin_amdgcn_s_sleep(1); \
    if ((++_sp & 255u) == 0u) { if (xb_ld(&(bar)[XB_TMO])) break; if (_sp > XB_SPIN_CAP) { atomicAdd(&(bar)[XB_TMO], 1u); break; } } } } while (0)

struct XcdBarrier {
    unsigned* bar; unsigned x;
    volatile LAS unsigned* st;
};

__device__ __forceinline__ XcdBarrier xcd_barrier_post(unsigned* bar, volatile LAS unsigned* st) {
    XcdBarrier b; b.bar = bar; b.x = xb_xcc_id(); b.st = st;
    if (threadIdx.x == 0) (void)xb_add(&bar[XB_XCNT(b.x)], 1u);
    return b;
}
__device__ __forceinline__ void xcd_barrier_complete(unsigned* bar, unsigned x, unsigned& nloc, unsigned& nx) {
    const unsigned G = gridDim.x * gridDim.y * gridDim.z;
    unsigned sum, cnt, mine, sp = 0u;
    for (;;) {
        sum = 0u; cnt = 0u; mine = 0u;
#pragma unroll
        for (unsigned j = 0; j < 16; ++j) { const unsigned c = xb_ld(&bar[XB_XCNT(j)]); sum += c; cnt += (c > 0u) ? 1u : 0u; mine = (j == x) ? c : mine; }
        if (sum == G) break;
        __builtin_amdgcn_s_sleep(1);
        if ((++sp & 255u) == 0u) { if (xb_ld(&bar[XB_TMO])) break; if (sp > XB_SPIN_CAP) { atomicAdd(&bar[XB_TMO], 1u); break; } }
    }
    nloc = mine > 0u ? mine : 1u; nx = cnt > 0u ? cnt : 1u;
}

__device__ __forceinline__ void xcd_barrier(const XcdBarrier& b) {
    asm volatile("s_waitcnt vmcnt(0)" ::: "memory");
    __syncthreads();
    if (threadIdx.x == 0) {
        unsigned* bar = b.bar;
        __builtin_amdgcn_s_waitcnt(0);
        unsigned nloc = b.st[0], nx = b.st[1];
        if (nloc == 0u) { xcd_barrier_complete(bar, b.x, nloc, nx); b.st[0] = nloc; b.st[1] = nx; }
        const unsigned old = xb_add(&bar[XB_XSUB(b.x)], 1u);
        const unsigned gen = old / nloc;
        if (old + 1u == (gen + 1u) * nloc) {
            __builtin_amdgcn_fence(__ATOMIC_RELEASE, "agent");
            asm volatile("s_waitcnt vmcnt(0)" ::: "memory");
            const unsigned og = xb_add(&bar[XB_TOP], 1u);
            const unsigned tg = og / nx;
            if (og + 1u == (tg + 1u) * nx) xb_add(&bar[XB_TOPGEN], 1u);
            else XB_SPIN(xb_ld(&bar[XB_TOPGEN]) == tg, bar);
            __builtin_amdgcn_fence(__ATOMIC_ACQUIRE, "agent");
            xb_add(&bar[XB_XGEN(b.x)], 1u);
            asm volatile("s_waitcnt vmcnt(0)" ::: "memory");
        } else {
            XB_SPIN(xb_ld(&bar[XB_XGEN(b.x)]) == gen, bar);
            __builtin_amdgcn_fence(__ATOMIC_ACQUIRE, "agent");
            asm volatile("s_waitcnt vmcnt(0)" ::: "memory");
        }
    }
    __syncthreads();
}

__device__ __forceinline__ void norm_pass(const bf16* QKV, unsigned* tab, int gw, int NGW, int lane) {
    for (int c = gw; c < MROWS / 32; c += NGW) {
        const int r0 = c * 32, b = r0 / SEQL; float mx[4] = {0.f, 0.f, 0.f, 0.f};
#pragma unroll 4
        for (int i = 0; i < 32; ++i) { const GAS v4u* p = (const GAS v4u*)(QKV + (size_t)(r0 + i) * NQKV) + lane;
#pragma unroll
            for (int j = 0; j < 4; ++j) { const v4u w = p[64 * j]; float ss = 0.f; const unsigned ww[4] = {w.x, w.y, w.z, w.w};
#pragma unroll
                for (int k = 0; k < 4; ++k) { const float lo = __uint_as_float(ww[k] << 16), hi = __uint_as_float(ww[k] & 0xffff0000u); ss += lo * lo + hi * hi; }
                ss += __shfl_xor(ss, 1); ss += __shfl_xor(ss, 2); ss += __shfl_xor(ss, 4); mx[j] = fmaxf(mx[j], ss); } }
        if ((lane & 7) == 0) {
#pragma unroll
            for (int j = 0; j < 4; ++j) atomicMax(tab + b * 32 + j * 8 + (lane >> 3), __float_as_uint(mx[j])); }
    }
}

__global__ void __launch_bounds__(NWAVES * 64, 2) mk_fwd(Args args) {
    extern __shared__ __attribute__((aligned(16))) unsigned char lds[];
    cg::grid_group grid = cg::this_grid();
    LAS unsigned char* L = (LAS unsigned char*)lds;
    const int wave = __builtin_amdgcn_readfirstlane((int)threadIdx.x >> 6);
#define lane ({ int t_ = threadIdx.x; asm volatile("" : "+v"(t_)); t_ & 63; })
    const int G = gridDim.x, bx = blockIdx.x, vcu = (G % 8 == 0) ? (bx % 8) * (G / 8) + bx / 8 : bx;
    const int gw = vcu * NWAVES + wave, NGW = G * NWAVES;
    unsigned char* ws = args.ws;
    unsigned char* XL = ws + WS_XL; bf16* Y = (bf16*)(ws + WS_Z); bf16* XB = (bf16*)(ws + WS_XB); bf16* H = (bf16*)(ws + WS_H);
#define GEMM_SWIGLU(f) do { pg8::Gemm g_{XB, (const bf16*)(ws + WS_WIN + (f) * WIN_BYTES), MROWS, 2 * DFF, DMODEL, DMODEL, DMODEL, 0}; pg8::StaticOrder S_; S_.init(MROWS, 2 * DFF, G, bx); \
        pg8::EpiSwiglu E_{H, DFF}; pg8::gemm_phase<pg8::EpiSwiglu, pg8::StaticOrder, PG8_ALIGN, PG8_SP2>(L, g_, S_, E_); } while (0)
#define GEMM_DOWN(f) do { pg8::Gemm g_{H, (const bf16*)(ws + WS_WOUT + (f) * WOUT_BYTES), MROWS, DMODEL, DFF, DFF, DFF, 0}; pg8::StaticOrder S_; S_.init(MROWS, DMODEL, G, bx, 1); \
        pg8::EpiScaleBf16 E_{Y, nullptr, 0.5f}; pg8::gemm_phase<pg8::EpiScaleBf16, pg8::StaticOrder, PG8_ALIGN, PG8_SP2>(L, g_, S_, E_); } while (0)
#define FFN(f, ig, ib, INF, OUTF) do { GEMM_SWIGLU(f); SYNC(); GEMM_DOWN(f); SYNC(); ln_pass<4, INF, OUTF>(args.in[0], Y, args.in[ig], args.in[ib], args.out, XB, XL, gw, NGW, lane); SYNC(); } while (0)

    unsigned* ctl = (unsigned*)ws;
    volatile LAS unsigned* bst = (volatile LAS unsigned*)(L + 141 * 1024);
    if (threadIdx.x < 2) bst[threadIdx.x] = 0u;
    if (bx == 0) for (int i = threadIdx.x; i < 8192; i += NWAVES * 64) ctl[i] = 0u;
    prologue(args, L, gw, NGW, wave, lane);
    __syncthreads(); grid.sync();
    const XcdBarrier xbar = xcd_barrier_post(ctl + 4096, bst);
#define SYNC() xcd_barrier(xbar)
    FFN(0, 3, 4, true, false);
    pool_diff_pass(XB, XL, H, gw, NGW, lane); SYNC();
    { pg8::Gemm g_{H, (const bf16*)(ws + WS_PW), MROWS, DMODEL, 256, DMODEL, 256, 512}; pg8::StaticOrder S_; S_.init(MROWS, DMODEL, G, bx);
      pg8::EpiScaleBf16 E_{Y, args.in[6], 0.f}; pg8::gemm_phase<pg8::EpiScaleBf16, pg8::StaticOrder, PG8_ALIGN, PG8_SP2>(L, g_, S_, E_); }
    SYNC(); ln_pass<4, false, false>(nullptr, Y, args.in[7], args.in[8], nullptr, XB, XL, gw, NGW, lane); SYNC();
    FFN(1, 11, 12, false, false);
    FFN(2, 15, 16, false, false);
    { pg8::Gemm g_{XB, (const bf16*)(ws + WS_WQKV), MROWS, NQKV, DMODEL, DMODEL, DMODEL, 0}; pg8::StaticOrder S_; S_.init(MROWS, NQKV, G, bx);
      pg8::EpiBf16<0> E_{H, NQKV, nullptr, 1024, 1024, attn_body::C2}; pg8::gemm_phase<pg8::EpiBf16<0>, pg8::StaticOrder, PG8_ALIGN, PG8_SP2>(L, g_, S_, E_); }
    SYNC();
    norm_pass(H, ctl, gw, NGW, lane); SYNC();
    attn_body::attn_phase<8>((char*)lds, (const attn_body::bf16*)H, (attn_body::bf16*)Y, ctl);
    SYNC();
    attn_combine_pass((const bf16*)Y, args.in[18], args.in[19], args.in[20], args.in[21], args.in[22], H, gw, NGW, lane);
    SYNC();
    { pg8::Gemm g_{H, (const bf16*)(ws + WS_WO), MROWS, DMODEL, DMODEL, DMODEL, DMODEL, 0}; pg8::StaticOrder S_; S_.init(MROWS, DMODEL, G, bx);
      pg8::EpiScaleBf16 E_{Y, nullptr, 1.0f}; pg8::gemm_phase<pg8::EpiScaleBf16, pg8::StaticOrder, PG8_ALIGN, PG8_SP2>(L, g_, S_, E_); }
    SYNC(); ln_pass<4, false, false>(nullptr, Y, args.in[24], args.in[25], nullptr, XB, XL, gw, NGW, lane); SYNC();
    FFN(3, 28, 29, false, true);
#undef lane
}

extern "C" void kernel_launch(void* const* d_in, const int* in_sizes, int n_in, void* d_out, int out_size, void* d_ws, size_t ws_size, hipStream_t stream) {
    static int grid = 0;
    if (grid == 0) {
        if (n_in != 30 || in_sizes[0] != MROWS * DMODEL || out_size != MROWS * DMODEL || ws_size < WS_END) { fprintf(stderr, "kernel_launch: unexpected shapes: n_in %d in0 %d out %d ws %zu\n", n_in, n_in > 0 ? in_sizes[0] : -1, out_size, ws_size); grid = -1; return; }
        int dev = 0, cus = 0, per_cu = 0;
        hipGetDevice(&dev); hipDeviceGetAttribute(&cus, hipDeviceAttributeMultiprocessorCount, dev);
        if (hipFuncSetAttribute((const void*)mk_fwd, hipFuncAttributeMaxDynamicSharedMemorySize, LDS_BYTES) != hipSuccess) { fprintf(stderr, "kernel_launch: hipFuncSetAttribute failed\n"); grid = -1; return; }
        if (hipOccupancyMaxActiveBlocksPerMultiprocessor(&per_cu, (const void*)mk_fwd, NWAVES * 64, LDS_BYTES) != hipSuccess || per_cu < 1) { fprintf(stderr, "kernel_launch: occupancy query says %d blocks per CU\n", per_cu); per_cu = 1; }
        (void)hipGetLastError();
        grid = cus * per_cu;
    }
    if (grid < 0) return;
    Args a{};
    for (int i = 0; i < 30; ++i) a.in[i] = (const float*)d_in[i];
    a.out = (float*)d_out; a.ws = (unsigned char*)d_ws;
    void* kargs[] = {&a};
    hipError_t e = hipLaunchCooperativeKernel((const void*)mk_fwd, dim3(grid), dim3(NWAVES * 64), kargs, LDS_BYTES, stream);
    if (e != hipSuccess) fprintf(stderr, "cooperative launch failed: %s (grid %d)\n", hipGetErrorString(e), grid);
}
```

```cpp
#include <hip/hip_runtime.h>
#include <hip/hip_cooperative_groups.h>
#include <cstdio>
#include <cstdint>
namespace cg = cooperative_groups;
namespace pg8 {
#define PG8_LAS __attribute__((address_space(3)))
typedef unsigned short bf16_t;
typedef short bf16x8 __attribute__((ext_vector_type(8)));
typedef float f32x4 __attribute__((ext_vector_type(4)));
typedef unsigned u32x4 __attribute__((ext_vector_type(4)));
constexpr int BM = 256, BK = 64, HALF = 128, HTB = HALF * BK * 2  , STAGE_BYTES = 8 * HTB, NXCD = 8, WGM = 8;

__host__ __device__ __forceinline__ int lds_byte(int r, int c) { const int st = (r >> 4) * 2 + (c >> 5), rr = r & 15, cc = c & 31, ob = rr * 64 + cc * 2; return st * 1024 + (ob ^ (((ob >> 9) & 1) << 5)); }
__host__ __device__ __forceinline__ void stage_rc(int b, int& R, int& C) { const int st = b / 1024, sb = b % 1024, swz = sb ^ (((sb >> 9) & 1) << 5); R = (st >> 1) * 16 + swz / 64; C = (st & 1) * 32 + (swz % 64) / 2; }
__host__ __device__ __forceinline__ int perm32(int rho) { const int n = rho >> 4, i = rho & 15; return 8 * (i >> 2) + 4 * n + (i & 3); }

struct Unit { int pm, pn; };
struct Gemm { const bf16_t* A; const bf16_t* Bt; int M, N, K, lda, ldb, apn; };

struct StaticOrder {
    int nM, nN, nwg, G, c, rev;
    __host__ __device__ void init(int M, int N, int G_, int c_, int rev_ = 0) { nM = M / BM; nN = N / BM; nwg = nM * nN; G = G_; c = c_; rev = rev_; }
    __host__ __device__ bool next(int i, Unit& u) const {
        const long L = (long)i * G + c; if (L >= nwg) return false;
        int wgid = rev ? nwg - 1 - (int)L : (int)L; { const int q = nwg / NXCD, r = nwg % NXCD, xcd = wgid % NXCD, off = wgid / NXCD; wgid = (xcd < r ? xcd * (q + 1) : r * (q + 1) + (xcd - r) * q) + off; }
        const int nig = WGM * nN, gid = wgid / nig, fm = gid * WGM, gsz = (nM - fm) < WGM ? (nM - fm) : WGM;
        u.pm = fm + ((wgid % nig) % gsz); u.pn = (wgid % nig) / gsz; return true;
    }
    __device__ __forceinline__ void a_ready(const Unit&) const {}
    __device__ __forceinline__ void done(const Unit&) const {}
};

__device__ __forceinline__ unsigned cvt_pk_bf16(float lo, float hi) { unsigned r; asm volatile("v_cvt_pk_bf16_f32 %0, %1, %2" : "=v"(r) : "v"(lo), "v"(hi)); return r; }
typedef float f32x2 __attribute__((ext_vector_type(2)));
__device__ __forceinline__ f32x2 gelu_pk(f32x2 v) {
    const f32x2 av = __builtin_elementwise_abs(v), d = av * 0.2316418882f + 1.0f;
    f32x2 t; t.x = __builtin_amdgcn_rcpf(d.x); t.y = __builtin_amdgcn_rcpf(d.y);
    f32x2 q = t * 0.5307027145f + (-0.7265760135f); q = q * t + 0.7107068705f; q = q * t + (-0.142248368f); q = q * t + 0.127414796f; q = q * t;
    const f32x2 s = (v * v) * (-0.72134752044f);
    f32x2 e; e.x = __builtin_amdgcn_exp2f(s.x); e.y = __builtin_amdgcn_exp2f(s.y);
    const f32x2 m = v * (q * e), r = v - m;
    f32x2 o; o.x = v.x < 0.f ? m.x : r.x; o.y = v.y < 0.f ? m.y : r.y; return o;
}

template <int ACT  > struct EpiBf16 {
    static constexpr bool PERM = true, AFTER_DRAIN = false; static_assert(ACT == 0 || ACT == 1, "EpiBf16: ACT is 0 (none) or 1 (gelu_pk)");
    bf16_t* O; int ldc; const float* bias; int split_cols; size_t split_stride; float scale0;
    __device__ __forceinline__ void operator()(const f32x4 (&acc)[2][2][4][2], const Unit& u, int wr, int wc, int fr, int fq) const {
        const int row0 = u.pm * BM + wr * 64 + fr; int colt = u.pn * BM; bf16_t* base = O;
        float sc = 1.f; if (split_cols) { const int t = colt / split_cols; base += (size_t)t * split_stride; colt -= t * split_cols; if (t == 0) sc = scale0; }
        const int col0 = colt + wc * 32 + 8 * fq, bcol0 = u.pn * BM + wc * 32 + 8 * fq;
        f32x4 bv[2][2];
#pragma unroll
        for (int bj = 0; bj < 2; ++bj)
#pragma unroll
            for (int n = 0; n < 2; ++n) bv[bj][n] = bias ? *(const f32x4*)(bias + bcol0 + bj * HALF + 4 * n) : (f32x4){0.f, 0.f, 0.f, 0.f};
#pragma unroll
        for (int ai = 0; ai < 2; ++ai)
#pragma unroll
            for (int m = 0; m < 4; ++m) { bf16_t* rowp = base + (size_t)(row0 + ai * HALF + m * 16) * ldc + col0;
#pragma unroll
                for (int bj = 0; bj < 2; ++bj) { f32x4 v0 = acc[ai][bj][m][0] + bv[bj][0], v1 = acc[ai][bj][m][1] + bv[bj][1];
                    if (ACT == 1) { f32x2 a = gelu_pk((f32x2){v0[0], v0[1]}), b = gelu_pk((f32x2){v0[2], v0[3]}), c = gelu_pk((f32x2){v1[0], v1[1]}), d = gelu_pk((f32x2){v1[2], v1[3]});
                        v0 = (f32x4){a.x, a.y, b.x, b.y}; v1 = (f32x4){c.x, c.y, d.x, d.y}; }
                    v0 = v0 * sc; v1 = v1 * sc; u32x4 w; w.x = cvt_pk_bf16(v0[0], v0[1]); w.y = cvt_pk_bf16(v0[2], v0[3]); w.z = cvt_pk_bf16(v1[0], v1[1]); w.w = cvt_pk_bf16(v1[2], v1[3]);
                    *(u32x4*)(rowp + bj * HALF) = w; } }
    }
};
template <class Epi, class Sched, bool ALIGN_EPI = false, bool SP2 = false>
__device__ __forceinline__ void gemm_phase(PG8_LAS unsigned char* lds, const Gemm g, const Sched& S, const Epi& E) {
    int tid_ = threadIdx.x; asm volatile("" : "+v"(tid_));
    const int tid = tid_, wid = __builtin_amdgcn_readfirstlane(tid >> 6), lane = tid & 63, wr = wid >> 2, wc = wid & 3, fr = lane & 15, fq = lane >> 4;
    const int K = g.K, nt = K / BK;
    unsigned voffA[2], voffB[2];
#pragma unroll
    for (int i = 0; i < 2; ++i) { int R, C; stage_rc(tid * 16 + i * 8192, R, C); const int Rb = Epi::PERM ? ((R & ~31) + perm32(R & 31)) : R;
        voffA[i] = (unsigned)(R * g.lda + C) * 2u; voffB[i] = (unsigned)(Rb * g.ldb + C) * 2u; }
    const size_t kstep = (size_t)(BK * 2);
    const size_t hstepA = (size_t)HALF * g.lda * 2, hstepB = (size_t)HALF * g.ldb * 2;
    const size_t tstepA = 2 * hstepA, tstepB = 2 * hstepB;
    const unsigned ldsw = (unsigned)wid * 1024u;
    const int aoff = lds_byte(wr * 64 + fr, fq * 8), boff = lds_byte(wc * 32 + fr, fq * 8);
#define PG8_SA(b, h) (((b) * 2 + (h)) * HTB)
#define PG8_SB(b, h) ((4 + (b) * 2 + (h)) * HTB)
#define PG8_STAGE(bufoff, gbase, voff) do { _Pragma("unroll") for (int _i = 0; _i < 2; ++_i) \
        __builtin_amdgcn_global_load_lds((const unsigned*)((const char*)(gbase) + (voff)[_i]), (PG8_LAS unsigned*)(lds + (bufoff) + ldsw + _i * 8192), 16, 0, 0); } while (0)
#define PG8_LDA(dst, b, h) do { _Pragma("unroll") for (int m = 0; m < 4; ++m) _Pragma("unroll") for (int k = 0; k < 2; ++k) dst[m][k] = *(const PG8_LAS bf16x8*)(lds + PG8_SA(b, h) + aoff + m * 2048 + k * 1024); } while (0)
#define PG8_LDB(dst, b, h) do { _Pragma("unroll") for (int n = 0; n < 2; ++n) _Pragma("unroll") for (int k = 0; k < 2; ++k) dst[n][k] = *(const PG8_LAS bf16x8*)(lds + PG8_SB(b, h) + boff + n * 2048 + k * 1024); } while (0)
#define PG8_MMA(ai, bj, At, Bt) do { __builtin_amdgcn_s_setprio(1); _Pragma("unroll") for (int m = 0; m < 4; ++m) _Pragma("unroll") for (int n = 0; n < 2; ++n) _Pragma("unroll") for (int k = 0; k < 2; ++k) \
        acc[ai][bj][m][n] = __builtin_amdgcn_mfma_f32_16x16x32_bf16(Bt[n][k], At[m][k], acc[ai][bj][m][n], 0, 0, 0); __builtin_amdgcn_s_setprio(0); } while (0)
#define PG8_WAIT_V(n) asm volatile("s_waitcnt vmcnt(" #n ")" ::: "memory")
#define PG8_WAIT_L(n) asm volatile("s_waitcnt lgkmcnt(" #n ")" ::: "memory")
#define PG8_BAR __builtin_amdgcn_s_barrier()
#define PG8_SCHED __builtin_amdgcn_sched_barrier(0)
    Unit cur, nxt; int ui = 0;
    if (!S.next(0, cur)) return;
    f32x4 acc[2][2][4][2];
#pragma unroll
    for (int a = 0; a < 2; ++a)
#pragma unroll
        for (int b = 0; b < 2; ++b)
#pragma unroll
            for (int m = 0; m < 4; ++m)
#pragma unroll
                for (int n = 0; n < 2; ++n) acc[a][b][m][n] = (f32x4){0.f, 0.f, 0.f, 0.f};
    bf16x8 At[4][2], B0[2][2], B1[2][2];
    const char* cA = (const char*)g.A + (size_t)cur.pm * tstepA + (size_t)cur.pn * g.apn; const char* cB = (const char*)g.Bt + (size_t)cur.pn * tstepB;
    S.a_ready(cur);
    if constexpr (SP2) {
        PG8_STAGE(PG8_SB(0, 0), cB, voffB); PG8_STAGE(PG8_SB(0, 1), cB + hstepB, voffB); PG8_STAGE(PG8_SA(0, 0), cA, voffA); PG8_STAGE(PG8_SA(0, 1), cA + hstepA, voffA);
        if (wr == 1) PG8_BAR;
        PG8_WAIT_V(2); PG8_BAR;
        PG8_STAGE(PG8_SB(1, 0), cB + kstep, voffB); PG8_STAGE(PG8_SA(1, 0), cA + kstep, voffA); PG8_STAGE(PG8_SB(1, 1), cB + hstepB + kstep, voffB);
        PG8_WAIT_V(6); PG8_BAR;
    } else {
        PG8_STAGE(PG8_SB(0, 0), cB, voffB); PG8_STAGE(PG8_SA(0, 0), cA, voffA); PG8_STAGE(PG8_SB(0, 1), cB + hstepB, voffB); PG8_STAGE(PG8_SA(0, 1), cA + hstepA, voffA);
        if (wr == 1) PG8_BAR;
        PG8_WAIT_V(4); PG8_BAR;
        PG8_STAGE(PG8_SB(1, 0), cB + kstep, voffB); PG8_STAGE(PG8_SA(1, 0), cA + kstep, voffA); PG8_STAGE(PG8_SB(1, 1), cB + hstepB + kstep, voffB);
        PG8_WAIT_V(6); PG8_BAR;
    }
    for (;;) {
        const bool has_next = S.next(ui + 1, nxt);
        const char* nA = has_next ? (const char*)g.A + (size_t)nxt.pm * tstepA + (size_t)nxt.pn * g.apn : cA; const char* nB = has_next ? (const char*)g.Bt + (size_t)nxt.pn * tstepB : cB;
        for (int t = 0; t < nt; t += 2) {
            const bool last = (t == nt - 2);
            const char* a1 = cA + (size_t)(t + 1) * kstep;
            const char* a2 = last ? nA : cA + (size_t)(t + 2) * kstep; const char* b2 = last ? nB : cB + (size_t)(t + 2) * kstep;
            const char* a3 = a2 + kstep; const char* b3 = b2 + kstep;
            if (last && has_next) S.a_ready(nxt);
            if constexpr (SP2) {
            PG8_LDB(B0, 0, 0); PG8_LDB(B1, 0, 1); PG8_SCHED; PG8_LDA(At, 0, 0); PG8_STAGE(PG8_SA(1, 1), a1 + hstepA, voffA);
            PG8_WAIT_V(8); PG8_WAIT_L(0); PG8_BAR; PG8_MMA(0, 0, At, B0); PG8_MMA(0, 1, At, B1); PG8_BAR; PG8_SCHED;
            PG8_LDA(At, 0, 1); PG8_STAGE(PG8_SB(0, 0), b2, voffB); PG8_STAGE(PG8_SB(0, 1), b2 + hstepB, voffB); PG8_STAGE(PG8_SA(0, 0), a2, voffA);
            PG8_WAIT_V(8); PG8_WAIT_L(0); PG8_BAR; PG8_MMA(1, 0, At, B0); PG8_MMA(1, 1, At, B1); PG8_BAR; PG8_SCHED;
            PG8_LDB(B0, 1, 0); PG8_LDB(B1, 1, 1); PG8_SCHED; PG8_LDA(At, 1, 0); PG8_STAGE(PG8_SA(0, 1), a2 + hstepA, voffA);
            PG8_WAIT_V(8); PG8_WAIT_L(0); PG8_BAR; PG8_MMA(0, 0, At, B0); PG8_MMA(0, 1, At, B1); PG8_BAR; PG8_SCHED;
            PG8_LDA(At, 1, 1); PG8_STAGE(PG8_SB(1, 0), b3, voffB); PG8_STAGE(PG8_SB(1, 1), b3 + hstepB, voffB); PG8_STAGE(PG8_SA(1, 0), a3, voffA);
            PG8_WAIT_V(8); PG8_WAIT_L(0); PG8_BAR; PG8_MMA(1, 0, At, B0); PG8_MMA(1, 1, At, B1); PG8_BAR; PG8_SCHED;
            } else {
            PG8_LDB(B0, 0, 0); PG8_SCHED; PG8_LDA(At, 0, 0); PG8_STAGE(PG8_SA(1, 1), a1 + hstepA, voffA);
            PG8_WAIT_L(8); PG8_BAR; PG8_WAIT_L(0); PG8_MMA(0, 0, At, B0); PG8_BAR; PG8_SCHED;
            PG8_LDB(B1, 0, 1); PG8_STAGE(PG8_SB(0, 0), b2, voffB);
            PG8_BAR; PG8_WAIT_L(0); PG8_MMA(0, 1, At, B1); PG8_BAR;
            PG8_LDA(At, 0, 1); PG8_STAGE(PG8_SA(0, 0), a2, voffA);
            PG8_BAR; PG8_WAIT_L(0); PG8_MMA(1, 0, At, B0); PG8_BAR; PG8_SCHED;
            PG8_STAGE(PG8_SB(0, 1), b2 + hstepB, voffB);
            PG8_WAIT_V(6); PG8_BAR; PG8_MMA(1, 1, At, B1); PG8_BAR;
            PG8_LDB(B0, 1, 0); PG8_SCHED; PG8_LDA(At, 1, 0); PG8_STAGE(PG8_SA(0, 1), a2 + hstepA, voffA);
            PG8_WAIT_L(8); PG8_BAR; PG8_WAIT_L(0); PG8_MMA(0, 0, At, B0); PG8_BAR; PG8_SCHED;
            PG8_LDB(B1, 1, 1); PG8_STAGE(PG8_SB(1, 0), b3, voffB);
            PG8_BAR; PG8_WAIT_L(0); PG8_MMA(0, 1, At, B1); PG8_BAR;
            PG8_LDA(At, 1, 1); PG8_STAGE(PG8_SA(1, 0), a3, voffA);
            PG8_BAR; PG8_WAIT_L(0); PG8_MMA(1, 0, At, B0); PG8_BAR; PG8_SCHED;
            PG8_STAGE(PG8_SB(1, 1), b3 + hstepB, voffB);
            PG8_WAIT_V(6); PG8_BAR; PG8_MMA(1, 1, At, B1); PG8_BAR;
            }
        }
        if constexpr (ALIGN_EPI) { if (wr == 0) PG8_BAR; }
        if constexpr (!Epi::AFTER_DRAIN) { E(acc, cur, wr, wc, fr, fq); S.done(cur); }
        if (!has_next) break;
#pragma unroll
        for (int a = 0; a < 2; ++a)
#pragma unroll
            for (int b = 0; b < 2; ++b)
#pragma unroll
                for (int m = 0; m < 4; ++m)
#pragma unroll
                    for (int n = 0; n < 2; ++n) acc[a][b][m][n] = (f32x4){0.f, 0.f, 0.f, 0.f};
        cur = nxt; cA = nA; cB = nB; ++ui;
        if constexpr (ALIGN_EPI) { if (wr == 1) PG8_BAR; }
    }
    PG8_WAIT_V(0);
    if constexpr (!ALIGN_EPI) { if (wr == 0) PG8_BAR; }
    PG8_BAR;
    if constexpr (Epi::AFTER_DRAIN) { E.fused(acc, cur, wr, wc, fr, fq, lds, wid, lane); S.done(cur); }
#undef PG8_SA
#undef PG8_SB
#undef PG8_STAGE
#undef PG8_LDA
#undef PG8_LDB
#undef PG8_MMA
#undef PG8_WAIT_V
#undef PG8_WAIT_L
#undef PG8_BAR
#undef PG8_SCHED
}
}
namespace pg8 {
struct EpiSwiglu {
    static constexpr bool PERM = true, AFTER_DRAIN = false;
    bf16_t* H; int ldh;
    __device__ __forceinline__ void operator()(const f32x4 (&acc)[2][2][4][2], const Unit& u, int wr, int wc, int fr, int fq) const {
        const int row0 = u.pm * BM + wr * 64 + fr, col0 = u.pn * HALF + wc * 32 + 8 * fq;
#pragma unroll
        for (int ai = 0; ai < 2; ++ai)
#pragma unroll
            for (int m = 0; m < 4; ++m) { bf16_t* rowp = H + (size_t)(row0 + ai * HALF + m * 16) * ldh + col0;
                float hv[8];
#pragma unroll
                for (int n = 0; n < 2; ++n)
#pragma unroll
                    for (int i = 0; i < 4; ++i) { const float g = acc[ai][0][m][n][i], up = acc[ai][1][m][n][i];
                        const float e = __builtin_amdgcn_exp2f(g * -1.4426950408889634f); hv[n * 4 + i] = g * __builtin_amdgcn_rcpf(1.0f + e) * up; }
                u32x4 w; w.x = cvt_pk_bf16(hv[0], hv[1]); w.y = cvt_pk_bf16(hv[2], hv[3]); w.z = cvt_pk_bf16(hv[4], hv[5]); w.w = cvt_pk_bf16(hv[6], hv[7]);
                *(u32x4*)rowp = w; }
    }
};
struct EpiScaleBf16 {
    static constexpr bool PERM = true, AFTER_DRAIN = false;
    bf16_t* Y; const float* cscale; float cs;
    __device__ __forceinline__ void operator()(const f32x4 (&acc)[2][2][4][2], const Unit& u, int wr, int wc, int fr, int fq) const {
        const int row0 = u.pm * BM + wr * 64 + fr, col0 = u.pn * BM + wc * 32 + 8 * fq;
        f32x4 sc[2][2];
#pragma unroll
        for (int bj = 0; bj < 2; ++bj)
#pragma unroll
            for (int n = 0; n < 2; ++n) sc[bj][n] = cscale ? *(const f32x4*)(cscale + col0 + bj * HALF + 4 * n) : (f32x4){cs, cs, cs, cs};
#pragma unroll
        for (int ai = 0; ai < 2; ++ai)
#pragma unroll
            for (int m = 0; m < 4; ++m) { bf16_t* rowp = Y + (size_t)(row0 + ai * HALF + m * 16) * 1024 + col0;
#pragma unroll
                for (int bj = 0; bj < 2; ++bj) { const f32x4 v0 = acc[ai][bj][m][0] * sc[bj][0], v1 = acc[ai][bj][m][1] * sc[bj][1];
                    u32x4 w; w.x = cvt_pk_bf16(v0[0], v0[1]); w.y = cvt_pk_bf16(v0[2], v0[3]); w.z = cvt_pk_bf16(v1[0], v1[1]); w.w = cvt_pk_bf16(v1[2], v1[3]);
                    *(u32x4*)(rowp + bj * HALF) = w; } }
    }
};
}
#define PG8_SP2 true
#define PG8_ALIGN true
#include <hip/hip_bf16.h>
#include <cmath>
#include <hip/hip_bf16.h>
#include <cmath>
namespace attn_body {
using bf16=__hip_bfloat16;
using bf16x8=__attribute__((ext_vector_type(8)))short;
using s16x4=__attribute__((ext_vector_type(4)))short;
using f32x16=__attribute__((ext_vector_type(16)))float;
using u32x4=__attribute__((ext_vector_type(4)))unsigned;
constexpr int SEQ=8192,D=64,PQ=3072,PO=2048;
constexpr int NW=8,QBLK=32,QB=QBLK*NW,KVBLK=64,NQB=SEQ/QB;
constexpr int ATTN_UNIT_ROWS=QB;
__device__ __forceinline__ int crow(int r,int hi){return (r&3)+8*(r>>2)+4*hi;}
#define SBAR() __builtin_amdgcn_sched_barrier(0)
__device__ __forceinline__ void cmask(f32x16&p0,f32x16&p1,int jb,int qrel,int hi){
  const float NEG=-INFINITY; int kb=64*jb+4*hi;
  #pragma unroll
  for(int r=0;r<16;++r){int kv=kb+(r&3)+8*(r>>2); if(kv>qrel)p0[r]=NEG; if(kv+32>qrel)p1[r]=NEG;}
}

constexpr int NSLOT=3, SLOTB=8192;
constexpr int LDS_K=0, LDS_V=NSLOT*SLOTB, LDS_WS=3*NSLOT*SLOTB, LDS_OST=LDS_WS+NW*64*4, LDS_BYTES=LDS_OST+NW*8192;
constexpr float C2=0.125f*1.4426950408889634f;
__device__ __forceinline__ void glds16(const void*gsrc,unsigned lds_dst){unsigned keep;
  asm volatile("s_mov_b32 %0, m0\n\ts_mov_b32 m0, %2\n\ts_nop 0\n\tglobal_load_lds_dwordx4 %1, off\n\ts_mov_b32 m0, %0":"=&s"(keep):"v"(gsrc),"s"(lds_dst):"memory");}
template<int IMM> __device__ __forceinline__ void glds16s(const void*sbase,unsigned voff,unsigned lds_dst){unsigned keep;
  asm volatile("s_mov_b32 %0, m0\n\ts_mov_b32 m0, %3\n\ts_nop 0\n\tglobal_load_lds_dwordx4 %1, %2 offset:%c4\n\ts_mov_b32 m0, %0":"=&s"(keep):"v"(voff),"s"(sbase),"s"(lds_dst),"i"(IMM):"memory");}
__device__ __forceinline__ float max3f(float a,float b,float c){float r;asm("v_max3_f32 %0, %1, %2, %3":"=v"(r):"v"(a),"v"(b),"v"(c));return r;}
__device__ __forceinline__ float max2f(float a,float b){float r;asm("v_max_f32_e32 %0, %1, %2":"=v"(r):"v"(a),"v"(b));return r;}
__device__ __forceinline__ float fadd_s(float a,float b){float r;asm("v_add_f32_e32 %0, %1, %2":"=v"(r):"v"(a),"v"(b));return r;}
__device__ __forceinline__ float fsub_s(float a,float b){float r;asm("v_sub_f32_e32 %0, %1, %2":"=v"(r):"v"(a),"v"(b));return r;}
typedef float f32x2_t __attribute__((ext_vector_type(2))); typedef __bf16 bf16x2_t __attribute__((ext_vector_type(2)));
__device__ __forceinline__ unsigned cvtpk_s(float lo,float hi){f32x2_t v={lo,hi};bf16x2_t b=__builtin_convertvector(v,bf16x2_t);return __builtin_bit_cast(unsigned,b);}
#define WAIT_BAR(N) asm volatile("s_waitcnt vmcnt(" #N ") lgkmcnt(0)\n\ts_barrier":::"memory")

__device__ __forceinline__ void qkt(f32x16&p0,f32x16&p1,const char*Kslot,const bf16x8*qr,const f32x16&negm,int r32,int hi){
  const char*kb=Kslot+hi*1024+r32*16;
  #pragma unroll
  for(int d0=0;d0<4;++d0){
    const bf16x8 b0=*reinterpret_cast<const bf16x8*>(kb+d0*2048);
    const bf16x8 b1=*reinterpret_cast<const bf16x8*>(kb+d0*2048+512);
    if(d0==0){p0=__builtin_amdgcn_mfma_f32_32x32x16_bf16(b0,qr[0],negm,0,0,0);p1=__builtin_amdgcn_mfma_f32_32x32x16_bf16(b1,qr[0],negm,0,0,0);}
    else{p0=__builtin_amdgcn_mfma_f32_32x32x16_bf16(b0,qr[d0],p0,0,0,0);p1=__builtin_amdgcn_mfma_f32_32x32x16_bf16(b1,qr[d0],p1,0,0,0);}}
}
typedef __attribute__((address_space(3))) const char* lds_cptr;
typedef short v4i16_t __attribute__((ext_vector_type(4)));
__device__ __forceinline__ void kload8(bf16x8*kf,lds_cptr kp){
  kf[0]=*(const __attribute__((address_space(3))) bf16x8*)(kp);      kf[1]=*(const __attribute__((address_space(3))) bf16x8*)(kp+512);
  kf[2]=*(const __attribute__((address_space(3))) bf16x8*)(kp+2048); kf[3]=*(const __attribute__((address_space(3))) bf16x8*)(kp+2560);
  kf[4]=*(const __attribute__((address_space(3))) bf16x8*)(kp+4096); kf[5]=*(const __attribute__((address_space(3))) bf16x8*)(kp+4608);
  kf[6]=*(const __attribute__((address_space(3))) bf16x8*)(kp+6144); kf[7]=*(const __attribute__((address_space(3))) bf16x8*)(kp+6656);
}
__device__ __forceinline__ void kload2(bf16x8*kf,lds_cptr kp,int j){ kf[2*j]=*(const __attribute__((address_space(3))) bf16x8*)(kp+j*2048); kf[2*j+1]=*(const __attribute__((address_space(3))) bf16x8*)(kp+j*2048+512); }
__device__ __forceinline__ s16x4 vtr(lds_cptr p){ return __builtin_bit_cast(s16x4,__builtin_amdgcn_ds_read_tr16_b64_v4i16((__attribute__((address_space(3))) v4i16_t*)p)); }
__device__ __forceinline__ float rowmax(const f32x16&p0,const f32x16&p1){
  float a=max3f(p0[0],p0[1],p1[0]),b=max3f(p0[2],p0[3],p1[1]);a=max3f(a,p1[2],p1[3]);
  #pragma unroll
  for(int r=4;r<16;r+=4){a=max3f(a,p0[r],p0[r+1]);b=max3f(b,p0[r+2],p0[r+3]);a=max3f(a,p1[r],p1[r+1]);b=max3f(b,p1[r+2],p1[r+3]);}
  const float m=max2f(a,b);
  auto rr=__builtin_amdgcn_permlane32_swap(__float_as_uint(m),__float_as_uint(m),false,false);
  return max2f(__uint_as_float(rr[0]),__uint_as_float(rr[1]));
}
__device__ __forceinline__ void pv(f32x16*o,int vb,bf16x8 pa0,bf16x8 pa1,bf16x8 pa2,bf16x8 pa3){
  #pragma unroll
  for(int d0=0;d0<4;++d0){s16x4 lo[4],hi[4];
    #pragma unroll
    for(int ks=0;ks<4;++ks){
      asm volatile("ds_read_b64_tr_b16 %0,%1 offset:%c2":"=&v"(lo[ks]):"v"(vb),"i"(d0*4096+ks*1024):"memory");
      asm volatile("ds_read_b64_tr_b16 %0,%1 offset:%c2":"=&v"(hi[ks]):"v"(vb),"i"(d0*4096+ks*1024+512):"memory");}
    asm volatile("s_waitcnt lgkmcnt(0)":::"memory");SBAR();
    #define PK(k) (bf16x8){lo[k][0],lo[k][1],lo[k][2],lo[k][3],hi[k][0],hi[k][1],hi[k][2],hi[k][3]}
    o[d0]=__builtin_amdgcn_mfma_f32_32x32x16_bf16(pa0,PK(0),o[d0],0,0,0);
    o[d0]=__builtin_amdgcn_mfma_f32_32x32x16_bf16(pa1,PK(1),o[d0],0,0,0);
    o[d0]=__builtin_amdgcn_mfma_f32_32x32x16_bf16(pa2,PK(2),o[d0],0,0,0);
    o[d0]=__builtin_amdgcn_mfma_f32_32x32x16_bf16(pa3,PK(3),o[d0],0,0,0);
    #undef PK
  }
}

#ifndef ATTN_STORE16
#define ATTN_STORE16(p,v) (*(u32x4*)(p)=(v))
#endif
template<int THRL> __device__ __forceinline__ void attn_unit(long rowbase,int qb,const bf16*Q,const bf16*__restrict__ K,const bf16*__restrict__ V,bf16*O,float sl,int T0,char*shm){
  int tid_=threadIdx.x; asm volatile("":"+v"(tid_)); const int tid=tid_,lane=tid&63,r32=lane&31,hi=lane>>5; const int wid=__builtin_amdgcn_readfirstlane(tid>>6);
  const int q0=qb*QB; const float sl64=64.f*sl, sl32=32.f*sl;
  const bf16*Qw=Q+(rowbase+q0+wid*QBLK)*PQ;
  const bf16*Kh=K+(rowbase+(long)T0*KVBLK)*PQ,*Vh=V+(rowbase+(long)T0*KVBLK)*PQ;
  const unsigned lds0=(unsigned)(uintptr_t)shm;
  float*wsf=(float*)(shm+LDS_WS)+wid*64;
  const unsigned koff=(unsigned)(lane*PQ+wid*8)*2u, voff=(unsigned)((16*(wid&3)+(lane>>2))*PQ+(wid>>2)*32+(lane&3)*8)*2u;
  const unsigned kdst=lds0+LDS_K+wid*1024, vdst=lds0+LDS_V+wid*1024;
  #define DMA_K(t,slot) glds16s<0>(Kh+(long)(t)*KVBLK*PQ,koff,(unsigned)__builtin_amdgcn_readfirstlane(kdst+(slot)))
  #define DMA_V(t,slot) do{ glds16s<0>(Vh+(long)(t)*KVBLK*PQ,voff,(unsigned)__builtin_amdgcn_readfirstlane(vdst+2*(slot))); glds16s<0>(Vh+(long)(t)*KVBLK*PQ+64,voff,(unsigned)__builtin_amdgcn_readfirstlane(vdst+2*(slot)+8192)); }while(0)
  const int vb0=(int)(lds0+LDS_V)+((lane>>4)&1)*32+(lane&3)*8+(4*hi+((lane&15)>>2))*64;
  const char*Kbase=shm+LDS_K; bf16x8 kf[8];
  const lds_cptr shm3=(lds_cptr)shm; const lds_cptr kp0=shm3+LDS_K+hi*1024+r32*16; const lds_cptr vp0=shm3+LDS_V+((lane>>4)&1)*32+(lane&3)*8+(4*hi+((lane&15)>>2))*64;
  const int NT=(q0+QB)/KVBLK-T0;
  DMA_K(0,0);DMA_V(0,0);DMA_K(1,SLOTB);
  bf16x8 qr[4];
  #pragma unroll
  for(int d0=0;d0<4;++d0)qr[d0]=*reinterpret_cast<const bf16x8*>(&Qw[(long)r32*PQ+d0*16+hi*8]);
  typedef __attribute__((address_space(3))) bf16x8* lds_q8; const lds_q8 qpark=(lds_q8)((__attribute__((address_space(3))) char*)shm+LDS_OST+wid*8192+lane*16);
  #pragma unroll
  for(int d0=0;d0<4;++d0)qpark[d0*64]=qr[d0];
  #define QLD(d0) (qpark[(d0)*64])
  float mhat=0.f,l_reg=0.f;f32x16 o[4];o[0]=f32x16{};o[1]=f32x16{};o[2]=f32x16{};o[3]=f32x16{};const int qrel=wid*QBLK+r32;
  f32x16 negm;
  #pragma unroll
  for(int r=0;r<16;++r)negm[r]=sl*(float)(T0*KVBLK+crow(r,hi)-(q0+qrel));
  asm volatile("":"+v"(negm));
  #define CMASK(P0,P1,t) do{int jb_=(t)-(NT-4); if(jb_>=0)cmask(P0,P1,jb_,qrel,hi);}while(0)
  bool resc=false;
  #define START(P0,P1) do{ const float rm=rowmax(P0,P1); resc=false; \
    { const float dl=rm; mhat=fadd_s(mhat,dl); \
      _Pragma("unroll") for(int r=0;r<16;++r){P0[r]=fsub_s(P0[r],dl);P1[r]=fsub_s(P1[r],dl);} \
      { const float adj_=sl64-dl; _Pragma("unroll") for(int r=0;r<16;++r)negm[r]+=adj_; } asm volatile("":"+v"(negm)); } \
    _Pragma("unroll") for(int r=0;r<16;++r)P0[r]=__builtin_amdgcn_exp2f(P0[r]); }while(0)
  #define RESC() do{ if(resc){ asm volatile("s_waitcnt lgkmcnt(0)":::"memory"); \
      _Pragma("unroll") for(int d_=0;d_<4;++d_) _Pragma("unroll") for(int r=0;r<16;++r)o[d_][r]*=wsf[crow(r,hi)]; } }while(0)
  f32x16 pA0,pA1,pB0,pB1;
  int sl_prev=0,sl_cur=0,sl_next=SLOTB;
  #define ROT() do{sl_prev=sl_cur;sl_cur=sl_next;sl_next=(sl_next==(NSLOT-1)*SLOTB)?0:sl_next+SLOTB;}while(0)
  DMA_K(2,2*SLOTB);
  WAIT_BAR(3);
  qkt(pA0,pA1,Kbase,qr,negm,r32,hi);asm volatile("s_nop 15\n\ts_nop 7":"+v"(pA0),"+v"(pA1));
  _Pragma("unroll") for(int r=0;r<16;++r)pA1[r]+=sl32;
  CMASK(pA0,pA1,0);
  START(pA0,pA1);
  _Pragma("unroll") for(int r=0;r<16;++r)pA1[r]=__builtin_amdgcn_exp2f(pA1[r]);
  WAIT_BAR(0);
  DMA_K(3,0);DMA_V(1,SLOTB);
  ROT();
  kload8(kf,kp0+sl_cur);
  WAIT_BAR(3);
  s16x4 vlo[8],vhi[8]; u32x4 pw0,pw1,pw2,pw3;
  #define PKW(P,B) cvtpk_s(P[B],P[B+1])
  #define PAF(k) __builtin_bit_cast(bf16x8,pw##k)
  #define VFR(i) (bf16x8){vlo[i][0],vlo[i][1],vlo[i][2],vlo[i][3],vhi[i][0],vhi[i][1],vhi[i][2],vhi[i][3]}
  #define PIN(x) asm volatile("":"+v"(x))
  #define MX3(a,b,c) __builtin_fmaxf(__builtin_fmaxf((a),(b)),(c))
  #define GAPA(MF,A0,A1,A2,A3,W0,W1,PW) do{ MF; sacc+=A0; sacc+=A1; sacc+=A2; sacc+=A3; PIN(sacc); W0; W1; PIN(PW); SBAR(); }while(0)
  #define EX(v) __builtin_amdgcn_exp2f(v)
  #define GAPB2(MF,X,B) do{ MF; X[B]=EX(X[B]); X[B+1]=EX(X[B+1]); PIN(X); SBAR(); }while(0)
  #define VRD(i) do{ vlo[i]=vtr(vp_+(((i)>>2)*4096+((i)&3)*1024)); vhi[i]=vtr(vp_+(((i)>>2)*4096+((i)&3)*1024+512)); }while(0)
  #define VRD2(i) do{ vlo[i]=vtr(vp_+((2+((i)>>2))*4096+((i)&3)*1024)); vhi[i]=vtr(vp_+((2+((i)>>2))*4096+((i)&3)*1024+512)); }while(0)
  #define KRD(G,j) do{ if(G){ kload2(kf,kp0+sl_next,j); SBAR(); } }while(0)
  #define STEP(C0,C1,P0,P1,t,GK,GV,GL) do{ SBAR(); \
    const lds_cptr vp_=vp0+2*sl_prev; \
    const bf16x8 q0_=QLD(0),q1_=QLD(1); \
    VRD(0); SBAR(); float sacc=(P0[0]+P0[1]); \
    GAPA(C0=__builtin_amdgcn_mfma_f32_32x32x16_bf16(kf[0],q0_,negm,0,0,0), P0[2],P0[3],P0[4],P0[5],     pw0[0]=PKW(P0,0), pw0[1]=PKW(P0,2), pw0); \
    VRD(4); SBAR(); GAPA(C1=__builtin_amdgcn_mfma_f32_32x32x16_bf16(kf[1],q0_,negm,0,0,0), P0[6],P0[7],P0[8],P0[9],     pw0[2]=PKW(P0,4), pw0[3]=PKW(P0,6), pw0); \
    const bf16x8 q2_=QLD(2); VRD(1); SBAR(); GAPA(C0=__builtin_amdgcn_mfma_f32_32x32x16_bf16(kf[2],q1_,C0,0,0,0),   P0[10],P0[11],P0[12],P0[13], pw1[0]=PKW(P0,8), pw1[1]=PKW(P0,10), pw1); \
    VRD(5); SBAR(); GAPA(C1=__builtin_amdgcn_mfma_f32_32x32x16_bf16(kf[3],q1_,C1,0,0,0),   P0[14],P0[15],P1[0],P1[1],   pw1[2]=PKW(P0,12),pw1[3]=PKW(P0,14), pw1); \
    const bf16x8 q3_=QLD(3); VRD(2); SBAR(); GAPA(C0=__builtin_amdgcn_mfma_f32_32x32x16_bf16(kf[4],q2_,C0,0,0,0),   P1[2],P1[3],P1[4],P1[5],     pw2[0]=PKW(P1,0), pw2[1]=PKW(P1,2), pw2); \
    VRD(6); SBAR(); GAPA(C1=__builtin_amdgcn_mfma_f32_32x32x16_bf16(kf[5],q2_,C1,0,0,0),   P1[6],P1[7],P1[8],P1[9],     pw2[2]=PKW(P1,4), pw2[3]=PKW(P1,6), pw2); \
    VRD(3); SBAR(); GAPA(C0=__builtin_amdgcn_mfma_f32_32x32x16_bf16(kf[6],q3_,C0,0,0,0),   P1[10],P1[11],P1[12],P1[13], pw3[0]=PKW(P1,8), pw3[1]=PKW(P1,10), pw3); \
    VRD(7); SBAR(); GAPA(C1=__builtin_amdgcn_mfma_f32_32x32x16_bf16(kf[7],q3_,C1,0,0,0),   P1[14],P1[15],0.f,0.f,       pw3[2]=PKW(P1,12),pw3[3]=PKW(P1,14), pw3); \
    l_reg+=sacc; \
    if(GK){DMA_K((t)+3,sl_cur);} if(GV){DMA_V((t)+1,sl_next);} \
    _Pragma("unroll") for(int r=0;r<16;++r)C1[r]+=sl32; \
    CMASK(C0,C1,t); \
    { float a=MX3(C0[0],C0[1],C1[0]),b=MX3(C0[2],C0[3],C1[1]); a=MX3(a,C1[2],C1[3]); \
      _Pragma("unroll") for(int r=4;r<16;r+=4){a=MX3(a,C0[r],C0[r+1]);b=MX3(b,C0[r+2],C0[r+3]);a=MX3(a,C1[r],C1[r+1]);b=MX3(b,C1[r+2],C1[r+3]);} \
      float rm=__builtin_fmaxf(a,b); { auto rr=__builtin_amdgcn_permlane32_swap(__float_as_uint(rm),__float_as_uint(rm),false,false); rm=__builtin_fmaxf(__uint_as_float(rr[0]),__uint_as_float(rr[1])); } \
      resc=false; float adj_=sl64; \
      if(__builtin_expect(__any(rm>(float)THRL),0)){ const float dl=__builtin_fmaxf(rm,0.f); mhat+=dl; adj_-=dl; \
        _Pragma("unroll") for(int r=0;r<16;++r){C0[r]-=dl;C1[r]-=dl;} \
        const float f=__builtin_amdgcn_exp2f(-dl); l_reg*=f; if(hi==0)wsf[r32]=f; resc=true; } \
      _Pragma("unroll") for(int r=0;r<16;++r)negm[r]+=adj_; asm volatile("":"+v"(negm)); } \
    SBAR(); \
    GAPB2(o[0]=__builtin_amdgcn_mfma_f32_32x32x16_bf16(PAF(0),VFR(0),o[0],0,0,0), C0,0); VRD2(0); SBAR(); \
    GAPB2(o[1]=__builtin_amdgcn_mfma_f32_32x32x16_bf16(PAF(0),VFR(4),o[1],0,0,0), C0,2); VRD2(4); SBAR(); \
    KRD(GL,0); GAPB2(o[0]=__builtin_amdgcn_mfma_f32_32x32x16_bf16(PAF(1),VFR(1),o[0],0,0,0), C0,4); VRD2(1); SBAR(); \
    KRD(GL,1); GAPB2(o[1]=__builtin_amdgcn_mfma_f32_32x32x16_bf16(PAF(1),VFR(5),o[1],0,0,0), C0,6); VRD2(5); SBAR(); \
    KRD(GL,2); GAPB2(o[0]=__builtin_amdgcn_mfma_f32_32x32x16_bf16(PAF(2),VFR(2),o[0],0,0,0), C0,8); VRD2(2); SBAR(); \
    KRD(GL,3); GAPB2(o[1]=__builtin_amdgcn_mfma_f32_32x32x16_bf16(PAF(2),VFR(6),o[1],0,0,0), C0,10); VRD2(6); SBAR(); \
    GAPB2(o[0]=__builtin_amdgcn_mfma_f32_32x32x16_bf16(PAF(3),VFR(3),o[0],0,0,0), C0,12); VRD2(3); SBAR(); \
    GAPB2(o[1]=__builtin_amdgcn_mfma_f32_32x32x16_bf16(PAF(3),VFR(7),o[1],0,0,0), C0,14); VRD2(7); SBAR(); \
    GAPB2(o[2]=__builtin_amdgcn_mfma_f32_32x32x16_bf16(PAF(0),VFR(0),o[2],0,0,0), C1,0); \
    GAPB2(o[3]=__builtin_amdgcn_mfma_f32_32x32x16_bf16(PAF(0),VFR(4),o[3],0,0,0), C1,2); \
    GAPB2(o[2]=__builtin_amdgcn_mfma_f32_32x32x16_bf16(PAF(1),VFR(1),o[2],0,0,0), C1,4); \
    GAPB2(o[3]=__builtin_amdgcn_mfma_f32_32x32x16_bf16(PAF(1),VFR(5),o[3],0,0,0), C1,6); \
    GAPB2(o[2]=__builtin_amdgcn_mfma_f32_32x32x16_bf16(PAF(2),VFR(2),o[2],0,0,0), C1,8); \
    GAPB2(o[3]=__builtin_amdgcn_mfma_f32_32x32x16_bf16(PAF(2),VFR(6),o[3],0,0,0), C1,10); \
    GAPB2(o[2]=__builtin_amdgcn_mfma_f32_32x32x16_bf16(PAF(3),VFR(3),o[2],0,0,0), C1,12); \
    GAPB2(o[3]=__builtin_amdgcn_mfma_f32_32x32x16_bf16(PAF(3),VFR(7),o[3],0,0,0), C1,14); \
    }while(0)
  int t=1;
  #undef CMASK
  #define CMASK(P0,P1,t) do{}while(0)
  for(;t+5<NT;t+=2){
    STEP(pB0,pB1,pA0,pA1,t,true,true,true);     WAIT_BAR(3); RESC(); ROT();
    STEP(pA0,pA1,pB0,pB1,t+1,true,true,true);   WAIT_BAR(3); RESC(); ROT();
  }
  #undef CMASK
  #define CMASK(P0,P1,t) do{int jb_=(t)-(NT-4); if(jb_>=0)cmask(P0,P1,jb_,qrel,hi);}while(0)
  #define ENDW(tt) do{ if((tt)+3<NT){WAIT_BAR(3);} else if((tt)+2<NT){WAIT_BAR(2);} else {WAIT_BAR(0);} }while(0)
  for(;t+1<NT;t+=2){
    STEP(pB0,pB1,pA0,pA1,t,(t+3<NT),(t+1<NT),(t+1<NT));       ENDW(t);   RESC(); ROT();
    STEP(pA0,pA1,pB0,pB1,t+1,(t+4<NT),(t+2<NT),(t+2<NT));     ENDW(t+1); RESC(); ROT();
  }
  STEP(pB0,pB1,pA0,pA1,NT-1,false,false,false); RESC();
  { float sacc=pB0[0]+pB0[1]; _Pragma("unroll") for(int r=2;r<16;++r)sacc+=pB0[r]; _Pragma("unroll") for(int r=0;r<16;++r)sacc+=pB1[r]; l_reg+=sacc;
    pw0=(u32x4){PKW(pB0,0),PKW(pB0,2),PKW(pB0,4),PKW(pB0,6)};pw1=(u32x4){PKW(pB0,8),PKW(pB0,10),PKW(pB0,12),PKW(pB0,14)};pw2=(u32x4){PKW(pB1,0),PKW(pB1,2),PKW(pB1,4),PKW(pB1,6)};pw3=(u32x4){PKW(pB1,8),PKW(pB1,10),PKW(pB1,12),PKW(pB1,14)};
    SBAR(); pv(o,vb0+2*sl_cur,PAF(0),PAF(1),PAF(2),PAF(3)); }
  #undef PKW
  #undef PAF
  #undef VFR
  #undef PIN
  #undef MX3
  #undef GAPA
  #undef GAPB2
  #undef VRD2
  #undef EX
  #undef VRD
  #undef KRD
  #undef STEP
  #undef ENDW
  {auto rr=__builtin_amdgcn_permlane32_swap(__float_as_uint(l_reg),__float_as_uint(l_reg),false,false);l_reg=__uint_as_float(rr[0])+__uint_as_float(rr[1]);}
  if(hi==0)wsf[32+r32]=l_reg;asm volatile("s_waitcnt lgkmcnt(0)":::"memory");
  float rli[16];
  #pragma unroll
  for(int r=0;r<16;++r)rli[r]=__builtin_amdgcn_rcpf(wsf[32+crow(r,hi)]);
  bf16*Ow=O+(rowbase+q0+wid*QBLK)*PO;
  { bf16*stg=(bf16*)(shm+LDS_OST)+wid*4096;
    #pragma unroll
    for(int r=0;r<16;++r){const int orow=crow(r,hi);
      #pragma unroll
      for(int d0=0;d0<4;++d0)stg[orow*128+d0*32+r32]=__float2bfloat16(o[d0][r]*rli[r]);}
    asm volatile("s_waitcnt lgkmcnt(0)":::"memory");
    #pragma unroll
    for(int i=0;i<8;++i){const int row=i*4+(lane>>4),ch=lane&15; const u32x4 v=*(const u32x4*)(stg+row*128+ch*8); ATTN_STORE16(Ow+(long)row*PO+ch*8,v);} }
  asm volatile("s_waitcnt lgkmcnt(0)\n\ts_barrier":::"memory");
  #undef QLD
  #undef DMA_K
  #undef DMA_V
  #undef CMASK
  #undef START
  #undef RESC
  #undef ROT
}
constexpr int ATTN_LDS_BYTES=LDS_BYTES;
template<int THRL=8> __device__ __forceinline__ void attn_phase(char*lds,const bf16*QKV,bf16*OP,unsigned*ctl){
  volatile __attribute__((address_space(3))) unsigned* qword=(volatile __attribute__((address_space(3))) unsigned*)(__attribute__((address_space(3))) char*)lds+(140*1024/4);
  const int x0=(int)(__builtin_amdgcn_s_getreg((3<<11)|20)&7u);
  for(int qi=0;qi<8;++qi){ const int b=(x0+qi)&7;
  for(;;){
    if(threadIdx.x==0){ const unsigned i=__hip_atomic_fetch_add(ctl+256+16*b,1u,__ATOMIC_RELAXED,__HIP_MEMORY_SCOPE_AGENT); *qword=i; }
    asm volatile("s_waitcnt lgkmcnt(0)\n\ts_barrier":::"memory");
    const int idx=__builtin_amdgcn_readfirstlane((int)*qword);
    asm volatile("s_waitcnt lgkmcnt(0)\n\ts_barrier":::"memory");
    if(idx>=16*NQB)break;
    const int grp=idx>>5,h=7-(grp>>1),mp=grp&1,qb=NQB-1-(idx&31);
    const float sl=__builtin_ldexpf(1.4426950408889634f,-(h+1));
    const float qn2=__uint_as_float(__hip_atomic_load(ctl+b*32+mp*8+h,__ATOMIC_RELAXED,__HIP_MEMORY_SCOPE_AGENT)),kn2=__uint_as_float(__hip_atomic_load(ctl+b*32+16+mp*8+h,__ATOMIC_RELAXED,__HIP_MEMORY_SCOPE_AGENT));
    const float thr=2.04f*sqrtf(qn2*kn2)+152.f, xs=(float)(qb*QB-63)-thr/sl;
    int T0=0; if(xs>=0.f){ T0=((int)(xs*(1.f/64.f))+1)&~1; if(T0>4*qb)T0=4*qb; }
    T0=__builtin_amdgcn_readfirstlane(T0);
    attn_unit<THRL>((long)b*SEQ,qb,QKV+mp*512+h*64,QKV+1024+mp*512+h*64,QKV+2048+h*128,OP+mp*1024+h*128,sl,T0,lds);
  } }
}
#undef SBAR
#undef WAIT_BAR
}
constexpr int NWAVES = 8;
constexpr int BATCH = 8, SEQL = 8192, DMODEL = 1024, DFF = 2816, NQKV = 3072;
constexpr int MROWS = BATCH * SEQL;
constexpr float LN_EPS = 1e-5f, RMS_EPS = 1e-5f;
constexpr float DN_ALPHA = 1.41421356237309515f;
constexpr float LAMBDA_INIT = 0.35550906759096927f;
constexpr size_t MiB = 1u << 20;
constexpr size_t WS_WIN = 2 * MiB, WIN_BYTES = 11 * MiB;
constexpr size_t WS_WOUT = 46 * MiB, WOUT_BYTES = 11 * MiB / 2;
constexpr size_t WS_WQKV = 68 * MiB, WS_WO = 74 * MiB, WS_PW = 76 * MiB;
constexpr size_t WS_Z = 80 * MiB;
constexpr size_t WS_XB = 336 * MiB;
constexpr size_t WS_H = 464 * MiB;
constexpr size_t WS_XL = 848 * MiB;
constexpr size_t WS_END = 912 * MiB;
constexpr int LDS_BYTES = 147456;
#define GAS __attribute__((address_space(1)))
#define LAS __attribute__((address_space(3)))
typedef unsigned short bf16;
typedef unsigned v4u __attribute__((ext_vector_type(4)));
typedef unsigned v2u __attribute__((ext_vector_type(2)));
typedef float f32x4 __attribute__((ext_vector_type(4)));
#define LDS_WAIT() asm volatile("s_waitcnt lgkmcnt(0)" ::: "memory")
__device__ __forceinline__ unsigned pk2(float lo, float hi) { return pg8::cvt_pk_bf16(lo, hi); }
__device__ __forceinline__ float wave_sum(float v) {
#pragma unroll
    for (int o = 1; o < 64; o <<= 1) v += __shfl_xor(v, o);
    return v;
}
__device__ __forceinline__ void p0_transpose_item(const float* W, int K, int N, bf16* WT, int mode, int row_off, LAS float* scr, int item, int lane) {
    const int nblk = N / 32, kb = item / nblk, nb = item % nblk, k0 = 64 * kb, n0 = 32 * nb;
    int r0 = row_off + n0;
    if (mode == 1) { const int j = n0 < DFF ? n0 : n0 - DFF; r0 = (j >> 7) * 256 + (j & 127) + (n0 < DFF ? 0 : 128); }
#pragma unroll 8
    for (int i = 0; i < 32; ++i) { const int kk = 2 * i + (lane >> 5); scr[kk * 33 + (lane & 31)] = W[(size_t)(k0 + kk) * N + n0 + (lane & 31)]; }
    LDS_WAIT(); asm volatile("" ::: "memory");
    const int c = lane & 7;
#pragma unroll
    for (int j = 0; j < 4; ++j) { const int n = (lane >> 3) + 8 * j; const LAS float* s = scr + (8 * c) * 33 + n;
        v4u o; o.x = pk2(s[0 * 33], s[1 * 33]); o.y = pk2(s[2 * 33], s[3 * 33]); o.z = pk2(s[4 * 33], s[5 * 33]); o.w = pk2(s[6 * 33], s[7 * 33]);
        *(GAS v4u*)(WT + (size_t)(r0 + n) * K + k0 + 8 * c) = o; }
    LDS_WAIT(); asm volatile("" ::: "memory");
}
struct Args { const float* in[30]; float* out; unsigned char* ws; };

__device__ __forceinline__ void prologue(const Args& a, LAS unsigned char* lds, int gw, int NGW, int wave, int lane) {
    LAS float* scr = (LAS float*)(lds + wave * 16384);
    unsigned char* ws = a.ws;
    constexpr int I_IN = (DMODEL / 64) * (2 * DFF / 32), I_OUT = (DFF / 64) * (DMODEL / 32), I_QKV = (DMODEL / 64) * (NQKV / 32), I_O = (DMODEL / 64) * (DMODEL / 32), I_P = (256 / 64) * (256 / 32);
    constexpr int NITEMS = 4 * I_IN + 4 * I_OUT + I_QKV + I_O + 4 * I_P;
    for (int it = gw; it < NITEMS; it += NGW) {
        int r = it;
        if (r < 4 * I_IN) { const int f = r / I_IN; const int idx = f == 0 ? 1 : f == 1 ? 9 : f == 2 ? 13 : 26;
            p0_transpose_item(a.in[idx], DMODEL, 2 * DFF, (bf16*)(ws + WS_WIN + f * WIN_BYTES), 1, 0, scr, r % I_IN, lane); continue; } r -= 4 * I_IN;
        if (r < 4 * I_OUT) { const int f = r / I_OUT; const int idx = f == 0 ? 2 : f == 1 ? 10 : f == 2 ? 14 : 27;
            p0_transpose_item(a.in[idx], DFF, DMODEL, (bf16*)(ws + WS_WOUT + f * WOUT_BYTES), 0, 0, scr, r % I_OUT, lane); continue; } r -= 4 * I_OUT;
        if (r < I_QKV) { p0_transpose_item(a.in[17], DMODEL, NQKV, (bf16*)(ws + WS_WQKV), 0, 0, scr, r, lane); continue; } r -= I_QKV;
        if (r < I_O) { p0_transpose_item(a.in[23], DMODEL, DMODEL, (bf16*)(ws + WS_WO), 0, 0, scr, r, lane); continue; } r -= I_O;
        { const int g = r / I_P; p0_transpose_item(a.in[5] + (size_t)g * 65536, 256, 256, (bf16*)(ws + WS_PW), 0, g * 256, scr, r % I_P, lane); }
    }
    const GAS f32x4* x4 = (const GAS f32x4*)a.in[0]; GAS v4u* xb = (GAS v4u*)(ws + WS_XB);
    const size_t n8 = (size_t)MROWS * DMODEL / 8, nthr = (size_t)NGW * 64;
#pragma unroll 4
    for (size_t i = (size_t)gw * 64 + lane; i < n8; i += nthr) { const f32x4 p = x4[2 * i], q = x4[2 * i + 1];
        v4u o; o.x = pk2(p.x, p.y); o.y = pk2(p.z, p.w); o.z = pk2(q.x, q.y); o.w = pk2(q.z, q.w); xb[i] = o; }
}
template <int R, bool IN_F32, bool OUT_F32> __device__ __forceinline__ void ln_pass(const float* xin, const bf16* Y, const float* g, const float* b, float* xout, bf16* XB, unsigned char* XL, int gw, int NGW, int lane) {
    f32x4 gv[4], bv[4];
#pragma unroll
    for (int j = 0; j < 4; ++j) { const int c4 = (j >> 1) * 128 + lane * 2 + (j & 1); gv[j] = ((const GAS f32x4*)g)[c4]; bv[j] = ((const GAS f32x4*)b)[c4]; }
    for (int m0 = gw * R; m0 < MROWS; m0 += NGW * R) {
        f32x4 v[R][4]; v4u yy[R][2]; float s[R], s2[R];
        if (IN_F32) {
#pragma unroll
            for (int r = 0; r < R; ++r) { const GAS f32x4* xr = (const GAS f32x4*)(xin + (size_t)(m0 + r) * DMODEL) + lane * 2; const GAS v4u* yr = (const GAS v4u*)(Y + (size_t)(m0 + r) * DMODEL) + lane;
                v[r][0] = xr[0]; v[r][1] = xr[1]; v[r][2] = xr[128]; v[r][3] = xr[129]; yy[r][0] = yr[0]; yy[r][1] = yr[64]; }
        } else {
            v4u hh[R][2]; v2u ll[R][2];
#pragma unroll
            for (int r = 0; r < R; ++r) { const GAS v4u* hr = (const GAS v4u*)(XB + (size_t)(m0 + r) * DMODEL) + lane; const GAS v2u* lr = (const GAS v2u*)(XL + (size_t)(m0 + r) * DMODEL) + lane; const GAS v4u* yr = (const GAS v4u*)(Y + (size_t)(m0 + r) * DMODEL) + lane;
                hh[r][0] = hr[0]; hh[r][1] = hr[64]; ll[r][0] = lr[0]; ll[r][1] = lr[64]; yy[r][0] = yr[0]; yy[r][1] = yr[64]; }
#pragma unroll
            for (int r = 0; r < R; ++r)
#pragma unroll
                for (int h = 0; h < 2; ++h) { const unsigned hw[4] = {hh[r][h].x, hh[r][h].y, hh[r][h].z, hh[r][h].w}; const int lw[2] = {(int)ll[r][h].x, (int)ll[r][h].y};
#pragma unroll
                    for (int q = 0; q < 2; ++q) { const float c = 1.0f / 512.0f;
                        v[r][2 * h + q] = (f32x4){__uint_as_float(hw[2 * q] << 16) + __builtin_amdgcn_cvt_f32_fp8(lw[q], 0) * c, __uint_as_float(hw[2 * q] & 0xffff0000u) + __builtin_amdgcn_cvt_f32_fp8(lw[q], 1) * c,
                                                  __uint_as_float(hw[2 * q + 1] << 16) + __builtin_amdgcn_cvt_f32_fp8(lw[q], 2) * c, __uint_as_float(hw[2 * q + 1] & 0xffff0000u) + __builtin_amdgcn_cvt_f32_fp8(lw[q], 3) * c}; } }
        }
#pragma unroll
        for (int r = 0; r < R; ++r) { const unsigned yw[8] = {yy[r][0].x, yy[r][0].y, yy[r][0].z, yy[r][0].w, yy[r][1].x, yy[r][1].y, yy[r][1].z, yy[r][1].w}; s[r] = 0.f;
#pragma unroll
            for (int j = 0; j < 4; ++j) { const f32x4 yv = (f32x4){__uint_as_float(yw[2 * j] << 16), __uint_as_float(yw[2 * j] & 0xffff0000u), __uint_as_float(yw[2 * j + 1] << 16), __uint_as_float(yw[2 * j + 1] & 0xffff0000u)};
                v[r][j] = v[r][j] * DN_ALPHA + yv; s[r] += (v[r][j].x + v[r][j].y) + (v[r][j].z + v[r][j].w); } }
#pragma unroll
        for (int o = 1; o < 64; o <<= 1)
#pragma unroll
            for (int r = 0; r < R; ++r) s[r] += __shfl_xor(s[r], o);
#pragma unroll
        for (int r = 0; r < R; ++r) { const float mean = s[r] * (1.f / DMODEL); s2[r] = 0.f;
#pragma unroll
            for (int j = 0; j < 4; ++j) { v[r][j] = v[r][j] - mean; s2[r] += (v[r][j].x * v[r][j].x + v[r][j].y * v[r][j].y) + (v[r][j].z * v[r][j].z + v[r][j].w * v[r][j].w); } }
#pragma unroll
        for (int o = 1; o < 64; o <<= 1)
#pragma unroll
            for (int r = 0; r < R; ++r) s2[r] += __shfl_xor(s2[r], o);
#pragma unroll
        for (int r = 0; r < R; ++r) { const float rstd = 1.f / sqrtf(s2[r] * (1.f / DMODEL) + LN_EPS);
#pragma unroll
            for (int j = 0; j < 4; ++j) v[r][j] = v[r][j] * rstd * gv[j] + bv[j];
            if (OUT_F32) { GAS f32x4* xo = (GAS f32x4*)(xout + (size_t)(m0 + r) * DMODEL) + lane * 2; xo[0] = v[r][0]; xo[1] = v[r][1]; xo[128] = v[r][2]; xo[129] = v[r][3]; }
            else { GAS v4u* o8 = (GAS v4u*)(XB + (size_t)(m0 + r) * DMODEL) + lane; GAS v2u* l8 = (GAS v2u*)(XL + (size_t)(m0 + r) * DMODEL) + lane;
#pragma unroll
                for (int h = 0; h < 2; ++h) { unsigned hw[4]; int lw[2];
#pragma unroll
                    for (int q = 0; q < 2; ++q) { const f32x4 x = v[r][2 * h + q]; hw[2 * q] = pk2(x.x, x.y); hw[2 * q + 1] = pk2(x.z, x.w);
                        const float l0 = (x.x - __uint_as_float(hw[2 * q] << 16)) * 512.f, l1 = (x.y - __uint_as_float(hw[2 * q] & 0xffff0000u)) * 512.f, l2 = (x.z - __uint_as_float(hw[2 * q + 1] << 16)) * 512.f, l3 = (x.w - __uint_as_float(hw[2 * q + 1] & 0xffff0000u)) * 512.f;
                        int p = __builtin_amdgcn_cvt_pk_fp8_f32(l0, l1, 0, false); lw[q] = __builtin_amdgcn_cvt_pk_fp8_f32(l2, l3, p, true); }
                    o8[64 * h] = (v4u){hw[0], hw[1], hw[2], hw[3]}; l8[64 * h] = (v2u){(unsigned)lw[0], (unsigned)lw[1]}; } }
        }
    }
}
__device__ __forceinline__ void pool_diff_pass(const bf16* XB, const unsigned char* XL, bf16* DB, int gw, int NGW, int lane) {
#define XLOAD(roff) ({ const v2u h_ = hc[(long)(roff) * 256]; const int l_ = (int)lc[(long)(roff) * 256]; const float c_ = 1.0f / 512.0f; \
        (f32x4){__uint_as_float(h_.x << 16) + __builtin_amdgcn_cvt_f32_fp8(l_, 0) * c_, __uint_as_float(h_.x & 0xffff0000u) + __builtin_amdgcn_cvt_f32_fp8(l_, 1) * c_, \
                __uint_as_float(h_.y << 16) + __builtin_amdgcn_cvt_f32_fp8(l_, 2) * c_, __uint_as_float(h_.y & 0xffff0000u) + __builtin_amdgcn_cvt_f32_fp8(l_, 3) * c_}; })
    for (int it = gw; it < (MROWS / 32) * 4; it += NGW) {
        const int g = it & 3, r0 = (it >> 2) * 32, t0 = r0 & (SEQL - 1), w = 2 << g;
        const GAS v2u* hc = (const GAS v2u*)(XB + (size_t)r0 * DMODEL + g * 256) + lane;
        const GAS unsigned* lc = (const GAS unsigned*)(XL + (size_t)r0 * DMODEL + g * 256) + lane;
        GAS v2u* dc = (GAS v2u*)(DB + (size_t)r0 * DMODEL + g * 256) + lane;
        f32x4 s = (f32x4){0.f, 0.f, 0.f, 0.f};
        if (t0 > 0) for (int i = 1; i <= w; ++i) s += XLOAD(-i);
        const float rw = 1.0f / (float)w;
        for (int j0 = 0; j0 < 32; j0 += 8) { f32x4 xv[8], xo[8];
#pragma unroll
            for (int k = 0; k < 8; ++k) { const int j = j0 + k, t = t0 + j; xv[k] = XLOAD(j); xo[k] = XLOAD(t >= w ? j - w : j); }
#pragma unroll
            for (int k = 0; k < 8; ++k) { const int j = j0 + k, t = t0 + j; s += xv[k]; if (t >= w) s -= xo[k];
                const float rc = t + 1 < w ? 1.0f / (float)(t + 1) : rw;
                const f32x4 d = s * rc - xv[k]; v2u o; o.x = pk2(d.x, d.y); o.y = pk2(d.z, d.w); dc[(long)j * 256] = o; } }
    }
#undef XLOAD
}
__device__ __forceinline__ void attn_combine_pass(const bf16* OP, const float* lq1, const float* lk1, const float* lq2, const float* lk2, const float* sg, bf16* OB, int gw, int NGW, int lane) {
    const float lam = __expf(wave_sum(lq1[lane] * lk1[lane])) - __expf(wave_sum(lq2[lane] * lk2[lane])) + LAMBDA_INIT;
    float gl[16];
#pragma unroll
    for (int i = 0; i < 16; ++i) gl[i] = sg[(lane & 7) * 16 + i] * (1.0f - LAMBDA_INIT);
    for (int m0 = gw * 4; m0 < MROWS; m0 += NGW * 4) {
        v4u A0[4], A1[4], B0[4], B1[4];
#pragma unroll
        for (int r = 0; r < 4; ++r) { const GAS v4u* p1 = (const GAS v4u*)(OP + (size_t)(m0 + r) * 2048) + lane * 2; const GAS v4u* p2 = p1 + 128; A0[r] = p1[0]; A1[r] = p1[1]; B0[r] = p2[0]; B1[r] = p2[1]; }
#pragma unroll
        for (int r = 0; r < 4; ++r) { const int m = m0 + r; const v4u a0 = A0[r], a1 = A1[r], b0 = B0[r], b1 = B1[r];
        unsigned aw[8] = {a0.x, a0.y, a0.z, a0.w, a1.x, a1.y, a1.z, a1.w}, bw[8] = {b0.x, b0.y, b0.z, b0.w, b1.x, b1.y, b1.z, b1.w};
        float o[16]; float ss = 0.f;
#pragma unroll
        for (int i = 0; i < 8; ++i) { const float x0 = __uint_as_float(aw[i] << 16), x1 = __uint_as_float(aw[i] & 0xffff0000u), y0 = __uint_as_float(bw[i] << 16), y1 = __uint_as_float(bw[i] & 0xffff0000u);
            o[2 * i] = x0 - lam * y0; o[2 * i + 1] = x1 - lam * y1; ss += o[2 * i] * o[2 * i] + o[2 * i + 1] * o[2 * i + 1]; }
        ss += __shfl_xor(ss, 1); ss += __shfl_xor(ss, 2); ss += __shfl_xor(ss, 4);
        const float rs = 1.0f / sqrtf(ss * (1.0f / 128.0f) + RMS_EPS);
        v4u w0, w1;
        w0.x = pk2(o[0] * rs * gl[0], o[1] * rs * gl[1]); w0.y = pk2(o[2] * rs * gl[2], o[3] * rs * gl[3]); w0.z = pk2(o[4] * rs * gl[4], o[5] * rs * gl[5]); w0.w = pk2(o[6] * rs * gl[6], o[7] * rs * gl[7]);
        w1.x = pk2(o[8] * rs * gl[8], o[9] * rs * gl[9]); w1.y = pk2(o[10] * rs * gl[10], o[11] * rs * gl[11]); w1.z = pk2(o[12] * rs * gl[12], o[13] * rs * gl[13]); w1.w = pk2(o[14] * rs * gl[14], o[15] * rs * gl[15]);
        GAS v4u* q = (GAS v4u*)(OB + (size_t)m * DMODEL) + lane * 2; q[0] = w0; q[1] = w1; }
    }
}

#define XB_TMO      128
#define XB_XCNT(j)  (256  + 64 * (j))
#define XB_XSUB(j)  (1280 + 64 * (j))
#define XB_XGEN(j)  (2304 + 64 * (j))
#define XB_TOP      3328
#define XB_TOPGEN   3392
#define XCD_BAR_WORDS 3456
#define XB_SPIN_CAP (1u << 18)

__device__ __forceinline__ unsigned xb_ld(unsigned* p)              { return __hip_atomic_load(p, __ATOMIC_RELAXED, __HIP_MEMORY_SCOPE_AGENT); }
__device__ __forceinline__ unsigned xb_add(unsigned* p, unsigned v) { return __hip_atomic_fetch_add(p, v, __ATOMIC_RELAXED, __HIP_MEMORY_SCOPE_AGENT); }
__device__ __forceinline__ unsigned xb_xcc_id() { return (unsigned)__builtin_amdgcn_s_getreg((3 << 11) | 20) & 0xFu; }
#define XB_SPIN(cond, bar) do { unsigned _sp = 0; while (cond) { __builtin_amdgcn_s_sleep(1); \
    if ((++_sp & 255u) == 0u) { if (xb_ld(&(bar)[XB_TMO])) break; if (_sp > XB_SPIN_CAP) { atomicAdd(&(bar)[XB_TMO], 1u); break; } } } } while (0)

struct XcdBarrier {
    unsigned* bar; unsigned x;
    volatile LAS unsigned* st;
};

__device__ __forceinline__ XcdBarrier xcd_barrier_post(unsigned* bar, volatile LAS unsigned* st) {
    XcdBarrier b; b.bar = bar; b.x = xb_xcc_id(); b.st = st;
    if (threadIdx.x == 0) (void)xb_add(&bar[XB_XCNT(b.x)], 1u);
    return b;
}
__device__ __forceinline__ void xcd_barrier_complete(unsigned* bar, unsigned x, unsigned& nloc, unsigned& nx) {
    const unsigned G = gridDim.x * gridDim.y * gridDim.z;
    unsigned sum, cnt, mine, sp = 0u;
    for (;;) {
        sum = 0u; cnt = 0u; mine = 0u;
#pragma unroll
        for (unsigned j = 0; j < 16; ++j) { const unsigned c = xb_ld(&bar[XB_XCNT(j)]); sum += c; cnt += (c > 0u) ? 1u : 0u; mine = (j == x) ? c : mine; }
        if (sum == G) break;
        __builtin_amdgcn_s_sleep(1);
        if ((++sp & 255u) == 0u) { if (xb_ld(&bar[XB_TMO])) break; if (sp > XB_SPIN_CAP) { atomicAdd(&bar[XB_TMO], 1u); break; } }
    }
    nloc = mine > 0u ? mine : 1u; nx = cnt > 0u ? cnt : 1u;
}

__device__ __forceinline__ void xcd_barrier(const XcdBarrier& b) {
    asm volatile("s_waitcnt vmcnt(0)" ::: "memory");
    __syncthreads();
    if (threadIdx.x == 0) {
        unsigned* bar = b.bar;
        __builtin_amdgcn_s_waitcnt(0);
        unsigned nloc = b.st[0], nx = b.st[1];
        if (nloc == 0u) { xcd_barrier_complete(bar, b.x, nloc, nx); b.st[0] = nloc; b.st[1] = nx; }
        const unsigned old = xb_add(&bar[XB_XSUB(b.x)], 1u);
        const unsigned gen = old / nloc;
        if (old + 1u == (gen + 1u) * nloc) {
            __builtin_amdgcn_fence(__ATOMIC_RELEASE, "agent");
            asm volatile("s_waitcnt vmcnt(0)" ::: "memory");
            const unsigned og = xb_add(&bar[XB_TOP], 1u);
            const unsigned tg = og / nx;
            if (og + 1u == (tg + 1u) * nx) xb_add(&bar[XB_TOPGEN], 1u);
            else XB_SPIN(xb_ld(&bar[XB_TOPGEN]) == tg, bar);
            __builtin_amdgcn_fence(__ATOMIC_ACQUIRE, "agent");
            xb_add(&bar[XB_XGEN(b.x)], 1u);
            asm volatile("s_waitcnt vmcnt(0)" ::: "memory");
        } else {
            XB_SPIN(xb_ld(&bar[XB_XGEN(b.x)]) == gen, bar);
            __builtin_amdgcn_fence(__ATOMIC_ACQUIRE, "agent");
            asm volatile("s_waitcnt vmcnt(0)" ::: "memory");
        }
    }
    __syncthreads();
}

__device__ __forceinline__ void norm_pass(const bf16* QKV, unsigned* tab, int gw, int NGW, int lane) {
    for (int c = gw; c < MROWS / 32; c += NGW) {
        const int r0 = c * 32, b = r0 / SEQL; float mx[4] = {0.f, 0.f, 0.f, 0.f};
#pragma unroll 4
        for (int i = 0; i < 32; ++i) { const GAS v4u* p = (const GAS v4u*)(QKV + (size_t)(r0 + i) * NQKV) + lane;
#pragma unroll
            for (int j = 0; j < 4; ++j) { const v4u w = p[64 * j]; float ss = 0.f; const unsigned ww[4] = {w.x, w.y, w.z, w.w};
#pragma unroll
                for (int k = 0; k < 4; ++k) { const float lo = __uint_as_float(ww[k] << 16), hi = __uint_as_float(ww[k] & 0xffff0000u); ss += lo * lo + hi * hi; }
                ss += __shfl_xor(ss, 1); ss += __shfl_xor(ss, 2); ss += __shfl_xor(ss, 4); mx[j] = fmaxf(mx[j], ss); } }
        if ((lane & 7) == 0) {
#pragma unroll
            for (int j = 0; j < 4; ++j) atomicMax(tab + b * 32 + j * 8 + (lane >> 3), __float_as_uint(mx[j])); }
    }
}

__global__ void __launch_bounds__(NWAVES * 64, 2) mk_fwd(Args args) {
    extern __shared__ __attribute__((aligned(16))) unsigned char lds[];
    cg::grid_group grid = cg::this_grid();
    LAS unsigned char* L = (LAS unsigned char*)lds;
    const int wave = __builtin_amdgcn_readfirstlane((int)threadIdx.x >> 6);
#define lane ({ int t_ = threadIdx.x; asm volatile("" : "+v"(t_)); t_ & 63; })
    const int G = gridDim.x, bx = blockIdx.x, vcu = (G % 8 == 0) ? (bx % 8) * (G / 8) + bx / 8 : bx;
    const int gw = vcu * NWAVES + wave, NGW = G * NWAVES;
    unsigned char* ws = args.ws;
    unsigned char* XL = ws + WS_XL; bf16* Y = (bf16*)(ws + WS_Z); bf16* XB = (bf16*)(ws + WS_XB); bf16* H = (bf16*)(ws + WS_H);
#define GEMM_SWIGLU(f) do { pg8::Gemm g_{XB, (const bf16*)(ws + WS_WIN + (f) * WIN_BYTES), MROWS, 2 * DFF, DMODEL, DMODEL, DMODEL, 0}; pg8::StaticOrder S_; S_.init(MROWS, 2 * DFF, G, bx); \
        pg8::EpiSwiglu E_{H, DFF}; pg8::gemm_phase<pg8::EpiSwiglu, pg8::StaticOrder, PG8_ALIGN, PG8_SP2>(L, g_, S_, E_); } while (0)
#define GEMM_DOWN(f) do { pg8::Gemm g_{H, (const bf16*)(ws + WS_WOUT + (f) * WOUT_BYTES), MROWS, DMODEL, DFF, DFF, DFF, 0}; pg8::StaticOrder S_; S_.init(MROWS, DMODEL, G, bx, 1); \
        pg8::EpiScaleBf16 E_{Y, nullptr, 0.5f}; pg8::gemm_phase<pg8::EpiScaleBf16, pg8::StaticOrder, PG8_ALIGN, PG8_SP2>(L, g_, S_, E_); } while (0)
#define FFN(f, ig, ib, INF, OUTF) do { GEMM_SWIGLU(f); SYNC(); GEMM_DOWN(f); SYNC(); ln_pass<4, INF, OUTF>(args.in[0], Y, args.in[ig], args.in[ib], args.out, XB, XL, gw, NGW, lane); SYNC(); } while (0)

    unsigned* ctl = (unsigned*)ws;
    volatile LAS unsigned* bst = (volatile LAS unsigned*)(L + 141 * 1024);
    if (threadIdx.x < 2) bst[threadIdx.x] = 0u;
    if (bx == 0) for (int i = threadIdx.x; i < 8192; i += NWAVES * 64) ctl[i] = 0u;
    prologue(args, L, gw, NGW, wave, lane);
    __syncthreads(); grid.sync();
    const XcdBarrier xbar = xcd_barrier_post(ctl + 4096, bst);
#define SYNC() xcd_barrier(xbar)
    FFN(0, 3, 4, true, false);
    pool_diff_pass(XB, XL, H, gw, NGW, lane); SYNC();
    { pg8::Gemm g_{H, (const bf16*)(ws + WS_PW), MROWS, DMODEL, 256, DMODEL, 256, 512}; pg8::StaticOrder S_; S_.init(MROWS, DMODEL, G, bx);
      pg8::EpiScaleBf16 E_{Y, args.in[6], 0.f}; pg8::gemm_phase<pg8::EpiScaleBf16, pg8::StaticOrder, PG8_ALIGN, PG8_SP2>(L, g_, S_, E_); }
    SYNC(); ln_pass<4, false, false>(nullptr, Y, args.in[7], args.in[8], nullptr, XB, XL, gw, NGW, lane); SYNC();
    FFN(1, 11, 12, false, false);
    FFN(2, 15, 16, false, false);
    { pg8::Gemm g_{XB, (const bf16*)(ws + WS_WQKV), MROWS, NQKV, DMODEL, DMODEL, DMODEL, 0}; pg8::StaticOrder S_; S_.init(MROWS, NQKV, G, bx);
      pg8::EpiBf16<0> E_{H, NQKV, nullptr, 1024, 1024, attn_body::C2}; pg8::gemm_phase<pg8::EpiBf16<0>, pg8::StaticOrder, PG8_ALIGN, PG8_SP2>(L, g_, S_, E_); }
    SYNC();
    norm_pass(H, ctl, gw, NGW, lane); SYNC();
    attn_body::attn_phase<16>((char*)lds, (const attn_body::bf16*)H, (attn_body::bf16*)Y, ctl);
    SYNC();
    attn_combine_pass((const bf16*)Y, args.in[18], args.in[19], args.in[20], args.in[21], args.in[22], H, gw, NGW, lane);
    SYNC();
    { pg8::Gemm g_{H, (const bf16*)(ws + WS_WO), MROWS, DMODEL, DMODEL, DMODEL, DMODEL, 0}; pg8::StaticOrder S_; S_.init(MROWS, DMODEL, G, bx);
      pg8::EpiScaleBf16 E_{Y, nullptr, 1.0f}; pg8::gemm_phase<pg8::EpiScaleBf16, pg8::StaticOrder, PG8_ALIGN, PG8_SP2>(L, g_, S_, E_); }
    SYNC(); ln_pass<4, false, false>(nullptr, Y, args.in[24], args.in[25], nullptr, XB, XL, gw, NGW, lane); SYNC();
    FFN(3, 28, 29, false, true);
#undef lane
}

extern "C" void kernel_launch(void* const* d_in, const int* in_sizes, int n_in, void* d_out, int out_size, void* d_ws, size_t ws_size, hipStream_t stream) {
    static int grid = 0;
    if (grid == 0) {
        if (n_in != 30 || in_sizes[0] != MROWS * DMODEL || out_size != MROWS * DMODEL || ws_size < WS_END) { fprintf(stderr, "kernel_launch: unexpected shapes: n_in %d in0 %d out %d ws %zu\n", n_in, n_in > 0 ? in_sizes[0] : -1, out_size, ws_size); grid = -1; return; }
        int dev = 0, cus = 0, per_cu = 0;
        hipGetDevice(&dev); hipDeviceGetAttribute(&cus, hipDeviceAttributeMultiprocessorCount, dev);
        if (hipFuncSetAttribute((const void*)mk_fwd, hipFuncAttributeMaxDynamicSharedMemorySize, LDS_BYTES) != hipSuccess) { fprintf(stderr, "kernel_launch: hipFuncSetAttribute failed\n"); grid = -1; return; }
        if (hipOccupancyMaxActiveBlocksPerMultiprocessor(&per_cu, (const void*)mk_fwd, NWAVES * 64, LDS_BYTES) != hipSuccess || per_cu < 1) { fprintf(stderr, "kernel_launch: occupancy query says %d blocks per CU\n", per_cu); per_cu = 1; }
        (void)hipGetLastError();
        grid = cus * per_cu;
    }
    if (grid < 0) return;
    Args a{};
    for (int i = 0; i < 30; ++i) a.in[i] = (const float*)d_in[i];
    a.out = (float*)d_out; a.ws = (unsigned char*)d_ws;
    void* kargs[] = {&a};
    hipError_t e = hipLaunchCooperativeKernel((const void*)mk_fwd, dim3(grid), dim3(NWAVES * 64), kargs, LDS_BYTES, stream);
    if (e != hipSuccess) fprintf(stderr, "cooperative launch failed: %s (grid %d)\n", hipGetErrorString(e), grid);
}
```

```cpp
#include <hip/hip_runtime.h>
#include <hip/hip_cooperative_groups.h>
#include <cstdio>
#include <cstdint>
namespace cg = cooperative_groups;
namespace pg8 {
#define PG8_LAS __attribute__((address_space(3)))
typedef unsigned short bf16_t;
typedef short bf16x8 __attribute__((ext_vector_type(8)));
typedef float f32x4 __attribute__((ext_vector_type(4)));
typedef unsigned u32x4 __attribute__((ext_vector_type(4)));
constexpr int BM = 256, BK = 64, HALF = 128, HTB = HALF * BK * 2  , STAGE_BYTES = 8 * HTB, NXCD = 8, WGM = 8;

__host__ __device__ __forceinline__ int lds_byte(int r, int c) { const int st = (r >> 4) * 2 + (c >> 5), rr = r & 15, cc = c & 31, ob = rr * 64 + cc * 2; return st * 1024 + (ob ^ (((ob >> 9) & 1) << 5)); }
__host__ __device__ __forceinline__ void stage_rc(int b, int& R, int& C) { const int st = b / 1024, sb = b % 1024, swz = sb ^ (((sb >> 9) & 1) << 5); R = (st >> 1) * 16 + swz / 64; C = (st & 1) * 32 + (swz % 64) / 2; }
__host__ __device__ __forceinline__ int perm32(int rho) { const int n = rho >> 4, i = rho & 15; return 8 * (i >> 2) + 4 * n + (i & 3); }

struct Unit { int pm, pn; };
struct Gemm { const bf16_t* A; const bf16_t* Bt; int M, N, K, lda, ldb, apn; };

struct StaticOrder {
    int nM, nN, nwg, G, c, rev;
    __host__ __device__ void init(int M, int N, int G_, int c_, int rev_ = 0) { nM = M / BM; nN = N / BM; nwg = nM * nN; G = G_; c = c_; rev = rev_; }
    __host__ __device__ bool next(int i, Unit& u) const {
        const long L = (long)i * G + c; if (L >= nwg) return false;
        int wgid = rev ? nwg - 1 - (int)L : (int)L; { const int q = nwg / NXCD, r = nwg % NXCD, xcd = wgid % NXCD, off = wgid / NXCD; wgid = (xcd < r ? xcd * (q + 1) : r * (q + 1) + (xcd - r) * q) + off; }
        const int nig = WGM * nN, gid = wgid / nig, fm = gid * WGM, gsz = (nM - fm) < WGM ? (nM - fm) : WGM;
        u.pm = fm + ((wgid % nig) % gsz); u.pn = (wgid % nig) / gsz; return true;
    }
    __device__ __forceinline__ void a_ready(const Unit&) const {}
    __device__ __forceinline__ void done(const Unit&) const {}
};

__device__ __forceinline__ unsigned cvt_pk_bf16(float lo, float hi) { unsigned r; asm volatile("v_cvt_pk_bf16_f32 %0, %1, %2" : "=v"(r) : "v"(lo), "v"(hi)); return r; }
typedef float f32x2 __attribute__((ext_vector_type(2)));
__device__ __forceinline__ f32x2 gelu_pk(f32x2 v) {
    const f32x2 av = __builtin_elementwise_abs(v), d = av * 0.2316418882f + 1.0f;
    f32x2 t; t.x = __builtin_amdgcn_rcpf(d.x); t.y = __builtin_amdgcn_rcpf(d.y);
    f32x2 q = t * 0.5307027145f + (-0.7265760135f); q = q * t + 0.7107068705f; q = q * t + (-0.142248368f); q = q * t + 0.127414796f; q = q * t;
    const f32x2 s = (v * v) * (-0.72134752044f);
    f32x2 e; e.x = __builtin_amdgcn_exp2f(s.x); e.y = __builtin_amdgcn_exp2f(s.y);
    const f32x2 m = v * (q * e), r = v - m;
    f32x2 o; o.x = v.x < 0.f ? m.x : r.x; o.y = v.y < 0.f ? m.y : r.y; return o;
}

template <int ACT  > struct EpiBf16 {
    static constexpr bool PERM = true, AFTER_DRAIN = false; static_assert(ACT == 0 || ACT == 1, "EpiBf16: ACT is 0 (none) or 1 (gelu_pk)");
    bf16_t* O; int ldc; const float* bias; int split_cols; size_t split_stride; float scale0;
    __device__ __forceinline__ void operator()(const f32x4 (&acc)[2][2][4][2], const Unit& u, int wr, int wc, int fr, int fq) const {
        const int row0 = u.pm * BM + wr * 64 + fr; int colt = u.pn * BM; bf16_t* base = O;
        float sc = 1.f; if (split_cols) { const int t = colt / split_cols; base += (size_t)t * split_stride; colt -= t * split_cols; if (t == 0) sc = scale0; }
        const int col0 = colt + wc * 32 + 8 * fq, bcol0 = u.pn * BM + wc * 32 + 8 * fq;
        f32x4 bv[2][2];
#pragma unroll
        for (int bj = 0; bj < 2; ++bj)
#pragma unroll
            for (int n = 0; n < 2; ++n) bv[bj][n] = bias ? *(const f32x4*)(bias + bcol0 + bj * HALF + 4 * n) : (f32x4){0.f, 0.f, 0.f, 0.f};
#pragma unroll
        for (int ai = 0; ai < 2; ++ai)
#pragma unroll
            for (int m = 0; m < 4; ++m) { bf16_t* rowp = base + (size_t)(row0 + ai * HALF + m * 16) * ldc + col0;
#pragma unroll
                for (int bj = 0; bj < 2; ++bj) { f32x4 v0 = acc[ai][bj][m][0] + bv[bj][0], v1 = acc[ai][bj][m][1] + bv[bj][1];
                    if (ACT == 1) { f32x2 a = gelu_pk((f32x2){v0[0], v0[1]}), b = gelu_pk((f32x2){v0[2], v0[3]}), c = gelu_pk((f32x2){v1[0], v1[1]}), d = gelu_pk((f32x2){v1[2], v1[3]});
                        v0 = (f32x4){a.x, a.y, b.x, b.y}; v1 = (f32x4){c.x, c.y, d.x, d.y}; }
                    v0 = v0 * sc; v1 = v1 * sc; u32x4 w; w.x = cvt_pk_bf16(v0[0], v0[1]); w.y = cvt_pk_bf16(v0[2], v0[3]); w.z = cvt_pk_bf16(v1[0], v1[1]); w.w = cvt_pk_bf16(v1[2], v1[3]);
                    *(u32x4*)(rowp + bj * HALF) = w; } }
    }
};
template <class Epi, class Sched, bool ALIGN_EPI = false, bool SP2 = false>
__device__ __forceinline__ void gemm_phase(PG8_LAS unsigned char* lds, const Gemm g, const Sched& S, const Epi& E) {
    int tid_ = threadIdx.x; asm volatile("" : "+v"(tid_));
    const int tid = tid_, wid = __builtin_amdgcn_readfirstlane(tid >> 6), lane = tid & 63, wr = wid >> 2, wc = wid & 3, fr = lane & 15, fq = lane >> 4;
    const int K = g.K, nt = K / BK;
    unsigned voffA[2], voffB[2];
#pragma unroll
    for (int i = 0; i < 2; ++i) { int R, C; stage_rc(tid * 16 + i * 8192, R, C); const int Rb = Epi::PERM ? ((R & ~31) + perm32(R & 31)) : R;
        voffA[i] = (unsigned)(R * g.lda + C) * 2u; voffB[i] = (unsigned)(Rb * g.ldb + C) * 2u; }
    const size_t kstep = (size_t)(BK * 2);
    const size_t hstepA = (size_t)HALF * g.lda * 2, hstepB = (size_t)HALF * g.ldb * 2;
    const size_t tstepA = 2 * hstepA, tstepB = 2 * hstepB;
    const unsigned ldsw = (unsigned)wid * 1024u;
    const int aoff = lds_byte(wr * 64 + fr, fq * 8), boff = lds_byte(wc * 32 + fr, fq * 8);
#define PG8_SA(b, h) (((b) * 2 + (h)) * HTB)
#define PG8_SB(b, h) ((4 + (b) * 2 + (h)) * HTB)
#define PG8_STAGE(bufoff, gbase, voff) do { _Pragma("unroll") for (int _i = 0; _i < 2; ++_i) \
        __builtin_amdgcn_global_load_lds((const unsigned*)((const char*)(gbase) + (voff)[_i]), (PG8_LAS unsigned*)(lds + (bufoff) + ldsw + _i * 8192), 16, 0, 0); } while (0)
#define PG8_LDA(dst, b, h) do { _Pragma("unroll") for (int m = 0; m < 4; ++m) _Pragma("unroll") for (int k = 0; k < 2; ++k) dst[m][k] = *(const PG8_LAS bf16x8*)(lds + PG8_SA(b, h) + aoff + m * 2048 + k * 1024); } while (0)
#define PG8_LDB(dst, b, h) do { _Pragma("unroll") for (int n = 0; n < 2; ++n) _Pragma("unroll") for (int k = 0; k < 2; ++k) dst[n][k] = *(const PG8_LAS bf16x8*)(lds + PG8_SB(b, h) + boff + n * 2048 + k * 1024); } while (0)
#define PG8_MMA(ai, bj, At, Bt) do { __builtin_amdgcn_s_setprio(1); _Pragma("unroll") for (int m = 0; m < 4; ++m) _Pragma("unroll") for (int n = 0; n < 2; ++n) _Pragma("unroll") for (int k = 0; k < 2; ++k) \
        acc[ai][bj][m][n] = __builtin_amdgcn_mfma_f32_16x16x32_bf16(Bt[n][k], At[m][k], acc[ai][bj][m][n], 0, 0, 0); __builtin_amdgcn_s_setprio(0); } while (0)
#define PG8_WAIT_V(n) asm volatile("s_waitcnt vmcnt(" #n ")" ::: "memory")
#define PG8_WAIT_L(n) asm volatile("s_waitcnt lgkmcnt(" #n ")" ::: "memory")
#define PG8_BAR __builtin_amdgcn_s_barrier()
#define PG8_SCHED __builtin_amdgcn_sched_barrier(0)
    Unit cur, nxt; int ui = 0;
    if (!S.next(0, cur)) return;
    f32x4 acc[2][2][4][2];
#pragma unroll
    for (int a = 0; a < 2; ++a)
#pragma unroll
        for (int b = 0; b < 2; ++b)
#pragma unroll
            for (int m = 0; m < 4; ++m)
#pragma unroll
                for (int n = 0; n < 2; ++n) acc[a][b][m][n] = (f32x4){0.f, 0.f, 0.f, 0.f};
    bf16x8 At[4][2], B0[2][2], B1[2][2];
    const char* cA = (const char*)g.A + (size_t)cur.pm * tstepA + (size_t)cur.pn * g.apn; const char* cB = (const char*)g.Bt + (size_t)cur.pn * tstepB;
    S.a_ready(cur);
    if constexpr (SP2) {
        PG8_STAGE(PG8_SB(0, 0), cB, voffB); PG8_STAGE(PG8_SB(0, 1), cB + hstepB, voffB); PG8_STAGE(PG8_SA(0, 0), cA, voffA); PG8_STAGE(PG8_SA(0, 1), cA + hstepA, voffA);
        if (wr == 1) PG8_BAR;
        PG8_WAIT_V(2); PG8_BAR;
        PG8_STAGE(PG8_SB(1, 0), cB + kstep, voffB); PG8_STAGE(PG8_SA(1, 0), cA + kstep, voffA); PG8_STAGE(PG8_SB(1, 1), cB + hstepB + kstep, voffB);
        PG8_WAIT_V(6); PG8_BAR;
    } else {
        PG8_STAGE(PG8_SB(0, 0), cB, voffB); PG8_STAGE(PG8_SA(0, 0), cA, voffA); PG8_STAGE(PG8_SB(0, 1), cB + hstepB, voffB); PG8_STAGE(PG8_SA(0, 1), cA + hstepA, voffA);
        if (wr == 1) PG8_BAR;
        PG8_WAIT_V(4); PG8_BAR;
        PG8_STAGE(PG8_SB(1, 0), cB + kstep, voffB); PG8_STAGE(PG8_SA(1, 0), cA + kstep, voffA); PG8_STAGE(PG8_SB(1, 1), cB + hstepB + kstep, voffB);
        PG8_WAIT_V(6); PG8_BAR;
    }
    for (;;) {
        const bool has_next = S.next(ui + 1, nxt);
        const char* nA = has_next ? (const char*)g.A + (size_t)nxt.pm * tstepA + (size_t)nxt.pn * g.apn : cA; const char* nB = has_next ? (const char*)g.Bt + (size_t)nxt.pn * tstepB : cB;
        for (int t = 0; t < nt; t += 2) {
            const bool last = (t == nt - 2);
            const char* a1 = cA + (size_t)(t + 1) * kstep;
            const char* a2 = last ? nA : cA + (size_t)(t + 2) * kstep; const char* b2 = last ? nB : cB + (size_t)(t + 2) * kstep;
            const char* a3 = a2 + kstep; const char* b3 = b2 + kstep;
            if (last && has_next) S.a_ready(nxt);
            if constexpr (SP2) {
            PG8_LDB(B0, 0, 0); PG8_LDB(B1, 0, 1); PG8_SCHED; PG8_LDA(At, 0, 0); PG8_STAGE(PG8_SA(1, 1), a1 + hstepA, voffA);
            PG8_WAIT_V(8); PG8_WAIT_L(0); PG8_BAR; PG8_MMA(0, 0, At, B0); PG8_MMA(0, 1, At, B1); PG8_BAR; PG8_SCHED;
            PG8_LDA(At, 0, 1); PG8_STAGE(PG8_SB(0, 0), b2, voffB); PG8_STAGE(PG8_SB(0, 1), b2 + hstepB, voffB); PG8_STAGE(PG8_SA(0, 0), a2, voffA);
            PG8_WAIT_V(8); PG8_WAIT_L(0); PG8_BAR; PG8_MMA(1, 0, At, B0); PG8_MMA(1, 1, At, B1); PG8_BAR; PG8_SCHED;
            PG8_LDB(B0, 1, 0); PG8_LDB(B1, 1, 1); PG8_SCHED; PG8_LDA(At, 1, 0); PG8_STAGE(PG8_SA(0, 1), a2 + hstepA, voffA);
            PG8_WAIT_V(8); PG8_WAIT_L(0); PG8_BAR; PG8_MMA(0, 0, At, B0); PG8_MMA(0, 1, At, B1); PG8_BAR; PG8_SCHED;
            PG8_LDA(At, 1, 1); PG8_STAGE(PG8_SB(1, 0), b3, voffB); PG8_STAGE(PG8_SB(1, 1), b3 + hstepB, voffB); PG8_STAGE(PG8_SA(1, 0), a3, voffA);
            PG8_WAIT_V(8); PG8_WAIT_L(0); PG8_BAR; PG8_MMA(1, 0, At, B0); PG8_MMA(1, 1, At, B1); PG8_BAR; PG8_SCHED;
            } else {
            PG8_LDB(B0, 0, 0); PG8_SCHED; PG8_LDA(At, 0, 0); PG8_STAGE(PG8_SA(1, 1), a1 + hstepA, voffA);
            PG8_WAIT_L(8); PG8_BAR; PG8_WAIT_L(0); PG8_MMA(0, 0, At, B0); PG8_BAR; PG8_SCHED;
            PG8_LDB(B1, 0, 1); PG8_STAGE(PG8_SB(0, 0), b2, voffB);
            PG8_BAR; PG8_WAIT_L(0); PG8_MMA(0, 1, At, B1); PG8_BAR;
            PG8_LDA(At, 0, 1); PG8_STAGE(PG8_SA(0, 0), a2, voffA);
            PG8_BAR; PG8_WAIT_L(0); PG8_MMA(1, 0, At, B0); PG8_BAR; PG8_SCHED;
            PG8_STAGE(PG8_SB(0, 1), b2 + hstepB, voffB);
            PG8_WAIT_V(6); PG8_BAR; PG8_MMA(1, 1, At, B1); PG8_BAR;
            PG8_LDB(B0, 1, 0); PG8_SCHED; PG8_LDA(At, 1, 0); PG8_STAGE(PG8_SA(0, 1), a2 + hstepA, voffA);
            PG8_WAIT_L(8); PG8_BAR; PG8_WAIT_L(0); PG8_MMA(0, 0, At, B0); PG8_BAR; PG8_SCHED;
            PG8_LDB(B1, 1, 1); PG8_STAGE(PG8_SB(1, 0), b3, voffB);
            PG8_BAR; PG8_WAIT_L(0); PG8_MMA(0, 1, At, B1); PG8_BAR;
            PG8_LDA(At, 1, 1); PG8_STAGE(PG8_SA(1, 0), a3, voffA);
            PG8_BAR; PG8_WAIT_L(0); PG8_MMA(1, 0, At, B0); PG8_BAR; PG8_SCHED;
            PG8_STAGE(PG8_SB(1, 1), b3 + hstepB, voffB);
            PG8_WAIT_V(6); PG8_BAR; PG8_MMA(1, 1, At, B1); PG8_BAR;
            }
        }
        if constexpr (ALIGN_EPI) { if (wr == 0) PG8_BAR; }
        if constexpr (!Epi::AFTER_DRAIN) { E(acc, cur, wr, wc, fr, fq); S.done(cur); }
        if (!has_next) break;
#pragma unroll
        for (int a = 0; a < 2; ++a)
#pragma unroll
            for (int b = 0; b < 2; ++b)
#pragma unroll
                for (int m = 0; m < 4; ++m)
#pragma unroll
                    for (int n = 0; n < 2; ++n) acc[a][b][m][n] = (f32x4){0.f, 0.f, 0.f, 0.f};
        cur = nxt; cA = nA; cB = nB; ++ui;
        if constexpr (ALIGN_EPI) { if (wr == 1) PG8_BAR; }
    }
    PG8_WAIT_V(0);
    if constexpr (!ALIGN_EPI) { if (wr == 0) PG8_BAR; }
    PG8_BAR;
    if constexpr (Epi::AFTER_DRAIN) { E.fused(acc, cur, wr, wc, fr, fq, lds, wid, lane); S.done(cur); }
#undef PG8_SA
#undef PG8_SB
#undef PG8_STAGE
#undef PG8_LDA
#undef PG8_LDB
#undef PG8_MMA
#undef PG8_WAIT_V
#undef PG8_WAIT_L
#undef PG8_BAR
#undef PG8_SCHED
}
}
namespace pg8 {
struct EpiSwiglu {
    static constexpr bool PERM = true, AFTER_DRAIN = false;
    bf16_t* H; int ldh;
    __device__ __forceinline__ void operator()(const f32x4 (&acc)[2][2][4][2], const Unit& u, int wr, int wc, int fr, int fq) const {
        const int row0 = u.pm * BM + wr * 64 + fr, col0 = u.pn * HALF + wc * 32 + 8 * fq;
#pragma unroll
        for (int ai = 0; ai < 2; ++ai)
#pragma unroll
            for (int m = 0; m < 4; ++m) { bf16_t* rowp = H + (size_t)(row0 + ai * HALF + m * 16) * ldh + col0;
                float hv[8];
#pragma unroll
                for (int n = 0; n < 2; ++n)
#pragma unroll
                    for (int i = 0; i < 4; ++i) { const float g = acc[ai][0][m][n][i], up = acc[ai][1][m][n][i];
                        const float e = __builtin_amdgcn_exp2f(g * -1.4426950408889634f); hv[n * 4 + i] = g * __builtin_amdgcn_rcpf(1.0f + e) * up; }
                u32x4 w; w.x = cvt_pk_bf16(hv[0], hv[1]); w.y = cvt_pk_bf16(hv[2], hv[3]); w.z = cvt_pk_bf16(hv[4], hv[5]); w.w = cvt_pk_bf16(hv[6], hv[7]);
                *(u32x4*)rowp = w; }
    }
};
struct EpiScaleBf16 {
    static constexpr bool PERM = true, AFTER_DRAIN = false;
    bf16_t* Y; const float* cscale; float cs;
    __device__ __forceinline__ void operator()(const f32x4 (&acc)[2][2][4][2], const Unit& u, int wr, int wc, int fr, int fq) const {
        const int row0 = u.pm * BM + wr * 64 + fr, col0 = u.pn * BM + wc * 32 + 8 * fq;
        f32x4 sc[2][2];
#pragma unroll
        for (int bj = 0; bj < 2; ++bj)
#pragma unroll
            for (int n = 0; n < 2; ++n) sc[bj][n] = cscale ? *(const f32x4*)(cscale + col0 + bj * HALF + 4 * n) : (f32x4){cs, cs, cs, cs};
#pragma unroll
        for (int ai = 0; ai < 2; ++ai)
#pragma unroll
            for (int m = 0; m < 4; ++m) { bf16_t* rowp = Y + (size_t)(row0 + ai * HALF + m * 16) * 1024 + col0;
#pragma unroll
                for (int bj = 0; bj < 2; ++bj) { const f32x4 v0 = acc[ai][bj][m][0] * sc[bj][0], v1 = acc[ai][bj][m][1] * sc[bj][1];
                    u32x4 w; w.x = cvt_pk_bf16(v0[0], v0[1]); w.y = cvt_pk_bf16(v0[2], v0[3]); w.z = cvt_pk_bf16(v1[0], v1[1]); w.w = cvt_pk_bf16(v1[2], v1[3]);
                    *(u32x4*)(rowp + bj * HALF) = w; } }
    }
};
}
#define PG8_SP2 true
#define PG8_ALIGN true
#include <hip/hip_bf16.h>
#include <cmath>
#include <hip/hip_bf16.h>
#include <cmath>
namespace attn_body {
using bf16=__hip_bfloat16;
using bf16x8=__attribute__((ext_vector_type(8)))short;
using s16x4=__attribute__((ext_vector_type(4)))short;
using f32x16=__attribute__((ext_vector_type(16)))float;
using u32x4=__attribute__((ext_vector_type(4)))unsigned;
constexpr int SEQ=8192,D=64,PQ=3072,PO=2048;
constexpr int NW=8,QBLK=32,QB=QBLK*NW,KVBLK=64,NQB=SEQ/QB;
constexpr int ATTN_UNIT_ROWS=QB;
__device__ __forceinline__ int crow(int r,int hi){return (r&3)+8*(r>>2)+4*hi;}
#define SBAR() __builtin_amdgcn_sched_barrier(0)
__device__ __forceinline__ void cmask(f32x16&p0,f32x16&p1,int jb,int qrel,int hi){
  const float NEG=-INFINITY; int kb=64*jb+4*hi;
  #pragma unroll
  for(int r=0;r<16;++r){int kv=kb+(r&3)+8*(r>>2); if(kv>qrel)p0[r]=NEG; if(kv+32>qrel)p1[r]=NEG;}
}

constexpr int NSLOT=3, SLOTB=8192;
constexpr int LDS_K=0, LDS_V=NSLOT*SLOTB, LDS_WS=3*NSLOT*SLOTB, LDS_OST=LDS_WS+NW*64*4, LDS_BYTES=LDS_OST+NW*8192;
constexpr float C2=0.125f*1.4426950408889634f;
__device__ __forceinline__ void glds16(const void*gsrc,unsigned lds_dst){unsigned keep;
  asm volatile("s_mov_b32 %0, m0\n\ts_mov_b32 m0, %2\n\ts_nop 0\n\tglobal_load_lds_dwordx4 %1, off\n\ts_mov_b32 m0, %0":"=&s"(keep):"v"(gsrc),"s"(lds_dst):"memory");}
template<int IMM> __device__ __forceinline__ void glds16s(const void*sbase,unsigned voff,unsigned lds_dst){unsigned keep;
  asm volatile("s_mov_b32 %0, m0\n\ts_mov_b32 m0, %3\n\ts_nop 0\n\tglobal_load_lds_dwordx4 %1, %2 offset:%c4\n\ts_mov_b32 m0, %0":"=&s"(keep):"v"(voff),"s"(sbase),"s"(lds_dst),"i"(IMM):"memory");}
__device__ __forceinline__ float max3f(float a,float b,float c){float r;asm("v_max3_f32 %0, %1, %2, %3":"=v"(r):"v"(a),"v"(b),"v"(c));return r;}
__device__ __forceinline__ float max2f(float a,float b){float r;asm("v_max_f32_e32 %0, %1, %2":"=v"(r):"v"(a),"v"(b));return r;}
__device__ __forceinline__ float fadd_s(float a,float b){float r;asm("v_add_f32_e32 %0, %1, %2":"=v"(r):"v"(a),"v"(b));return r;}
__device__ __forceinline__ float fsub_s(float a,float b){float r;asm("v_sub_f32_e32 %0, %1, %2":"=v"(r):"v"(a),"v"(b));return r;}
typedef float f32x2_t __attribute__((ext_vector_type(2))); typedef __bf16 bf16x2_t __attribute__((ext_vector_type(2)));
__device__ __forceinline__ unsigned cvtpk_s(float lo,float hi){f32x2_t v={lo,hi};bf16x2_t b=__builtin_convertvector(v,bf16x2_t);return __builtin_bit_cast(unsigned,b);}
#define WAIT_BAR(N) asm volatile("s_waitcnt vmcnt(" #N ") lgkmcnt(0)\n\ts_barrier":::"memory")

__device__ __forceinline__ void qkt(f32x16&p0,f32x16&p1,const char*Kslot,const bf16x8*qr,const f32x16&negm,int r32,int hi){
  const char*kb=Kslot+hi*1024+r32*16;
  #pragma unroll
  for(int d0=0;d0<4;++d0){
    const bf16x8 b0=*reinterpret_cast<const bf16x8*>(kb+d0*2048);
    const bf16x8 b1=*reinterpret_cast<const bf16x8*>(kb+d0*2048+512);
    if(d0==0){p0=__builtin_amdgcn_mfma_f32_32x32x16_bf16(b0,qr[0],negm,0,0,0);p1=__builtin_amdgcn_mfma_f32_32x32x16_bf16(b1,qr[0],negm,0,0,0);}
    else{p0=__builtin_amdgcn_mfma_f32_32x32x16_bf16(b0,qr[d0],p0,0,0,0);p1=__builtin_amdgcn_mfma_f32_32x32x16_bf16(b1,qr[d0],p1,0,0,0);}}
}
typedef __attribute__((address_space(3))) const char* lds_cptr;
typedef short v4i16_t __attribute__((ext_vector_type(4)));
__device__ __forceinline__ void kload8(bf16x8*kf,lds_cptr kp){
  kf[0]=*(const __attribute__((address_space(3))) bf16x8*)(kp);      kf[1]=*(const __attribute__((address_space(3))) bf16x8*)(kp+512);
  kf[2]=*(const __attribute__((address_space(3))) bf16x8*)(kp+2048); kf[3]=*(const __attribute__((address_space(3))) bf16x8*)(kp+2560);
  kf[4]=*(const __attribute__((address_space(3))) bf16x8*)(kp+4096); kf[5]=*(const __attribute__((address_space(3))) bf16x8*)(kp+4608);
  kf[6]=*(const __attribute__((address_space(3))) bf16x8*)(kp+6144); kf[7]=*(const __attribute__((address_space(3))) bf16x8*)(kp+6656);
}
__device__ __forceinline__ void kload2(bf16x8*kf,lds_cptr kp,int j){ kf[2*j]=*(const __attribute__((address_space(3))) bf16x8*)(kp+j*2048); kf[2*j+1]=*(const __attribute__((address_space(3))) bf16x8*)(kp+j*2048+512); }
__device__ __forceinline__ s16x4 vtr(lds_cptr p){ return __builtin_bit_cast(s16x4,__builtin_amdgcn_ds_read_tr16_b64_v4i16((__attribute__((address_space(3))) v4i16_t*)p)); }
__device__ __forceinline__ float rowmax(const f32x16&p0,const f32x16&p1){
  float a=max3f(p0[0],p0[1],p1[0]),b=max3f(p0[2],p0[3],p1[1]);a=max3f(a,p1[2],p1[3]);
  #pragma unroll
  for(int r=4;r<16;r+=4){a=max3f(a,p0[r],p0[r+1]);b=max3f(b,p0[r+2],p0[r+3]);a=max3f(a,p1[r],p1[r+1]);b=max3f(b,p1[r+2],p1[r+3]);}
  const float m=max2f(a,b);
  auto rr=__builtin_amdgcn_permlane32_swap(__float_as_uint(m),__float_as_uint(m),false,false);
  return max2f(__uint_as_float(rr[0]),__uint_as_float(rr[1]));
}
__device__ __forceinline__ void pv(f32x16*o,int vb,bf16x8 pa0,bf16x8 pa1,bf16x8 pa2,bf16x8 pa3){
  #pragma unroll
  for(int d0=0;d0<4;++d0){s16x4 lo[4],hi[4];
    #pragma unroll
    for(int ks=0;ks<4;++ks){
      asm volatile("ds_read_b64_tr_b16 %0,%1 offset:%c2":"=&v"(lo[ks]):"v"(vb),"i"(d0*4096+ks*1024):"memory");
      asm volatile("ds_read_b64_tr_b16 %0,%1 offset:%c2":"=&v"(hi[ks]):"v"(vb),"i"(d0*4096+ks*1024+512):"memory");}
    asm volatile("s_waitcnt lgkmcnt(0)":::"memory");SBAR();
    #define PK(k) (bf16x8){lo[k][0],lo[k][1],lo[k][2],lo[k][3],hi[k][0],hi[k][1],hi[k][2],hi[k][3]}
    o[d0]=__builtin_amdgcn_mfma_f32_32x32x16_bf16(pa0,PK(0),o[d0],0,0,0);
    o[d0]=__builtin_amdgcn_mfma_f32_32x32x16_bf16(pa1,PK(1),o[d0],0,0,0);
    o[d0]=__builtin_amdgcn_mfma_f32_32x32x16_bf16(pa2,PK(2),o[d0],0,0,0);
    o[d0]=__builtin_amdgcn_mfma_f32_32x32x16_bf16(pa3,PK(3),o[d0],0,0,0);
    #undef PK
  }
}

#ifndef ATTN_STORE16
#define ATTN_STORE16(p,v) (*(u32x4*)(p)=(v))
#endif
template<int THRL> __device__ __forceinline__ void attn_unit(long rowbase,int qb,const bf16*Q,const bf16*__restrict__ K,const bf16*__restrict__ V,bf16*O,float sl,int T0,char*shm){
  int tid_=threadIdx.x; asm volatile("":"+v"(tid_)); const int tid=tid_,lane=tid&63,r32=lane&31,hi=lane>>5; const int wid=__builtin_amdgcn_readfirstlane(tid>>6);
  const int q0=qb*QB; const float sl64=64.f*sl, sl32=32.f*sl;
  const bf16*Qw=Q+(rowbase+q0+wid*QBLK)*PQ;
  const bf16*Kh=K+(rowbase+(long)T0*KVBLK)*PQ,*Vh=V+(rowbase+(long)T0*KVBLK)*PQ;
  const unsigned lds0=(unsigned)(uintptr_t)shm;
  float*wsf=(float*)(shm+LDS_WS)+wid*64;
  const unsigned koff=(unsigned)(lane*PQ+wid*8)*2u, voff=(unsigned)((16*(wid&3)+(lane>>2))*PQ+(wid>>2)*32+(lane&3)*8)*2u;
  const unsigned kdst=lds0+LDS_K+wid*1024, vdst=lds0+LDS_V+wid*1024;
  #define DMA_K(t,slot) glds16s<0>(Kh+(long)(t)*KVBLK*PQ,koff,(unsigned)__builtin_amdgcn_readfirstlane(kdst+(slot)))
  #define DMA_V(t,slot) do{ glds16s<0>(Vh+(long)(t)*KVBLK*PQ,voff,(unsigned)__builtin_amdgcn_readfirstlane(vdst+2*(slot))); glds16s<0>(Vh+(long)(t)*KVBLK*PQ+64,voff,(unsigned)__builtin_amdgcn_readfirstlane(vdst+2*(slot)+8192)); }while(0)
  const int vb0=(int)(lds0+LDS_V)+((lane>>4)&1)*32+(lane&3)*8+(4*hi+((lane&15)>>2))*64;
  const char*Kbase=shm+LDS_K; bf16x8 kf[8];
  const lds_cptr shm3=(lds_cptr)shm; const lds_cptr kp0=shm3+LDS_K+hi*1024+r32*16; const lds_cptr vp0=shm3+LDS_V+((lane>>4)&1)*32+(lane&3)*8+(4*hi+((lane&15)>>2))*64;
  const int NT=(q0+QB)/KVBLK-T0;
  DMA_K(0,0);DMA_V(0,0);DMA_K(1,SLOTB);
  bf16x8 qr[4];
  #pragma unroll
  for(int d0=0;d0<4;++d0)qr[d0]=*reinterpret_cast<const bf16x8*>(&Qw[(long)r32*PQ+d0*16+hi*8]);
  typedef __attribute__((address_space(3))) bf16x8* lds_q8; const lds_q8 qpark=(lds_q8)((__attribute__((address_space(3))) char*)shm+LDS_OST+wid*8192+lane*16);
  #pragma unroll
  for(int d0=0;d0<4;++d0)qpark[d0*64]=qr[d0];
  #define QLD(d0) (qpark[(d0)*64])
  float mhat=0.f,l_reg=0.f;f32x16 o[4];o[0]=f32x16{};o[1]=f32x16{};o[2]=f32x16{};o[3]=f32x16{};const int qrel=wid*QBLK+r32;
  f32x16 negm;
  #pragma unroll
  for(int r=0;r<16;++r)negm[r]=sl*(float)(T0*KVBLK+crow(r,hi)-(q0+qrel));
  asm volatile("":"+v"(negm));
  #define CMASK(P0,P1,t) do{int jb_=(t)-(NT-4); if(jb_>=0)cmask(P0,P1,jb_,qrel,hi);}while(0)
  bool resc=false;
  #define START(P0,P1) do{ const float rm=rowmax(P0,P1); resc=false; \
    { const float dl=rm; mhat=fadd_s(mhat,dl); \
      _Pragma("unroll") for(int r=0;r<16;++r){P0[r]=fsub_s(P0[r],dl);P1[r]=fsub_s(P1[r],dl);} \
      { const float adj_=sl64-dl; _Pragma("unroll") for(int r=0;r<16;++r)negm[r]+=adj_; } asm volatile("":"+v"(negm)); } \
    _Pragma("unroll") for(int r=0;r<16;++r)P0[r]=__builtin_amdgcn_exp2f(P0[r]); }while(0)
  #define RESC() do{ if(resc){ asm volatile("s_waitcnt lgkmcnt(0)":::"memory"); \
      _Pragma("unroll") for(int d_=0;d_<4;++d_) _Pragma("unroll") for(int r=0;r<16;++r)o[d_][r]*=wsf[crow(r,hi)]; } }while(0)
  f32x16 pA0,pA1,pB0,pB1;
  int sl_prev=0,sl_cur=0,sl_next=SLOTB;
  #define ROT() do{sl_prev=sl_cur;sl_cur=sl_next;sl_next=(sl_next==(NSLOT-1)*SLOTB)?0:sl_next+SLOTB;}while(0)
  DMA_K(2,2*SLOTB);
  WAIT_BAR(3);
  qkt(pA0,pA1,Kbase,qr,negm,r32,hi);asm volatile("s_nop 15\n\ts_nop 7":"+v"(pA0),"+v"(pA1));
  _Pragma("unroll") for(int r=0;r<16;++r)pA1[r]+=sl32;
  CMASK(pA0,pA1,0);
  START(pA0,pA1);
  _Pragma("unroll") for(int r=0;r<16;++r)pA1[r]=__builtin_amdgcn_exp2f(pA1[r]);
  WAIT_BAR(0);
  DMA_K(3,0);DMA_V(1,SLOTB);
  ROT();
  kload8(kf,kp0+sl_cur);
  WAIT_BAR(3);
  s16x4 vlo[8],vhi[8]; u32x4 pw0,pw1,pw2,pw3;
  #define PKW(P,B) cvtpk_s(P[B],P[B+1])
  #define PAF(k) __builtin_bit_cast(bf16x8,pw##k)
  #define VFR(i) (bf16x8){vlo[i][0],vlo[i][1],vlo[i][2],vlo[i][3],vhi[i][0],vhi[i][1],vhi[i][2],vhi[i][3]}
  #define PIN(x) asm volatile("":"+v"(x))
  #define MX3(a,b,c) __builtin_fmaxf(__builtin_fmaxf((a),(b)),(c))
  #define GAPA(MF,A0,A1,A2,A3,W0,W1,PW) do{ MF; sacc+=A0; sacc+=A1; sacc+=A2; sacc+=A3; PIN(sacc); W0; W1; PIN(PW); SBAR(); }while(0)
  #define EX(v) __builtin_amdgcn_exp2f(v)
  #define GAPB2(MF,X,B) do{ MF; X[B]=EX(X[B]); X[B+1]=EX(X[B+1]); PIN(X); SBAR(); }while(0)
  #define VRD(i) do{ vlo[i]=vtr(vp_+(((i)>>2)*4096+((i)&3)*1024)); vhi[i]=vtr(vp_+(((i)>>2)*4096+((i)&3)*1024+512)); }while(0)
  #define VRD2(i) do{ vlo[i]=vtr(vp_+((2+((i)>>2))*4096+((i)&3)*1024)); vhi[i]=vtr(vp_+((2+((i)>>2))*4096+((i)&3)*1024+512)); }while(0)
  #define KRD(G,j) do{ if(G){ kload2(kf,kp0+sl_next,j); SBAR(); } }while(0)
  #define STEP(C0,C1,P0,P1,t,GK,GV,GL) do{ SBAR(); \
    const lds_cptr vp_=vp0+2*sl_prev; \
    const bf16x8 q0_=QLD(0),q1_=QLD(1); \
    VRD(0); SBAR(); float sacc=(P0[0]+P0[1]); \
    GAPA(C0=__builtin_amdgcn_mfma_f32_32x32x16_bf16(kf[0],q0_,negm,0,0,0), P0[2],P0[3],P0[4],P0[5],     pw0[0]=PKW(P0,0), pw0[1]=PKW(P0,2), pw0); \
    VRD(4); SBAR(); GAPA(C1=__builtin_amdgcn_mfma_f32_32x32x16_bf16(kf[1],q0_,negm,0,0,0), P0[6],P0[7],P0[8],P0[9],     pw0[2]=PKW(P0,4), pw0[3]=PKW(P0,6), pw0); \
    const bf16x8 q2_=QLD(2); VRD(1); SBAR(); GAPA(C0=__builtin_amdgcn_mfma_f32_32x32x16_bf16(kf[2],q1_,C0,0,0,0),   P0[10],P0[11],P0[12],P0[13], pw1[0]=PKW(P0,8), pw1[1]=PKW(P0,10), pw1); \
    VRD(5); SBAR(); GAPA(C1=__builtin_amdgcn_mfma_f32_32x32x16_bf16(kf[3],q1_,C1,0,0,0),   P0[14],P0[15],P1[0],P1[1],   pw1[2]=PKW(P0,12),pw1[3]=PKW(P0,14), pw1); \
    const bf16x8 q3_=QLD(3); VRD(2); SBAR(); GAPA(C0=__builtin_amdgcn_mfma_f32_32x32x16_bf16(kf[4],q2_,C0,0,0,0),   P1[2],P1[3],P1[4],P1[5],     pw2[0]=PKW(P1,0), pw2[1]=PKW(P1,2), pw2); \
    VRD(6); SBAR(); GAPA(C1=__builtin_amdgcn_mfma_f32_32x32x16_bf16(kf[5],q2_,C1,0,0,0),   P1[6],P1[7],P1[8],P1[9],     pw2[2]=PKW(P1,4), pw2[3]=PKW(P1,6), pw2); \
    VRD(3); SBAR(); GAPA(C0=__builtin_amdgcn_mfma_f32_32x32x16_bf16(kf[6],q3_,C0,0,0,0),   P1[10],P1[11],P1[12],P1[13], pw3[0]=PKW(P1,8), pw3[1]=PKW(P1,10), pw3); \
    VRD(7); SBAR(); GAPA(C1=__builtin_amdgcn_mfma_f32_32x32x16_bf16(kf[7],q3_,C1,0,0,0),   P1[14],P1[15],0.f,0.f,       pw3[2]=PKW(P1,12),pw3[3]=PKW(P1,14), pw3); \
    l_reg+=sacc; \
    if(GK){DMA_K((t)+3,sl_cur);} if(GV){DMA_V((t)+1,sl_next);} \
    _Pragma("unroll") for(int r=0;r<16;++r)C1[r]+=sl32; \
    CMASK(C0,C1,t); \
    { float a=MX3(C0[0],C0[1],C1[0]),b=MX3(C0[2],C0[3],C1[1]); a=MX3(a,C1[2],C1[3]); \
      _Pragma("unroll") for(int r=4;r<16;r+=4){a=MX3(a,C0[r],C0[r+1]);b=MX3(b,C0[r+2],C0[r+3]);a=MX3(a,C1[r],C1[r+1]);b=MX3(b,C1[r+2],C1[r+3]);} \
      float rm=__builtin_fmaxf(a,b); { auto rr=__builtin_amdgcn_permlane32_swap(__float_as_uint(rm),__float_as_uint(rm),false,false); rm=__builtin_fmaxf(__uint_as_float(rr[0]),__uint_as_float(rr[1])); } \
      resc=false; float adj_=sl64; \
      if(__builtin_expect(__any(rm>(float)THRL),0)){ const float dl=__builtin_fmaxf(rm,0.f); mhat+=dl; adj_-=dl; \
        _Pragma("unroll") for(int r=0;r<16;++r){C0[r]-=dl;C1[r]-=dl;} \
        const float f=__builtin_amdgcn_exp2f(-dl); l_reg*=f; if(hi==0)wsf[r32]=f; resc=true; } \
      _Pragma("unroll") for(int r=0;r<16;++r)negm[r]+=adj_; asm volatile("":"+v"(negm)); } \
    SBAR(); \
    GAPB2(o[0]=__builtin_amdgcn_mfma_f32_32x32x16_bf16(PAF(0),VFR(0),o[0],0,0,0), C0,0); VRD2(0); SBAR(); \
    GAPB2(o[1]=__builtin_amdgcn_mfma_f32_32x32x16_bf16(PAF(0),VFR(4),o[1],0,0,0), C0,2); VRD2(4); SBAR(); \
    KRD(GL,0); GAPB2(o[0]=__builtin_amdgcn_mfma_f32_32x32x16_bf16(PAF(1),VFR(1),o[0],0,0,0), C0,4); VRD2(1); SBAR(); \
    KRD(GL,1); GAPB2(o[1]=__builtin_amdgcn_mfma_f32_32x32x16_bf16(PAF(1),VFR(5),o[1],0,0,0), C0,6); VRD2(5); SBAR(); \
    KRD(GL,2); GAPB2(o[0]=__builtin_amdgcn_mfma_f32_32x32x16_bf16(PAF(2),VFR(2),o[0],0,0,0), C0,8); VRD2(2); SBAR(); \
    KRD(GL,3); GAPB2(o[1]=__builtin_amdgcn_mfma_f32_32x32x16_bf16(PAF(2),VFR(6),o[1],0,0,0), C0,10); VRD2(6); SBAR(); \
    GAPB2(o[0]=__builtin_amdgcn_mfma_f32_32x32x16_bf16(PAF(3),VFR(3),o[0],0,0,0), C0,12); VRD2(3); SBAR(); \
    GAPB2(o[1]=__builtin_amdgcn_mfma_f32_32x32x16_bf16(PAF(3),VFR(7),o[1],0,0,0), C0,14); VRD2(7); SBAR(); \
    GAPB2(o[2]=__builtin_amdgcn_mfma_f32_32x32x16_bf16(PAF(0),VFR(0),o[2],0,0,0), C1,0); \
    GAPB2(o[3]=__builtin_amdgcn_mfma_f32_32x32x16_bf16(PAF(0),VFR(4),o[3],0,0,0), C1,2); \
    GAPB2(o[2]=__builtin_amdgcn_mfma_f32_32x32x16_bf16(PAF(1),VFR(1),o[2],0,0,0), C1,4); \
    GAPB2(o[3]=__builtin_amdgcn_mfma_f32_32x32x16_bf16(PAF(1),VFR(5),o[3],0,0,0), C1,6); \
    GAPB2(o[2]=__builtin_amdgcn_mfma_f32_32x32x16_bf16(PAF(2),VFR(2),o[2],0,0,0), C1,8); \
    GAPB2(o[3]=__builtin_amdgcn_mfma_f32_32x32x16_bf16(PAF(2),VFR(6),o[3],0,0,0), C1,10); \
    GAPB2(o[2]=__builtin_amdgcn_mfma_f32_32x32x16_bf16(PAF(3),VFR(3),o[2],0,0,0), C1,12); \
    GAPB2(o[3]=__builtin_amdgcn_mfma_f32_32x32x16_bf16(PAF(3),VFR(7),o[3],0,0,0), C1,14); \
    }while(0)
  int t=1;
  #undef CMASK
  #define CMASK(P0,P1,t) do{}while(0)
  for(;t+5<NT;t+=2){
    STEP(pB0,pB1,pA0,pA1,t,true,true,true);     WAIT_BAR(3); RESC(); ROT();
    STEP(pA0,pA1,pB0,pB1,t+1,true,true,true);   WAIT_BAR(3); RESC(); ROT();
  }
  #undef CMASK
  #define CMASK(P0,P1,t) do{int jb_=(t)-(NT-4); if(jb_>=0)cmask(P0,P1,jb_,qrel,hi);}while(0)
  #define ENDW(tt) do{ if((tt)+3<NT){WAIT_BAR(3);} else if((tt)+2<NT){WAIT_BAR(2);} else {WAIT_BAR(0);} }while(0)
  for(;t+1<NT;t+=2){
    STEP(pB0,pB1,pA0,pA1,t,(t+3<NT),(t+1<NT),(t+1<NT));       ENDW(t);   RESC(); ROT();
    STEP(pA0,pA1,pB0,pB1,t+1,(t+4<NT),(t+2<NT),(t+2<NT));     ENDW(t+1); RESC(); ROT();
  }
  STEP(pB0,pB1,pA0,pA1,NT-1,false,false,false); RESC();
  { float sacc=pB0[0]+pB0[1]; _Pragma("unroll") for(int r=2;r<16;++r)sacc+=pB0[r]; _Pragma("unroll") for(int r=0;r<16;++r)sacc+=pB1[r]; l_reg+=sacc;
    pw0=(u32x4){PKW(pB0,0),PKW(pB0,2),PKW(pB0,4),PKW(pB0,6)};pw1=(u32x4){PKW(pB0,8),PKW(pB0,10),PKW(pB0,12),PKW(pB0,14)};pw2=(u32x4){PKW(pB1,0),PKW(pB1,2),PKW(pB1,4),PKW(pB1,6)};pw3=(u32x4){PKW(pB1,8),PKW(pB1,10),PKW(pB1,12),PKW(pB1,14)};
    SBAR(); pv(o,vb0+2*sl_cur,PAF(0),PAF(1),PAF(2),PAF(3)); }
  #undef PKW
  #undef PAF
  #undef VFR
  #undef PIN
  #undef MX3
  #undef GAPA
  #undef GAPB2
  #undef VRD2
  #undef EX
  #undef VRD
  #undef KRD
  #undef STEP
  #undef ENDW
  {auto rr=__builtin_amdgcn_permlane32_swap(__float_as_uint(l_reg),__float_as_uint(l_reg),false,false);l_reg=__uint_as_float(rr[0])+__uint_as_float(rr[1]);}
  if(hi==0)wsf[32+r32]=l_reg;asm volatile("s_waitcnt lgkmcnt(0)":::"memory");
  float rli[16];
  #pragma unroll
  for(int r=0;r<16;++r)rli[r]=__builtin_amdgcn_rcpf(wsf[32+crow(r,hi)]);
  bf16*Ow=O+(rowbase+q0+wid*QBLK)*PO;
  { bf16*stg=(bf16*)(shm+LDS_OST)+wid*4096;
    #pragma unroll
    for(int r=0;r<16;++r){const int orow=crow(r,hi);
      #pragma unroll
      for(int d0=0;d0<4;++d0)stg[orow*128+d0*32+r32]=__float2bfloat16(o[d0][r]*rli[r]);}
    asm volatile("s_waitcnt lgkmcnt(0)":::"memory");
    #pragma unroll
    for(int i=0;i<8;++i){const int row=i*4+(lane>>4),ch=lane&15; const u32x4 v=*(const u32x4*)(stg+row*128+ch*8); ATTN_STORE16(Ow+(long)row*PO+ch*8,v);} }
  asm volatile("s_waitcnt lgkmcnt(0)\n\ts_barrier":::"memory");
  #undef QLD
  #undef DMA_K
  #undef DMA_V
  #undef CMASK
  #undef START
  #undef RESC
  #undef ROT
}
constexpr int ATTN_LDS_BYTES=LDS_BYTES;
template<int THRL=8> __device__ __forceinline__ void attn_phase(char*lds,const bf16*QKV,bf16*OP,unsigned*ctl){
  volatile __attribute__((address_space(3))) unsigned* qword=(volatile __attribute__((address_space(3))) unsigned*)(__attribute__((address_space(3))) char*)lds+(140*1024/4);
  const int x0=(int)(__builtin_amdgcn_s_getreg((3<<11)|20)&7u);
  for(int qi=0;qi<8;++qi){ const int b=(x0+qi)&7;
  for(;;){
    if(threadIdx.x==0){ const unsigned i=__hip_atomic_fetch_add(ctl+256+16*b,1u,__ATOMIC_RELAXED,__HIP_MEMORY_SCOPE_AGENT); *qword=i; }
    asm volatile("s_waitcnt lgkmcnt(0)\n\ts_barrier":::"memory");
    const int idx=__builtin_amdgcn_readfirstlane((int)*qword);
    asm volatile("s_waitcnt lgkmcnt(0)\n\ts_barrier":::"memory");
    if(idx>=16*NQB)break;
    const int grp=idx>>5,h=7-(grp>>1),mp=grp&1,qb=NQB-1-(idx&31);
    const float sl=__builtin_ldexpf(1.4426950408889634f,-(h+1));
    const float qn2=__uint_as_float(__hip_atomic_load(ctl+b*32+mp*8+h,__ATOMIC_RELAXED,__HIP_MEMORY_SCOPE_AGENT)),kn2=__uint_as_float(__hip_atomic_load(ctl+b*32+16+mp*8+h,__ATOMIC_RELAXED,__HIP_MEMORY_SCOPE_AGENT));
    const float thr=2.04f*sqrtf(qn2*kn2)+152.f, xs=(float)(qb*QB-63)-thr/sl;
    int T0=0; if(xs>=0.f){ T0=((int)(xs*(1.f/64.f))+1)&~1; if(T0>4*qb)T0=4*qb; }
    T0=__builtin_amdgcn_readfirstlane(T0);
    attn_unit<THRL>((long)b*SEQ,qb,QKV+mp*512+h*64,QKV+1024+mp*512+h*64,QKV+2048+h*128,OP+mp*1024+h*128,sl,T0,lds);
  } }
}
#undef SBAR
#undef WAIT_BAR
}
constexpr int NWAVES = 8;
constexpr int BATCH = 8, SEQL = 8192, DMODEL = 1024, DFF = 2816, NQKV = 3072;
constexpr int MROWS = BATCH * SEQL;
constexpr float LN_EPS = 1e-5f, RMS_EPS = 1e-5f;
constexpr float DN_ALPHA = 1.41421356237309515f;
constexpr float LAMBDA_INIT = 0.35550906759096927f;
constexpr size_t MiB = 1u << 20;
constexpr size_t WS_WIN = 2 * MiB, WIN_BYTES = 11 * MiB;
constexpr size_t WS_WOUT = 46 * MiB, WOUT_BYTES = 11 * MiB / 2;
constexpr size_t WS_WQKV = 68 * MiB, WS_WO = 74 * MiB, WS_PW = 76 * MiB;
constexpr size_t WS_Z = 80 * MiB;
constexpr size_t WS_XB = 336 * MiB;
constexpr size_t WS_H = 464 * MiB;
constexpr size_t WS_XL = 848 * MiB;
constexpr size_t WS_END = 912 * MiB;
constexpr int LDS_BYTES = 147456;
#define GAS __attribute__((address_space(1)))
#define LAS __attribute__((address_space(3)))
typedef unsigned short bf16;
typedef unsigned v4u __attribute__((ext_vector_type(4)));
typedef unsigned v2u __attribute__((ext_vector_type(2)));
typedef float f32x4 __attribute__((ext_vector_type(4)));
#define LDS_WAIT() asm volatile("s_waitcnt lgkmcnt(0)" ::: "memory")
__device__ __forceinline__ unsigned pk2(float lo, float hi) { return pg8::cvt_pk_bf16(lo, hi); }
__device__ __forceinline__ float wave_sum(float v) {
#pragma unroll
    for (int o = 1; o < 64; o <<= 1) v += __shfl_xor(v, o);
    return v;
}
__device__ __forceinline__ void p0_transpose_item(const float* W, int K, int N, bf16* WT, int mode, int row_off, LAS float* scr, int item, int lane) {
    const int nblk = N / 32, kb = item / nblk, nb = item % nblk, k0 = 64 * kb, n0 = 32 * nb;
    int r0 = row_off + n0;
    if (mode == 1) { const int j = n0 < DFF ? n0 : n0 - DFF; r0 = (j >> 7) * 256 + (j & 127) + (n0 < DFF ? 0 : 128); }
#pragma unroll 8
    for (int i = 0; i < 32; ++i) { const int kk = 2 * i + (lane >> 5); scr[kk * 33 + (lane & 31)] = W[(size_t)(k0 + kk) * N + n0 + (lane & 31)]; }
    LDS_WAIT(); asm volatile("" ::: "memory");
    const int c = lane & 7;
#pragma unroll
    for (int j = 0; j < 4; ++j) { const int n = (lane >> 3) + 8 * j; const LAS float* s = scr + (8 * c) * 33 + n;
        v4u o; o.x = pk2(s[0 * 33], s[1 * 33]); o.y = pk2(s[2 * 33], s[3 * 33]); o.z = pk2(s[4 * 33], s[5 * 33]); o.w = pk2(s[6 * 33], s[7 * 33]);
        *(GAS v4u*)(WT + (size_t)(r0 + n) * K + k0 + 8 * c) = o; }
    LDS_WAIT(); asm volatile("" ::: "memory");
}
struct Args { const float* in[30]; float* out; unsigned char* ws; };

__device__ __forceinline__ void prologue(const Args& a, LAS unsigned char* lds, int gw, int NGW, int wave, int lane) {
    LAS float* scr = (LAS float*)(lds + wave * 16384);
    unsigned char* ws = a.ws;
    constexpr int I_IN = (DMODEL / 64) * (2 * DFF / 32), I_OUT = (DFF / 64) * (DMODEL / 32), I_QKV = (DMODEL / 64) * (NQKV / 32), I_O = (DMODEL / 64) * (DMODEL / 32), I_P = (256 / 64) * (256 / 32);
    constexpr int NITEMS = 4 * I_IN + 4 * I_OUT + I_QKV + I_O + 4 * I_P;
    for (int it = gw; it < NITEMS; it += NGW) {
        int r = it;
        if (r < 4 * I_IN) { const int f = r / I_IN; const int idx = f == 0 ? 1 : f == 1 ? 9 : f == 2 ? 13 : 26;
            p0_transpose_item(a.in[idx], DMODEL, 2 * DFF, (bf16*)(ws + WS_WIN + f * WIN_BYTES), 1, 0, scr, r % I_IN, lane); continue; } r -= 4 * I_IN;
        if (r < 4 * I_OUT) { const int f = r / I_OUT; const int idx = f == 0 ? 2 : f == 1 ? 10 : f == 2 ? 14 : 27;
            p0_transpose_item(a.in[idx], DFF, DMODEL, (bf16*)(ws + WS_WOUT + f * WOUT_BYTES), 0, 0, scr, r % I_OUT, lane); continue; } r -= 4 * I_OUT;
        if (r < I_QKV) { p0_transpose_item(a.in[17], DMODEL, NQKV, (bf16*)(ws + WS_WQKV), 0, 0, scr, r, lane); continue; } r -= I_QKV;
        if (r < I_O) { p0_transpose_item(a.in[23], DMODEL, DMODEL, (bf16*)(ws + WS_WO), 0, 0, scr, r, lane); continue; } r -= I_O;
        { const int g = r / I_P; p0_transpose_item(a.in[5] + (size_t)g * 65536, 256, 256, (bf16*)(ws + WS_PW), 0, g * 256, scr, r % I_P, lane); }
    }
    const GAS f32x4* x4 = (const GAS f32x4*)a.in[0]; GAS v4u* xb = (GAS v4u*)(ws + WS_XB);
    const size_t n8 = (size_t)MROWS * DMODEL / 8, nthr = (size_t)NGW * 64;
#pragma unroll 4
    for (size_t i = (size_t)gw * 64 + lane; i < n8; i += nthr) { const f32x4 p = x4[2 * i], q = x4[2 * i + 1];
        v4u o; o.x = pk2(p.x, p.y); o.y = pk2(p.z, p.w); o.z = pk2(q.x, q.y); o.w = pk2(q.z, q.w); xb[i] = o; }
}
template <int R, bool IN_F32, bool OUT_F32> __device__ __forceinline__ void ln_pass(const float* xin, const bf16* Y, const float* g, const float* b, float* xout, bf16* XB, unsigned char* XL, int gw, int NGW, int lane) {
    f32x4 gv[4], bv[4];
#pragma unroll
    for (int j = 0; j < 4; ++j) { const int c4 = (j >> 1) * 128 + lane * 2 + (j & 1); gv[j] = ((const GAS f32x4*)g)[c4]; bv[j] = ((const GAS f32x4*)b)[c4]; }
    for (int m0 = gw * R; m0 < MROWS; m0 += NGW * R) {
        f32x4 v[R][4]; v4u yy[R][2]; float s[R], s2[R];
        if (IN_F32) {
#pragma unroll
            for (int r = 0; r < R; ++r) { const GAS f32x4* xr = (const GAS f32x4*)(xin + (size_t)(m0 + r) * DMODEL) + lane * 2; const GAS v4u* yr = (const GAS v4u*)(Y + (size_t)(m0 + r) * DMODEL) + lane;
                v[r][0] = xr[0]; v[r][1] = xr[1]; v[r][2] = xr[128]; v[r][3] = xr[129]; yy[r][0] = yr[0]; yy[r][1] = yr[64]; }
        } else {
            v4u hh[R][2]; v2u ll[R][2];
#pragma unroll
            for (int r = 0; r < R; ++r) { const GAS v4u* hr = (const GAS v4u*)(XB + (size_t)(m0 + r) * DMODEL) + lane; const GAS v2u* lr = (const GAS v2u*)(XL + (size_t)(m0 + r) * DMODEL) + lane; const GAS v4u* yr = (const GAS v4u*)(Y + (size_t)(m0 + r) * DMODEL) + lane;
                hh[r][0] = hr[0]; hh[r][1] = hr[64]; ll[r][0] = lr[0]; ll[r][1] = lr[64]; yy[r][0] = yr[0]; yy[r][1] = yr[64]; }
#pragma unroll
            for (int r = 0; r < R; ++r)
#pragma unroll
                for (int h = 0; h < 2; ++h) { const unsigned hw[4] = {hh[r][h].x, hh[r][h].y, hh[r][h].z, hh[r][h].w}; const int lw[2] = {(int)ll[r][h].x, (int)ll[r][h].y};
#pragma unroll
                    for (int q = 0; q < 2; ++q) { const float c = 1.0f / 512.0f;
                        v[r][2 * h + q] = (f32x4){__uint_as_float(hw[2 * q] << 16) + __builtin_amdgcn_cvt_f32_fp8(lw[q], 0) * c, __uint_as_float(hw[2 * q] & 0xffff0000u) + __builtin_amdgcn_cvt_f32_fp8(lw[q], 1) * c,
                                                  __uint_as_float(hw[2 * q + 1] << 16) + __builtin_amdgcn_cvt_f32_fp8(lw[q], 2) * c, __uint_as_float(hw[2 * q + 1] & 0xffff0000u) + __builtin_amdgcn_cvt_f32_fp8(lw[q], 3) * c}; } }
        }
#pragma unroll
        for (int r = 0; r < R; ++r) { const unsigned yw[8] = {yy[r][0].x, yy[r][0].y, yy[r][0].z, yy[r][0].w, yy[r][1].x, yy[r][1].y, yy[r][1].z, yy[r][1].w}; s[r] = 0.f;
#pragma unroll
            for (int j = 0; j < 4; ++j) { const f32x4 yv = (f32x4){__uint_as_float(yw[2 * j] << 16), __uint_as_float(yw[2 * j] & 0xffff0000u), __uint_as_float(yw[2 * j + 1] << 16), __uint_as_float(yw[2 * j + 1] & 0xffff0000u)};
                v[r][j] = v[r][j] * DN_ALPHA + yv; s[r] += (v[r][j].x + v[r][j].y) + (v[r][j].z + v[r][j].w); } }
#pragma unroll
        for (int o = 1; o < 64; o <<= 1)
#pragma unroll
            for (int r = 0; r < R; ++r) s[r] += __shfl_xor(s[r], o);
#pragma unroll
        for (int r = 0; r < R; ++r) { const float mean = s[r] * (1.f / DMODEL); s2[r] = 0.f;
#pragma unroll
            for (int j = 0; j < 4; ++j) { v[r][j] = v[r][j] - mean; s2[r] += (v[r][j].x * v[r][j].x + v[r][j].y * v[r][j].y) + (v[r][j].z * v[r][j].z + v[r][j].w * v[r][j].w); } }
#pragma unroll
        for (int o = 1; o < 64; o <<= 1)
#pragma unroll
            for (int r = 0; r < R; ++r) s2[r] += __shfl_xor(s2[r], o);
#pragma unroll
        for (int r = 0; r < R; ++r) { const float rstd = 1.f / sqrtf(s2[r] * (1.f / DMODEL) + LN_EPS);
#pragma unroll
            for (int j = 0; j < 4; ++j) v[r][j] = v[r][j] * rstd * gv[j] + bv[j];
            if (OUT_F32) { GAS f32x4* xo = (GAS f32x4*)(xout + (size_t)(m0 + r) * DMODEL) + lane * 2; xo[0] = v[r][0]; xo[1] = v[r][1]; xo[128] = v[r][2]; xo[129] = v[r][3]; }
            else { GAS v4u* o8 = (GAS v4u*)(XB + (size_t)(m0 + r) * DMODEL) + lane; GAS v2u* l8 = (GAS v2u*)(XL + (size_t)(m0 + r) * DMODEL) + lane;
#pragma unroll
                for (int h = 0; h < 2; ++h) { unsigned hw[4]; int lw[2];
#pragma unroll
                    for (int q = 0; q < 2; ++q) { const f32x4 x = v[r][2 * h + q]; hw[2 * q] = pk2(x.x, x.y); hw[2 * q + 1] = pk2(x.z, x.w);
                        const float l0 = (x.x - __uint_as_float(hw[2 * q] << 16)) * 512.f, l1 = (x.y - __uint_as_float(hw[2 * q] & 0xffff0000u)) * 512.f, l2 = (x.z - __uint_as_float(hw[2 * q + 1] << 16)) * 512.f, l3 = (x.w - __uint_as_float(hw[2 * q + 1] & 0xffff0000u)) * 512.f;
                        int p = __builtin_amdgcn_cvt_pk_fp8_f32(l0, l1, 0, false); lw[q] = __builtin_amdgcn_cvt_pk_fp8_f32(l2, l3, p, true); }
                    o8[64 * h] = (v4u){hw[0], hw[1], hw[2], hw[3]}; l8[64 * h] = (v2u){(unsigned)lw[0], (unsigned)lw[1]}; } }
        }
    }
}
__device__ __forceinline__ void ln_pool_pass(const bf16* Zp, const float* pscale, const float* g, const float* b, bf16* XB, unsigned char* XL, int gw, int NGW, int lane) {
    f32x4 gv[4], bv[4], pv[4];
#pragma unroll
    for (int j = 0; j < 4; ++j) { const int c4 = (j >> 1) * 128 + lane * 2 + (j & 1); gv[j] = ((const GAS f32x4*)g)[c4]; bv[j] = ((const GAS f32x4*)b)[c4]; pv[j] = ((const GAS f32x4*)pscale)[c4]; }
    const int wA = lane < 32 ? 2 : 4, wB = lane < 32 ? 8 : 16;
#define BF4LO(q) ((f32x4){__uint_as_float((q).x << 16), __uint_as_float((q).x & 0xffff0000u), __uint_as_float((q).y << 16), __uint_as_float((q).y & 0xffff0000u)})
#define BF4HI(q) ((f32x4){__uint_as_float((q).z << 16), __uint_as_float((q).z & 0xffff0000u), __uint_as_float((q).w << 16), __uint_as_float((q).w & 0xffff0000u)})
    for (int c = gw; c < MROWS / 32; c += NGW) {
        const int r0 = c * 32, t0 = r0 & (SEQL - 1);
        const GAS v4u* zp = (const GAS v4u*)(Zp + (size_t)r0 * DMODEL) + lane;
        f32x4 s[4] = {(f32x4){0.f, 0.f, 0.f, 0.f}, (f32x4){0.f, 0.f, 0.f, 0.f}, (f32x4){0.f, 0.f, 0.f, 0.f}, (f32x4){0.f, 0.f, 0.f, 0.f}};
        if (t0 > 0) for (int i = 1; i <= 16; ++i) { const v4u qa = zp[-(long)(i <= wA ? i : 1) * 128], qb = zp[-(long)(i <= wB ? i : 1) * 128 + 64]; const float ma = i <= wA ? 1.f : 0.f, mb = i <= wB ? 1.f : 0.f;
            s[0] += BF4LO(qa) * ma; s[1] += BF4HI(qa) * ma; s[2] += BF4LO(qb) * mb; s[3] += BF4HI(qb) * mb; }
        for (int j0 = 0; j0 < 32; j0 += 2) {
            v4u hh[2][2], zc[2][2], zo[2][2]; v2u ll[2][2]; f32x4 v[2][4]; float sm[2], s2[2];
#pragma unroll
            for (int r = 0; r < 2; ++r) { const int j = j0 + r, t = t0 + j; const size_t m = (size_t)(r0 + j);
                const GAS v4u* hr = (const GAS v4u*)(XB + m * DMODEL) + lane; const GAS v2u* lr = (const GAS v2u*)(XL + m * DMODEL) + lane;
                hh[r][0] = hr[0]; hh[r][1] = hr[64]; ll[r][0] = lr[0]; ll[r][1] = lr[64];
                zc[r][0] = zp[(long)j * 128]; zc[r][1] = zp[(long)j * 128 + 64];
                zo[r][0] = zp[(long)(t >= wA ? j - wA : j) * 128]; zo[r][1] = zp[(long)(t >= wB ? j - wB : j) * 128 + 64]; }
#pragma unroll
            for (int r = 0; r < 2; ++r) { const int t = t0 + j0 + r; const float ma = t >= wA ? 1.f : 0.f, mb = t >= wB ? 1.f : 0.f;
                const float rca = 1.0f / (float)(t + 1 < wA ? t + 1 : wA), rcb = 1.0f / (float)(t + 1 < wB ? t + 1 : wB);
                const f32x4 z0 = BF4LO(zc[r][0]), z1 = BF4HI(zc[r][0]), z2 = BF4LO(zc[r][1]), z3 = BF4HI(zc[r][1]);
                s[0] += z0 - BF4LO(zo[r][0]) * ma; s[1] += z1 - BF4HI(zo[r][0]) * ma; s[2] += z2 - BF4LO(zo[r][1]) * mb; s[3] += z3 - BF4HI(zo[r][1]) * mb;
                const f32x4 y[4] = {(s[0] * rca - z0) * pv[0], (s[1] * rca - z1) * pv[1], (s[2] * rcb - z2) * pv[2], (s[3] * rcb - z3) * pv[3]};
                sm[r] = 0.f;
#pragma unroll
                for (int h = 0; h < 2; ++h) { const unsigned hw[4] = {hh[r][h].x, hh[r][h].y, hh[r][h].z, hh[r][h].w}; const int lw[2] = {(int)ll[r][h].x, (int)ll[r][h].y};
#pragma unroll
                    for (int q = 0; q < 2; ++q) { const float cc = 1.0f / 512.0f;
                        const f32x4 x = (f32x4){__uint_as_float(hw[2 * q] << 16) + __builtin_amdgcn_cvt_f32_fp8(lw[q], 0) * cc, __uint_as_float(hw[2 * q] & 0xffff0000u) + __builtin_amdgcn_cvt_f32_fp8(lw[q], 1) * cc,
                                                 __uint_as_float(hw[2 * q + 1] << 16) + __builtin_amdgcn_cvt_f32_fp8(lw[q], 2) * cc, __uint_as_float(hw[2 * q + 1] & 0xffff0000u) + __builtin_amdgcn_cvt_f32_fp8(lw[q], 3) * cc};
                        v[r][2 * h + q] = x * DN_ALPHA + y[2 * h + q]; sm[r] += (v[r][2 * h + q].x + v[r][2 * h + q].y) + (v[r][2 * h + q].z + v[r][2 * h + q].w); } } }
#pragma unroll
            for (int o = 1; o < 64; o <<= 1)
#pragma unroll
                for (int r = 0; r < 2; ++r) sm[r] += __shfl_xor(sm[r], o);
#pragma unroll
            for (int r = 0; r < 2; ++r) { const float mean = sm[r] * (1.f / DMODEL); s2[r] = 0.f;
#pragma unroll
                for (int j = 0; j < 4; ++j) { v[r][j] = v[r][j] - mean; s2[r] += (v[r][j].x * v[r][j].x + v[r][j].y * v[r][j].y) + (v[r][j].z * v[r][j].z + v[r][j].w * v[r][j].w); } }
#pragma unroll
            for (int o = 1; o < 64; o <<= 1)
#pragma unroll
                for (int r = 0; r < 2; ++r) s2[r] += __shfl_xor(s2[r], o);
#pragma unroll
            for (int r = 0; r < 2; ++r) { const float rstd = 1.f / sqrtf(s2[r] * (1.f / DMODEL) + LN_EPS); const size_t m = (size_t)(r0 + j0 + r);
#pragma unroll
                for (int j = 0; j < 4; ++j) v[r][j] = v[r][j] * rstd * gv[j] + bv[j];
                GAS v4u* o8 = (GAS v4u*)(XB + m * DMODEL) + lane; GAS v2u* l8 = (GAS v2u*)(XL + m * DMODEL) + lane;
#pragma unroll
                for (int h = 0; h < 2; ++h) { unsigned hw[4]; int lw[2];
#pragma unroll
                    for (int q = 0; q < 2; ++q) { const f32x4 x = v[r][2 * h + q]; hw[2 * q] = pk2(x.x, x.y); hw[2 * q + 1] = pk2(x.z, x.w);
                        const float l0 = (x.x - __uint_as_float(hw[2 * q] << 16)) * 512.f, l1 = (x.y - __uint_as_float(hw[2 * q] & 0xffff0000u)) * 512.f, l2 = (x.z - __uint_as_float(hw[2 * q + 1] << 16)) * 512.f, l3 = (x.w - __uint_as_float(hw[2 * q + 1] & 0xffff0000u)) * 512.f;
                        int p = __builtin_amdgcn_cvt_pk_fp8_f32(l0, l1, 0, false); lw[q] = __builtin_amdgcn_cvt_pk_fp8_f32(l2, l3, p, true); }
                    o8[64 * h] = (v4u){hw[0], hw[1], hw[2], hw[3]}; l8[64 * h] = (v2u){(unsigned)lw[0], (unsigned)lw[1]}; } }
        }
    }
#undef BF4LO
#undef BF4HI
}
__device__ __forceinline__ void pool_diff_pass(const bf16* XB, const unsigned char* XL, bf16* DB, int gw, int NGW, int lane) {
#define XLOAD(roff) ({ const v2u h_ = hc[(long)(roff) * 256]; const int l_ = (int)lc[(long)(roff) * 256]; const float c_ = 1.0f / 512.0f; \
        (f32x4){__uint_as_float(h_.x << 16) + __builtin_amdgcn_cvt_f32_fp8(l_, 0) * c_, __uint_as_float(h_.x & 0xffff0000u) + __builtin_amdgcn_cvt_f32_fp8(l_, 1) * c_, \
                __uint_as_float(h_.y << 16) + __builtin_amdgcn_cvt_f32_fp8(l_, 2) * c_, __uint_as_float(h_.y & 0xffff0000u) + __builtin_amdgcn_cvt_f32_fp8(l_, 3) * c_}; })
    for (int it = gw; it < (MROWS / 32) * 4; it += NGW) {
        const int g = it & 3, r0 = (it >> 2) * 32, t0 = r0 & (SEQL - 1), w = 2 << g;
        const GAS v2u* hc = (const GAS v2u*)(XB + (size_t)r0 * DMODEL + g * 256) + lane;
        const GAS unsigned* lc = (const GAS unsigned*)(XL + (size_t)r0 * DMODEL + g * 256) + lane;
        GAS v2u* dc = (GAS v2u*)(DB + (size_t)r0 * DMODEL + g * 256) + lane;
        f32x4 s = (f32x4){0.f, 0.f, 0.f, 0.f};
        if (t0 > 0) for (int i = 1; i <= w; ++i) s += XLOAD(-i);
        const float rw = 1.0f / (float)w;
        for (int j0 = 0; j0 < 32; j0 += 8) { f32x4 xv[8], xo[8];
#pragma unroll
            for (int k = 0; k < 8; ++k) { const int j = j0 + k, t = t0 + j; xv[k] = XLOAD(j); xo[k] = XLOAD(t >= w ? j - w : j); }
#pragma unroll
            for (int k = 0; k < 8; ++k) { const int j = j0 + k, t = t0 + j; s += xv[k]; if (t >= w) s -= xo[k];
                const float rc = t + 1 < w ? 1.0f / (float)(t + 1) : rw;
                const f32x4 d = s * rc - xv[k]; v2u o; o.x = pk2(d.x, d.y); o.y = pk2(d.z, d.w); dc[(long)j * 256] = o; } }
    }
#undef XLOAD
}
__device__ __forceinline__ void attn_combine_pass(const bf16* OP, const float* lq1, const float* lk1, const float* lq2, const float* lk2, const float* sg, bf16* OB, int gw, int NGW, int lane) {
    const float lam = __expf(wave_sum(lq1[lane] * lk1[lane])) - __expf(wave_sum(lq2[lane] * lk2[lane])) + LAMBDA_INIT;
    float gl[16];
#pragma unroll
    for (int i = 0; i < 16; ++i) gl[i] = sg[(lane & 7) * 16 + i] * (1.0f - LAMBDA_INIT);
    for (int m0 = gw * 4; m0 < MROWS; m0 += NGW * 4) {
        v4u A0[4], A1[4], B0[4], B1[4];
#pragma unroll
        for (int r = 0; r < 4; ++r) { const GAS v4u* p1 = (const GAS v4u*)(OP + (size_t)(m0 + r) * 2048) + lane * 2; const GAS v4u* p2 = p1 + 128; A0[r] = p1[0]; A1[r] = p1[1]; B0[r] = p2[0]; B1[r] = p2[1]; }
#pragma unroll
        for (int r = 0; r < 4; ++r) { const int m = m0 + r; const v4u a0 = A0[r], a1 = A1[r], b0 = B0[r], b1 = B1[r];
        unsigned aw[8] = {a0.x, a0.y, a0.z, a0.w, a1.x, a1.y, a1.z, a1.w}, bw[8] = {b0.x, b0.y, b0.z, b0.w, b1.x, b1.y, b1.z, b1.w};
        float o[16]; float ss = 0.f;
#pragma unroll
        for (int i = 0; i < 8; ++i) { const float x0 = __uint_as_float(aw[i] << 16), x1 = __uint_as_float(aw[i] & 0xffff0000u), y0 = __uint_as_float(bw[i] << 16), y1 = __uint_as_float(bw[i] & 0xffff0000u);
            o[2 * i] = x0 - lam * y0; o[2 * i + 1] = x1 - lam * y1; ss += o[2 * i] * o[2 * i] + o[2 * i + 1] * o[2 * i + 1]; }
        ss += __shfl_xor(ss, 1); ss += __shfl_xor(ss, 2); ss += __shfl_xor(ss, 4);
        const float rs = 1.0f / sqrtf(ss * (1.0f / 128.0f) + RMS_EPS);
        v4u w0, w1;
        w0.x = pk2(o[0] * rs * gl[0], o[1] * rs * gl[1]); w0.y = pk2(o[2] * rs * gl[2], o[3] * rs * gl[3]); w0.z = pk2(o[4] * rs * gl[4], o[5] * rs * gl[5]); w0.w = pk2(o[6] * rs * gl[6], o[7] * rs * gl[7]);
        w1.x = pk2(o[8] * rs * gl[8], o[9] * rs * gl[9]); w1.y = pk2(o[10] * rs * gl[10], o[11] * rs * gl[11]); w1.z = pk2(o[12] * rs * gl[12], o[13] * rs * gl[13]); w1.w = pk2(o[14] * rs * gl[14], o[15] * rs * gl[15]);
        GAS v4u* q = (GAS v4u*)(OB + (size_t)m * DMODEL) + lane * 2; q[0] = w0; q[1] = w1; }
    }
}

#define XB_TMO      128
#define XB_XCNT(j)  (256  + 64 * (j))
#define XB_XSUB(j)  (1280 + 64 * (j))
#define XB_XGEN(j)  (2304 + 64 * (j))
#define XB_TOP      3328
#define XB_TOPGEN   3392
#define XCD_BAR_WORDS 3456
#define XB_SPIN_CAP (1u << 18)

__device__ __forceinline__ unsigned xb_ld(unsigned* p)              { return __hip_atomic_load(p, __ATOMIC_RELAXED, __HIP_MEMORY_SCOPE_AGENT); }
__device__ __forceinline__ unsigned xb_add(unsigned* p, unsigned v) { return __hip_atomic_fetch_add(p, v, __ATOMIC_RELAXED, __HIP_MEMORY_SCOPE_AGENT); }
__device__ __forceinline__ unsigned xb_xcc_id() { return (unsigned)__builtin_amdgcn_s_getreg((3 << 11) | 20) & 0xFu; }
#define XB_SPIN(cond, bar) do { unsigned _sp = 0; while (cond) { __builtin_amdgcn_s_sleep(1); \
    if ((++_sp & 255u) == 0u) { if (xb_ld(&(bar)[XB_TMO])) break; if (_sp > XB_SPIN_CAP) { atomicAdd(&(bar)[XB_TMO], 1u); break; } } } } while (0)

struct XcdBarrier {
    unsigned* bar; unsigned x;
    volatile LAS unsigned* st;
};

__device__ __forceinline__ XcdBarrier xcd_barrier_post(unsigned* bar, volatile LAS unsigned* st) {
    XcdBarrier b; b.bar = bar; b.x = xb_xcc_id(); b.st = st;
    if (threadIdx.x == 0) (void)xb_add(&bar[XB_XCNT(b.x)], 1u);
    return b;
}
__device__ __forceinline__ void xcd_barrier_complete(unsigned* bar, unsigned x, unsigned& nloc, unsigned& nx) {
    const unsigned G = gridDim.x * gridDim.y * gridDim.z;
    unsigned sum, cnt, mine, sp = 0u;
    for (;;) {
        sum = 0u; cnt = 0u; mine = 0u;
#pragma unroll
        for (unsigned j = 0; j < 16; ++j) { const unsigned c = xb_ld(&bar[XB_XCNT(j)]); sum += c; cnt += (c > 0u) ? 1u : 0u; mine = (j == x) ? c : mine; }
        if (sum == G) break;
        __builtin_amdgcn_s_sleep(1);
        if ((++sp & 255u) == 0u) { if (xb_ld(&bar[XB_TMO])) break; if (sp > XB_SPIN_CAP) { atomicAdd(&bar[XB_TMO], 1u); break; } }
    }
    nloc = mine > 0u ? mine : 1u; nx = cnt > 0u ? cnt : 1u;
}

__device__ __forceinline__ void xcd_barrier(const XcdBarrier& b) {
    asm volatile("s_waitcnt vmcnt(0)" ::: "memory");
    __syncthreads();
    if (threadIdx.x == 0) {
        unsigned* bar = b.bar;
        __builtin_amdgcn_s_waitcnt(0);
        unsigned nloc = b.st[0], nx = b.st[1];
        if (nloc == 0u) { xcd_barrier_complete(bar, b.x, nloc, nx); b.st[0] = nloc; b.st[1] = nx; }
        const unsigned old = xb_add(&bar[XB_XSUB(b.x)], 1u);
        const unsigned gen = old / nloc;
        if (old + 1u == (gen + 1u) * nloc) {
            __builtin_amdgcn_fence(__ATOMIC_RELEASE, "agent");
            asm volatile("s_waitcnt vmcnt(0)" ::: "memory");
            const unsigned og = xb_add(&bar[XB_TOP], 1u);
            const unsigned tg = og / nx;
            if (og + 1u == (tg + 1u) * nx) xb_add(&bar[XB_TOPGEN], 1u);
            else XB_SPIN(xb_ld(&bar[XB_TOPGEN]) == tg, bar);
            __builtin_amdgcn_fence(__ATOMIC_ACQUIRE, "agent");
            xb_add(&bar[XB_XGEN(b.x)], 1u);
            asm volatile("s_waitcnt vmcnt(0)" ::: "memory");
        } else {
            XB_SPIN(xb_ld(&bar[XB_XGEN(b.x)]) == gen, bar);
            __builtin_amdgcn_fence(__ATOMIC_ACQUIRE, "agent");
            asm volatile("s_waitcnt vmcnt(0)" ::: "memory");
        }
    }
    __syncthreads();
}

__device__ __forceinline__ void norm_pass(const bf16* QKV, unsigned* tab, int gw, int NGW, int lane) {
    for (int c = gw; c < MROWS / 32; c += NGW) {
        const int r0 = c * 32, b = r0 / SEQL; float mx[4] = {0.f, 0.f, 0.f, 0.f};
#pragma unroll 4
        for (int i = 0; i < 32; ++i) { const GAS v4u* p = (const GAS v4u*)(QKV + (size_t)(r0 + i) * NQKV) + lane;
#pragma unroll
            for (int j = 0; j < 4; ++j) { const v4u w = p[64 * j]; float ss = 0.f; const unsigned ww[4] = {w.x, w.y, w.z, w.w};
#pragma unroll
                for (int k = 0; k < 4; ++k) { const float lo = __uint_as_float(ww[k] << 16), hi = __uint_as_float(ww[k] & 0xffff0000u); ss += lo * lo + hi * hi; }
                ss += __shfl_xor(ss, 1); ss += __shfl_xor(ss, 2); ss += __shfl_xor(ss, 4); mx[j] = fmaxf(mx[j], ss); } }
        if ((lane & 7) == 0) {
#pragma unroll
            for (int j = 0; j < 4; ++j) atomicMax(tab + b * 32 + j * 8 + (lane >> 3), __float_as_uint(mx[j])); }
    }
}

__global__ void __launch_bounds__(NWAVES * 64, 2) mk_fwd(Args args) {
    extern __shared__ __attribute__((aligned(16))) unsigned char lds[];
    cg::grid_group grid = cg::this_grid();
    LAS unsigned char* L = (LAS unsigned char*)lds;
    const int wave = __builtin_amdgcn_readfirstlane((int)threadIdx.x >> 6);
#define lane ({ int t_ = threadIdx.x; asm volatile("" : "+v"(t_)); t_ & 63; })
    const int G = gridDim.x, bx = blockIdx.x, vcu = (G % 8 == 0) ? (bx % 8) * (G / 8) + bx / 8 : bx;
    const int gw = vcu * NWAVES + wave, NGW = G * NWAVES;
    unsigned char* ws = args.ws;
    unsigned char* XL = ws + WS_XL; bf16* Y = (bf16*)(ws + WS_Z); bf16* XB = (bf16*)(ws + WS_XB); bf16* H = (bf16*)(ws + WS_H);
#define GEMM_SWIGLU(f) do { pg8::Gemm g_{XB, (const bf16*)(ws + WS_WIN + (f) * WIN_BYTES), MROWS, 2 * DFF, DMODEL, DMODEL, DMODEL, 0}; pg8::StaticOrder S_; S_.init(MROWS, 2 * DFF, G, bx); \
        pg8::EpiSwiglu E_{H, DFF}; pg8::gemm_phase<pg8::EpiSwiglu, pg8::StaticOrder, PG8_ALIGN, PG8_SP2>(L, g_, S_, E_); } while (0)
#define GEMM_DOWN(f) do { pg8::Gemm g_{H, (const bf16*)(ws + WS_WOUT + (f) * WOUT_BYTES), MROWS, DMODEL, DFF, DFF, DFF, 0}; pg8::StaticOrder S_; S_.init(MROWS, DMODEL, G, bx, 1); \
        pg8::EpiScaleBf16 E_{Y, nullptr, 0.5f}; pg8::gemm_phase<pg8::EpiScaleBf16, pg8::StaticOrder, PG8_ALIGN, PG8_SP2>(L, g_, S_, E_); } while (0)
#define FFN(f, ig, ib, INF, OUTF) do { GEMM_SWIGLU(f); SYNC(); GEMM_DOWN(f); SYNC(); ln_pass<4, INF, OUTF>(args.in[0], Y, args.in[ig], args.in[ib], args.out, XB, XL, gw, NGW, lane); SYNC(); } while (0)

    unsigned* ctl = (unsigned*)ws;
    volatile LAS unsigned* bst = (volatile LAS unsigned*)(L + 141 * 1024);
    if (threadIdx.x < 2) bst[threadIdx.x] = 0u;
    if (bx == 0) for (int i = threadIdx.x; i < 8192; i += NWAVES * 64) ctl[i] = 0u;
    prologue(args, L, gw, NGW, wave, lane);
    __syncthreads(); grid.sync();
    const XcdBarrier xbar = xcd_barrier_post(ctl + 4096, bst);
#define SYNC() xcd_barrier(xbar)
    FFN(0, 3, 4, true, false);
    { pg8::Gemm g_{XB, (const bf16*)(ws + WS_PW), MROWS, DMODEL, 256, DMODEL, 256, 512}; pg8::StaticOrder S_; S_.init(MROWS, DMODEL, G, bx);
      pg8::EpiScaleBf16 E_{Y, nullptr, 1.0f}; pg8::gemm_phase<pg8::EpiScaleBf16, pg8::StaticOrder, PG8_ALIGN, PG8_SP2>(L, g_, S_, E_); }
    SYNC(); ln_pool_pass(Y, args.in[6], args.in[7], args.in[8], XB, XL, gw, NGW, lane); SYNC();
    FFN(1, 11, 12, false, false);
    FFN(2, 15, 16, false, false);
    { pg8::Gemm g_{XB, (const bf16*)(ws + WS_WQKV), MROWS, NQKV, DMODEL, DMODEL, DMODEL, 0}; pg8::StaticOrder S_; S_.init(MROWS, NQKV, G, bx);
      pg8::EpiBf16<0> E_{H, NQKV, nullptr, 1024, 1024, attn_body::C2}; pg8::gemm_phase<pg8::EpiBf16<0>, pg8::StaticOrder, PG8_ALIGN, PG8_SP2>(L, g_, S_, E_); }
    SYNC();
    norm_pass(H, ctl, gw, NGW, lane); SYNC();
    attn_body::attn_phase<16>((char*)lds, (const attn_body::bf16*)H, (attn_body::bf16*)Y, ctl);
    SYNC();
    attn_combine_pass((const bf16*)Y, args.in[18], args.in[19], args.in[20], args.in[21], args.in[22], H, gw, NGW, lane);
    SYNC();
    { pg8::Gemm g_{H, (const bf16*)(ws + WS_WO), MROWS, DMODEL, DMODEL, DMODEL, DMODEL, 0}; pg8::StaticOrder S_; S_.init(MROWS, DMODEL, G, bx);
      pg8::EpiScaleBf16 E_{Y, nullptr, 1.0f}; pg8::gemm_phase<pg8::EpiScaleBf16, pg8::StaticOrder, PG8_ALIGN, PG8_SP2>(L, g_, S_, E_); }
    SYNC(); ln_pass<4, false, false>(nullptr, Y, args.in[24], args.in[25], nullptr, XB, XL, gw, NGW, lane); SYNC();
    FFN(3, 28, 29, false, true);
#undef lane
}

extern "C" void kernel_launch(void* const* d_in, const int* in_sizes, int n_in, void* d_out, int out_size, void* d_ws, size_t ws_size, hipStream_t stream) {
    static int grid = 0;
    if (grid == 0) {
        if (n_in != 30 || in_sizes[0] != MROWS * DMODEL || out_size != MROWS * DMODEL || ws_size < WS_END) { fprintf(stderr, "kernel_launch: unexpected shapes: n_in %d in0 %d out %d ws %zu\n", n_in, n_in > 0 ? in_sizes[0] : -1, out_size, ws_size); grid = -1; return; }
        int dev = 0, cus = 0, per_cu = 0;
        hipGetDevice(&dev); hipDeviceGetAttribute(&cus, hipDeviceAttributeMultiprocessorCount, dev);
        if (hipFuncSetAttribute((const void*)mk_fwd, hipFuncAttributeMaxDynamicSharedMemorySize, LDS_BYTES) != hipSuccess) { fprintf(stderr, "kernel_launch: hipFuncSetAttribute failed\n"); grid = -1; return; }
        if (hipOccupancyMaxActiveBlocksPerMultiprocessor(&per_cu, (const void*)mk_fwd, NWAVES * 64, LDS_BYTES) != hipSuccess || per_cu < 1) { fprintf(stderr, "kernel_launch: occupancy query says %d blocks per CU\n", per_cu); per_cu = 1; }
        (void)hipGetLastError();
        grid = cus * per_cu;
    }
    if (grid < 0) return;
    Args a{};
    for (int i = 0; i < 30; ++i) a.in[i] = (const float*)d_in[i];
    a.out = (float*)d_out; a.ws = (unsigned char*)d_ws;
    void* kargs[] = {&a};
    hipError_t e = hipLaunchCooperativeKernel((const void*)mk_fwd, dim3(grid), dim3(NWAVES * 64), kargs, LDS_BYTES, stream);
    if (e != hipSuccess) fprintf(stderr, "cooperative launch failed: %s (grid %d)\n", hipGetErrorString(e), grid);
}
```

```cpp
#include <hip/hip_runtime.h>
#include <hip/hip_cooperative_groups.h>
#include <cstdio>
#include <cstdint>
namespace cg = cooperative_groups;
namespace pg8 {
#define PG8_LAS __attribute__((address_space(3)))
typedef unsigned short bf16_t;
typedef short bf16x8 __attribute__((ext_vector_type(8)));
typedef float f32x4 __attribute__((ext_vector_type(4)));
typedef unsigned u32x4 __attribute__((ext_vector_type(4)));
constexpr int BM = 256, BK = 64, HALF = 128, HTB = HALF * BK * 2  , STAGE_BYTES = 8 * HTB, NXCD = 8, WGM = 8;

__host__ __device__ __forceinline__ int lds_byte(int r, int c) { const int st = (r >> 4) * 2 + (c >> 5), rr = r & 15, cc = c & 31, ob = rr * 64 + cc * 2; return st * 1024 + (ob ^ (((ob >> 9) & 1) << 5)); }
__host__ __device__ __forceinline__ void stage_rc(int b, int& R, int& C) { const int st = b / 1024, sb = b % 1024, swz = sb ^ (((sb >> 9) & 1) << 5); R = (st >> 1) * 16 + swz / 64; C = (st & 1) * 32 + (swz % 64) / 2; }
__host__ __device__ __forceinline__ int perm32(int rho) { const int n = rho >> 4, i = rho & 15; return 8 * (i >> 2) + 4 * n + (i & 3); }

struct Unit { int pm, pn; };
struct Gemm { const bf16_t* A; const bf16_t* Bt; int M, N, K, lda, ldb, apn; };

struct StaticOrder {
    int nM, nN, nwg, G, c, rev;
    __host__ __device__ void init(int M, int N, int G_, int c_, int rev_ = 0) { nM = M / BM; nN = N / BM; nwg = nM * nN; G = G_; c = c_; rev = rev_; }
    __host__ __device__ bool next(int i, Unit& u) const {
        const long L = (long)i * G + c; if (L >= nwg) return false;
        int wgid = rev ? nwg - 1 - (int)L : (int)L; { const int q = nwg / NXCD, r = nwg % NXCD, xcd = wgid % NXCD, off = wgid / NXCD; wgid = (xcd < r ? xcd * (q + 1) : r * (q + 1) + (xcd - r) * q) + off; }
        const int nig = WGM * nN, gid = wgid / nig, fm = gid * WGM, gsz = (nM - fm) < WGM ? (nM - fm) : WGM;
        u.pm = fm + ((wgid % nig) % gsz); u.pn = (wgid % nig) / gsz; return true;
    }
    __device__ __forceinline__ void a_ready(const Unit&) const {}
    __device__ __forceinline__ void done(const Unit&) const {}
};

__device__ __forceinline__ unsigned cvt_pk_bf16(float lo, float hi) { unsigned r; asm volatile("v_cvt_pk_bf16_f32 %0, %1, %2" : "=v"(r) : "v"(lo), "v"(hi)); return r; }
typedef float f32x2 __attribute__((ext_vector_type(2)));
__device__ __forceinline__ f32x2 gelu_pk(f32x2 v) {
    const f32x2 av = __builtin_elementwise_abs(v), d = av * 0.2316418882f + 1.0f;
    f32x2 t; t.x = __builtin_amdgcn_rcpf(d.x); t.y = __builtin_amdgcn_rcpf(d.y);
    f32x2 q = t * 0.5307027145f + (-0.7265760135f); q = q * t + 0.7107068705f; q = q * t + (-0.142248368f); q = q * t + 0.127414796f; q = q * t;
    const f32x2 s = (v * v) * (-0.72134752044f);
    f32x2 e; e.x = __builtin_amdgcn_exp2f(s.x); e.y = __builtin_amdgcn_exp2f(s.y);
    const f32x2 m = v * (q * e), r = v - m;
    f32x2 o; o.x = v.x < 0.f ? m.x : r.x; o.y = v.y < 0.f ? m.y : r.y; return o;
}

template <int ACT  > struct EpiBf16 {
    static constexpr bool PERM = true, AFTER_DRAIN = false; static_assert(ACT == 0 || ACT == 1, "EpiBf16: ACT is 0 (none) or 1 (gelu_pk)");
    bf16_t* O; int ldc; const float* bias; int split_cols; size_t split_stride; float scale0;
    __device__ __forceinline__ void operator()(const f32x4 (&acc)[2][2][4][2], const Unit& u, int wr, int wc, int fr, int fq) const {
        const int row0 = u.pm * BM + wr * 64 + fr; int colt = u.pn * BM; bf16_t* base = O;
        float sc = 1.f; if (split_cols) { const int t = colt / split_cols; base += (size_t)t * split_stride; colt -= t * split_cols; if (t == 0) sc = scale0; }
        const int col0 = colt + wc * 32 + 8 * fq, bcol0 = u.pn * BM + wc * 32 + 8 * fq;
        f32x4 bv[2][2];
#pragma unroll
        for (int bj = 0; bj < 2; ++bj)
#pragma unroll
            for (int n = 0; n < 2; ++n) bv[bj][n] = bias ? *(const f32x4*)(bias + bcol0 + bj * HALF + 4 * n) : (f32x4){0.f, 0.f, 0.f, 0.f};
#pragma unroll
        for (int ai = 0; ai < 2; ++ai)
#pragma unroll
            for (int m = 0; m < 4; ++m) { bf16_t* rowp = base + (size_t)(row0 + ai * HALF + m * 16) * ldc + col0;
#pragma unroll
                for (int bj = 0; bj < 2; ++bj) { f32x4 v0 = acc[ai][bj][m][0] + bv[bj][0], v1 = acc[ai][bj][m][1] + bv[bj][1];
                    if (ACT == 1) { f32x2 a = gelu_pk((f32x2){v0[0], v0[1]}), b = gelu_pk((f32x2){v0[2], v0[3]}), c = gelu_pk((f32x2){v1[0], v1[1]}), d = gelu_pk((f32x2){v1[2], v1[3]});
                        v0 = (f32x4){a.x, a.y, b.x, b.y}; v1 = (f32x4){c.x, c.y, d.x, d.y}; }
                    v0 = v0 * sc; v1 = v1 * sc; u32x4 w; w.x = cvt_pk_bf16(v0[0], v0[1]); w.y = cvt_pk_bf16(v0[2], v0[3]); w.z = cvt_pk_bf16(v1[0], v1[1]); w.w = cvt_pk_bf16(v1[2], v1[3]);
                    *(u32x4*)(rowp + bj * HALF) = w; } }
    }
};
template <class Epi, class Sched, bool ALIGN_EPI = false, bool SP2 = false>
__device__ __forceinline__ void gemm_phase(PG8_LAS unsigned char* lds, const Gemm g, const Sched& S, const Epi& E) {
    int tid_ = threadIdx.x; asm volatile("" : "+v"(tid_));
    const int tid = tid_, wid = __builtin_amdgcn_readfirstlane(tid >> 6), lane = tid & 63, wr = wid >> 2, wc = wid & 3, fr = lane & 15, fq = lane >> 4;
    const int K = g.K, nt = K / BK;
    unsigned voffA[2], voffB[2];
#pragma unroll
    for (int i = 0; i < 2; ++i) { int R, C; stage_rc(tid * 16 + i * 8192, R, C); const int Rb = Epi::PERM ? ((R & ~31) + perm32(R & 31)) : R;
        voffA[i] = (unsigned)(R * g.lda + C) * 2u; voffB[i] = (unsigned)(Rb * g.ldb + C) * 2u; }
    const size_t kstep = (size_t)(BK * 2);
    const size_t hstepA = (size_t)HALF * g.lda * 2, hstepB = (size_t)HALF * g.ldb * 2;
    const size_t tstepA = 2 * hstepA, tstepB = 2 * hstepB;
    const unsigned ldsw = (unsigned)wid * 1024u;
    const int aoff = lds_byte(wr * 64 + fr, fq * 8), boff = lds_byte(wc * 32 + fr, fq * 8);
#define PG8_SA(b, h) (((b) * 2 + (h)) * HTB)
#define PG8_SB(b, h) ((4 + (b) * 2 + (h)) * HTB)
#define PG8_STAGE(bufoff, gbase, voff) do { _Pragma("unroll") for (int _i = 0; _i < 2; ++_i) \
        __builtin_amdgcn_global_load_lds((const unsigned*)((const char*)(gbase) + (voff)[_i]), (PG8_LAS unsigned*)(lds + (bufoff) + ldsw + _i * 8192), 16, 0, 0); } while (0)
#define PG8_LDA(dst, b, h) do { _Pragma("unroll") for (int m = 0; m < 4; ++m) _Pragma("unroll") for (int k = 0; k < 2; ++k) dst[m][k] = *(const PG8_LAS bf16x8*)(lds + PG8_SA(b, h) + aoff + m * 2048 + k * 1024); } while (0)
#define PG8_LDB(dst, b, h) do { _Pragma("unroll") for (int n = 0; n < 2; ++n) _Pragma("unroll") for (int k = 0; k < 2; ++k) dst[n][k] = *(const PG8_LAS bf16x8*)(lds + PG8_SB(b, h) + boff + n * 2048 + k * 1024); } while (0)
#define PG8_MMA(ai, bj, At, Bt) do { __builtin_amdgcn_s_setprio(1); _Pragma("unroll") for (int m = 0; m < 4; ++m) _Pragma("unroll") for (int n = 0; n < 2; ++n) _Pragma("unroll") for (int k = 0; k < 2; ++k) \
        acc[ai][bj][m][n] = __builtin_amdgcn_mfma_f32_16x16x32_bf16(Bt[n][k], At[m][k], acc[ai][bj][m][n], 0, 0, 0); __builtin_amdgcn_s_setprio(0); } while (0)
#define PG8_WAIT_V(n) asm volatile("s_waitcnt vmcnt(" #n ")" ::: "memory")
#define PG8_WAIT_L(n) asm volatile("s_waitcnt lgkmcnt(" #n ")" ::: "memory")
#define PG8_BAR __builtin_amdgcn_s_barrier()
#define PG8_SCHED __builtin_amdgcn_sched_barrier(0)
    Unit cur, nxt; int ui = 0;
    if (!S.next(0, cur)) return;
    f32x4 acc[2][2][4][2];
#pragma unroll
    for (int a = 0; a < 2; ++a)
#pragma unroll
        for (int b = 0; b < 2; ++b)
#pragma unroll
            for (int m = 0; m < 4; ++m)
#pragma unroll
                for (int n = 0; n < 2; ++n) acc[a][b][m][n] = (f32x4){0.f, 0.f, 0.f, 0.f};
    bf16x8 At[4][2], B0[2][2], B1[2][2];
    const char* cA = (const char*)g.A + (size_t)cur.pm * tstepA + (size_t)cur.pn * g.apn; const char* cB = (const char*)g.Bt + (size_t)cur.pn * tstepB;
    S.a_ready(cur);
    if constexpr (SP2) {
        PG8_STAGE(PG8_SB(0, 0), cB, voffB); PG8_STAGE(PG8_SB(0, 1), cB + hstepB, voffB); PG8_STAGE(PG8_SA(0, 0), cA, voffA); PG8_STAGE(PG8_SA(0, 1), cA + hstepA, voffA);
        if (wr == 1) PG8_BAR;
        PG8_WAIT_V(2); PG8_BAR;
        PG8_STAGE(PG8_SB(1, 0), cB + kstep, voffB); PG8_STAGE(PG8_SA(1, 0), cA + kstep, voffA); PG8_STAGE(PG8_SB(1, 1), cB + hstepB + kstep, voffB);
        PG8_WAIT_V(6); PG8_BAR;
    } else {
        PG8_STAGE(PG8_SB(0, 0), cB, voffB); PG8_STAGE(PG8_SA(0, 0), cA, voffA); PG8_STAGE(PG8_SB(0, 1), cB + hstepB, voffB); PG8_STAGE(PG8_SA(0, 1), cA + hstepA, voffA);
        if (wr == 1) PG8_BAR;
        PG8_WAIT_V(4); PG8_BAR;
        PG8_STAGE(PG8_SB(1, 0), cB + kstep, voffB); PG8_STAGE(PG8_SA(1, 0), cA + kstep, voffA); PG8_STAGE(PG8_SB(1, 1), cB + hstepB + kstep, voffB);
        PG8_WAIT_V(6); PG8_BAR;
    }
    for (;;) {
        const bool has_next = S.next(ui + 1, nxt);
        const char* nA = has_next ? (const char*)g.A + (size_t)nxt.pm * tstepA + (size_t)nxt.pn * g.apn : cA; const char* nB = has_next ? (const char*)g.Bt + (size_t)nxt.pn * tstepB : cB;
        for (int t = 0; t < nt; t += 2) {
            const bool last = (t == nt - 2);
            const char* a1 = cA + (size_t)(t + 1) * kstep;
            const char* a2 = last ? nA : cA + (size_t)(t + 2) * kstep; const char* b2 = last ? nB : cB + (size_t)(t + 2) * kstep;
            const char* a3 = a2 + kstep; const char* b3 = b2 + kstep;
            if (last && has_next) S.a_ready(nxt);
            if constexpr (SP2) {
            PG8_LDB(B0, 0, 0); PG8_LDB(B1, 0, 1); PG8_SCHED; PG8_LDA(At, 0, 0); PG8_STAGE(PG8_SA(1, 1), a1 + hstepA, voffA);
            PG8_WAIT_V(8); PG8_WAIT_L(0); PG8_BAR; PG8_MMA(0, 0, At, B0); PG8_MMA(0, 1, At, B1); PG8_BAR; PG8_SCHED;
            PG8_LDA(At, 0, 1); PG8_STAGE(PG8_SB(0, 0), b2, voffB); PG8_STAGE(PG8_SB(0, 1), b2 + hstepB, voffB); PG8_STAGE(PG8_SA(0, 0), a2, voffA);
            PG8_WAIT_V(8); PG8_WAIT_L(0); PG8_BAR; PG8_MMA(1, 0, At, B0); PG8_MMA(1, 1, At, B1); PG8_BAR; PG8_SCHED;
            PG8_LDB(B0, 1, 0); PG8_LDB(B1, 1, 1); PG8_SCHED; PG8_LDA(At, 1, 0); PG8_STAGE(PG8_SA(0, 1), a2 + hstepA, voffA);
            PG8_WAIT_V(8); PG8_WAIT_L(0); PG8_BAR; PG8_MMA(0, 0, At, B0); PG8_MMA(0, 1, At, B1); PG8_BAR; PG8_SCHED;
            PG8_LDA(At, 1, 1); PG8_STAGE(PG8_SB(1, 0), b3, voffB); PG8_STAGE(PG8_SB(1, 1), b3 + hstepB, voffB); PG8_STAGE(PG8_SA(1, 0), a3, voffA);
            PG8_WAIT_V(8); PG8_WAIT_L(0); PG8_BAR; PG8_MMA(1, 0, At, B0); PG8_MMA(1, 1, At, B1); PG8_BAR; PG8_SCHED;
            } else {
            PG8_LDB(B0, 0, 0); PG8_SCHED; PG8_LDA(At, 0, 0); PG8_STAGE(PG8_SA(1, 1), a1 + hstepA, voffA);
            PG8_WAIT_L(8); PG8_BAR; PG8_WAIT_L(0); PG8_MMA(0, 0, At, B0); PG8_BAR; PG8_SCHED;
            PG8_LDB(B1, 0, 1); PG8_STAGE(PG8_SB(0, 0), b2, voffB);
            PG8_BAR; PG8_WAIT_L(0); PG8_MMA(0, 1, At, B1); PG8_BAR;
            PG8_LDA(At, 0, 1); PG8_STAGE(PG8_SA(0, 0), a2, voffA);
            PG8_BAR; PG8_WAIT_L(0); PG8_MMA(1, 0, At, B0); PG8_BAR; PG8_SCHED;
            PG8_STAGE(PG8_SB(0, 1), b2 + hstepB, voffB);
            PG8_WAIT_V(6); PG8_BAR; PG8_MMA(1, 1, At, B1); PG8_BAR;
            PG8_LDB(B0, 1, 0); PG8_SCHED; PG8_LDA(At, 1, 0); PG8_STAGE(PG8_SA(0, 1), a2 + hstepA, voffA);
            PG8_WAIT_L(8); PG8_BAR; PG8_WAIT_L(0); PG8_MMA(0, 0, At, B0); PG8_BAR; PG8_SCHED;
            PG8_LDB(B1, 1, 1); PG8_STAGE(PG8_SB(1, 0), b3, voffB);
            PG8_BAR; PG8_WAIT_L(0); PG8_MMA(0, 1, At, B1); PG8_BAR;
            PG8_LDA(At, 1, 1); PG8_STAGE(PG8_SA(1, 0), a3, voffA);
            PG8_BAR; PG8_WAIT_L(0); PG8_MMA(1, 0, At, B0); PG8_BAR; PG8_SCHED;
            PG8_STAGE(PG8_SB(1, 1), b3 + hstepB, voffB);
            PG8_WAIT_V(6); PG8_BAR; PG8_MMA(1, 1, At, B1); PG8_BAR;
            }
        }
        if constexpr (ALIGN_EPI) { if (wr == 0) PG8_BAR; }
        if constexpr (!Epi::AFTER_DRAIN) { E(acc, cur, wr, wc, fr, fq); S.done(cur); }
        if (!has_next) break;
#pragma unroll
        for (int a = 0; a < 2; ++a)
#pragma unroll
            for (int b = 0; b < 2; ++b)
#pragma unroll
                for (int m = 0; m < 4; ++m)
#pragma unroll
                    for (int n = 0; n < 2; ++n) acc[a][b][m][n] = (f32x4){0.f, 0.f, 0.f, 0.f};
        cur = nxt; cA = nA; cB = nB; ++ui;
        if constexpr (ALIGN_EPI) { if (wr == 1) PG8_BAR; }
    }
    PG8_WAIT_V(0);
    if constexpr (!ALIGN_EPI) { if (wr == 0) PG8_BAR; }
    PG8_BAR;
    if constexpr (Epi::AFTER_DRAIN) { E.fused(acc, cur, wr, wc, fr, fq, lds, wid, lane); S.done(cur); }
#undef PG8_SA
#undef PG8_SB
#undef PG8_STAGE
#undef PG8_LDA
#undef PG8_LDB
#undef PG8_MMA
#undef PG8_WAIT_V
#undef PG8_WAIT_L
#undef PG8_BAR
#undef PG8_SCHED
}
}
namespace pg8 {
struct EpiSwiglu {
    static constexpr bool PERM = true, AFTER_DRAIN = false;
    bf16_t* H; int ldh;
    __device__ __forceinline__ void operator()(const f32x4 (&acc)[2][2][4][2], const Unit& u, int wr, int wc, int fr, int fq) const {
        const int row0 = u.pm * BM + wr * 64 + fr, col0 = u.pn * HALF + wc * 32 + 8 * fq;
#pragma unroll
        for (int ai = 0; ai < 2; ++ai)
#pragma unroll
            for (int m = 0; m < 4; ++m) { bf16_t* rowp = H + (size_t)(row0 + ai * HALF + m * 16) * ldh + col0;
                float hv[8];
#pragma unroll
                for (int n = 0; n < 2; ++n)
#pragma unroll
                    for (int i = 0; i < 4; ++i) { const float g = acc[ai][0][m][n][i], up = acc[ai][1][m][n][i];
                        const float e = __builtin_amdgcn_exp2f(g * -1.4426950408889634f); hv[n * 4 + i] = g * __builtin_amdgcn_rcpf(1.0f + e) * up; }
                u32x4 w; w.x = cvt_pk_bf16(hv[0], hv[1]); w.y = cvt_pk_bf16(hv[2], hv[3]); w.z = cvt_pk_bf16(hv[4], hv[5]); w.w = cvt_pk_bf16(hv[6], hv[7]);
                *(u32x4*)rowp = w; }
    }
};
struct EpiScaleBf16 {
    static constexpr bool PERM = true, AFTER_DRAIN = false;
    bf16_t* Y; const float* cscale; float cs;
    __device__ __forceinline__ void operator()(const f32x4 (&acc)[2][2][4][2], const Unit& u, int wr, int wc, int fr, int fq) const {
        const int row0 = u.pm * BM + wr * 64 + fr, col0 = u.pn * BM + wc * 32 + 8 * fq;
        f32x4 sc[2][2];
#pragma unroll
        for (int bj = 0; bj < 2; ++bj)
#pragma unroll
            for (int n = 0; n < 2; ++n) sc[bj][n] = cscale ? *(const f32x4*)(cscale + col0 + bj * HALF + 4 * n) : (f32x4){cs, cs, cs, cs};
#pragma unroll
        for (int ai = 0; ai < 2; ++ai)
#pragma unroll
            for (int m = 0; m < 4; ++m) { bf16_t* rowp = Y + (size_t)(row0 + ai * HALF + m * 16) * 1024 + col0;
#pragma unroll
                for (int bj = 0; bj < 2; ++bj) { const f32x4 v0 = acc[ai][bj][m][0] * sc[bj][0], v1 = acc[ai][bj][m][1] * sc[bj][1];
                    u32x4 w; w.x = cvt_pk_bf16(v0[0], v0[1]); w.y = cvt_pk_bf16(v0[2], v0[3]); w.z = cvt_pk_bf16(v1[0], v1[1]); w.w = cvt_pk_bf16(v1[2], v1[3]);
                    *(u32x4*)(rowp + bj * HALF) = w; } }
    }
};
struct EpiQKV {
    static constexpr bool PERM = true, AFTER_DRAIN = false;
    bf16_t* O; float qscale; unsigned* tab;
    __device__ __forceinline__ void operator()(const f32x4 (&acc)[2][2][4][2], const Unit& u, int wr, int wc, int fr, int fq) const {
        const int row0 = u.pm * BM + wr * 64 + fr, col0 = u.pn * BM + wc * 32 + 8 * fq; const float sc = u.pn < 4 ? qscale : 1.f; const bool nrm = u.pn < 8;
        float mx[2] = {0.f, 0.f};
#pragma unroll
        for (int ai = 0; ai < 2; ++ai)
#pragma unroll
            for (int m = 0; m < 4; ++m) { bf16_t* rowp = O + (size_t)(row0 + ai * HALF + m * 16) * 3072 + col0;
#pragma unroll
                for (int bj = 0; bj < 2; ++bj) { const f32x4 v0 = acc[ai][bj][m][0] * sc, v1 = acc[ai][bj][m][1] * sc;
                    u32x4 w; w.x = cvt_pk_bf16(v0[0], v0[1]); w.y = cvt_pk_bf16(v0[2], v0[3]); w.z = cvt_pk_bf16(v1[0], v1[1]); w.w = cvt_pk_bf16(v1[2], v1[3]);
                    *(u32x4*)(rowp + bj * HALF) = w;
                    if (nrm) { const unsigned ww[4] = {w.x, w.y, w.z, w.w}; float ss = 0.f;
#pragma unroll
                        for (int k = 0; k < 4; ++k) { const float lo = __uint_as_float(ww[k] << 16), hi = __uint_as_float(ww[k] & 0xffff0000u); ss += lo * lo + hi * hi; }
                        ss += __shfl_xor(ss, 16); ss += __shfl_xor(ss, 32); mx[bj] = fmaxf(mx[bj], ss); } } }
        if (nrm) {
#pragma unroll
            for (int bj = 0; bj < 2; ++bj) { float m = mx[bj]; m = fmaxf(m, __shfl_xor(m, 1)); m = fmaxf(m, __shfl_xor(m, 2)); m = fmaxf(m, __shfl_xor(m, 4)); m = fmaxf(m, __shfl_xor(m, 8));
                if ((fr | fq) == 0) atomicMax(tab + (u.pm >> 5) * 64 + (4 * u.pn + 2 * bj + (wc >> 1)) * 2 + (wc & 1), __float_as_uint(m)); } }
    }
};
}
#define PG8_SP2 true
#define PG8_ALIGN true
#include <hip/hip_bf16.h>
#include <cmath>
#include <hip/hip_bf16.h>
#include <cmath>
namespace attn_body {
using bf16=__hip_bfloat16;
using bf16x8=__attribute__((ext_vector_type(8)))short;
using s16x4=__attribute__((ext_vector_type(4)))short;
using f32x16=__attribute__((ext_vector_type(16)))float;
using u32x4=__attribute__((ext_vector_type(4)))unsigned;
constexpr int SEQ=8192,D=64,PQ=3072,PO=2048;
constexpr int NW=8,QBLK=32,QB=QBLK*NW,KVBLK=64,NQB=SEQ/QB;
constexpr int ATTN_UNIT_ROWS=QB;
__device__ __forceinline__ int crow(int r,int hi){return (r&3)+8*(r>>2)+4*hi;}
#define SBAR() __builtin_amdgcn_sched_barrier(0)
__device__ __forceinline__ void cmask(f32x16&p0,f32x16&p1,int jb,int qrel,int hi){
  const float NEG=-INFINITY; int kb=64*jb+4*hi;
  #pragma unroll
  for(int r=0;r<16;++r){int kv=kb+(r&3)+8*(r>>2); if(kv>qrel)p0[r]=NEG; if(kv+32>qrel)p1[r]=NEG;}
}

constexpr int NSLOT=3, SLOTB=8192;
constexpr int LDS_K=0, LDS_V=NSLOT*SLOTB, LDS_WS=3*NSLOT*SLOTB, LDS_OST=LDS_WS+NW*64*4, LDS_BYTES=LDS_OST+NW*8192;
constexpr float C2=0.125f*1.4426950408889634f;
__device__ __forceinline__ void glds16(const void*gsrc,unsigned lds_dst){unsigned keep;
  asm volatile("s_mov_b32 %0, m0\n\ts_mov_b32 m0, %2\n\ts_nop 0\n\tglobal_load_lds_dwordx4 %1, off\n\ts_mov_b32 m0, %0":"=&s"(keep):"v"(gsrc),"s"(lds_dst):"memory");}
template<int IMM> __device__ __forceinline__ void glds16s(const void*sbase,unsigned voff,unsigned lds_dst){unsigned keep;
  asm volatile("s_mov_b32 %0, m0\n\ts_mov_b32 m0, %3\n\ts_nop 0\n\tglobal_load_lds_dwordx4 %1, %2 offset:%c4\n\ts_mov_b32 m0, %0":"=&s"(keep):"v"(voff),"s"(sbase),"s"(lds_dst),"i"(IMM):"memory");}
__device__ __forceinline__ float max3f(float a,float b,float c){float r;asm("v_max3_f32 %0, %1, %2, %3":"=v"(r):"v"(a),"v"(b),"v"(c));return r;}
__device__ __forceinline__ float max2f(float a,float b){float r;asm("v_max_f32_e32 %0, %1, %2":"=v"(r):"v"(a),"v"(b));return r;}
__device__ __forceinline__ float fadd_s(float a,float b){float r;asm("v_add_f32_e32 %0, %1, %2":"=v"(r):"v"(a),"v"(b));return r;}
__device__ __forceinline__ float fsub_s(float a,float b){float r;asm("v_sub_f32_e32 %0, %1, %2":"=v"(r):"v"(a),"v"(b));return r;}
typedef float f32x2_t __attribute__((ext_vector_type(2))); typedef __bf16 bf16x2_t __attribute__((ext_vector_type(2)));
__device__ __forceinline__ unsigned cvtpk_s(float lo,float hi){f32x2_t v={lo,hi};bf16x2_t b=__builtin_convertvector(v,bf16x2_t);return __builtin_bit_cast(unsigned,b);}
#define WAIT_BAR(N) asm volatile("s_waitcnt vmcnt(" #N ") lgkmcnt(0)\n\ts_barrier":::"memory")

__device__ __forceinline__ void qkt(f32x16&p0,f32x16&p1,const char*Kslot,const bf16x8*qr,const f32x16&negm,int r32,int hi){
  const char*kb=Kslot+hi*1024+r32*16;
  #pragma unroll
  for(int d0=0;d0<4;++d0){
    const bf16x8 b0=*reinterpret_cast<const bf16x8*>(kb+d0*2048);
    const bf16x8 b1=*reinterpret_cast<const bf16x8*>(kb+d0*2048+512);
    if(d0==0){p0=__builtin_amdgcn_mfma_f32_32x32x16_bf16(b0,qr[0],negm,0,0,0);p1=__builtin_amdgcn_mfma_f32_32x32x16_bf16(b1,qr[0],negm,0,0,0);}
    else{p0=__builtin_amdgcn_mfma_f32_32x32x16_bf16(b0,qr[d0],p0,0,0,0);p1=__builtin_amdgcn_mfma_f32_32x32x16_bf16(b1,qr[d0],p1,0,0,0);}}
}
typedef __attribute__((address_space(3))) const char* lds_cptr;
typedef short v4i16_t __attribute__((ext_vector_type(4)));
__device__ __forceinline__ void kload8(bf16x8*kf,lds_cptr kp){
  kf[0]=*(const __attribute__((address_space(3))) bf16x8*)(kp);      kf[1]=*(const __attribute__((address_space(3))) bf16x8*)(kp+512);
  kf[2]=*(const __attribute__((address_space(3))) bf16x8*)(kp+2048); kf[3]=*(const __attribute__((address_space(3))) bf16x8*)(kp+2560);
  kf[4]=*(const __attribute__((address_space(3))) bf16x8*)(kp+4096); kf[5]=*(const __attribute__((address_space(3))) bf16x8*)(kp+4608);
  kf[6]=*(const __attribute__((address_space(3))) bf16x8*)(kp+6144); kf[7]=*(const __attribute__((address_space(3))) bf16x8*)(kp+6656);
}
__device__ __forceinline__ void kload2(bf16x8*kf,lds_cptr kp,int j){ kf[2*j]=*(const __attribute__((address_space(3))) bf16x8*)(kp+j*2048); kf[2*j+1]=*(const __attribute__((address_space(3))) bf16x8*)(kp+j*2048+512); }
__device__ __forceinline__ s16x4 vtr(lds_cptr p){ return __builtin_bit_cast(s16x4,__builtin_amdgcn_ds_read_tr16_b64_v4i16((__attribute__((address_space(3))) v4i16_t*)p)); }
__device__ __forceinline__ float rowmax(const f32x16&p0,const f32x16&p1){
  float a=max3f(p0[0],p0[1],p1[0]),b=max3f(p0[2],p0[3],p1[1]);a=max3f(a,p1[2],p1[3]);
  #pragma unroll
  for(int r=4;r<16;r+=4){a=max3f(a,p0[r],p0[r+1]);b=max3f(b,p0[r+2],p0[r+3]);a=max3f(a,p1[r],p1[r+1]);b=max3f(b,p1[r+2],p1[r+3]);}
  const float m=max2f(a,b);
  auto rr=__builtin_amdgcn_permlane32_swap(__float_as_uint(m),__float_as_uint(m),false,false);
  return max2f(__uint_as_float(rr[0]),__uint_as_float(rr[1]));
}
__device__ __forceinline__ void pv(f32x16*o,int vb,bf16x8 pa0,bf16x8 pa1,bf16x8 pa2,bf16x8 pa3){
  #pragma unroll
  for(int d0=0;d0<4;++d0){s16x4 lo[4],hi[4];
    #pragma unroll
    for(int ks=0;ks<4;++ks){
      asm volatile("ds_read_b64_tr_b16 %0,%1 offset:%c2":"=&v"(lo[ks]):"v"(vb),"i"(d0*4096+ks*1024):"memory");
      asm volatile("ds_read_b64_tr_b16 %0,%1 offset:%c2":"=&v"(hi[ks]):"v"(vb),"i"(d0*4096+ks*1024+512):"memory");}
    asm volatile("s_waitcnt lgkmcnt(0)":::"memory");SBAR();
    #define PK(k) (bf16x8){lo[k][0],lo[k][1],lo[k][2],lo[k][3],hi[k][0],hi[k][1],hi[k][2],hi[k][3]}
    o[d0]=__builtin_amdgcn_mfma_f32_32x32x16_bf16(pa0,PK(0),o[d0],0,0,0);
    o[d0]=__builtin_amdgcn_mfma_f32_32x32x16_bf16(pa1,PK(1),o[d0],0,0,0);
    o[d0]=__builtin_amdgcn_mfma_f32_32x32x16_bf16(pa2,PK(2),o[d0],0,0,0);
    o[d0]=__builtin_amdgcn_mfma_f32_32x32x16_bf16(pa3,PK(3),o[d0],0,0,0);
    #undef PK
  }
}

#ifndef ATTN_STORE16
#define ATTN_STORE16(p,v) (*(u32x4*)(p)=(v))
#endif
template<int THRL> __device__ __forceinline__ void attn_unit(long rowbase,int qb,const bf16*Q,const bf16*__restrict__ K,const bf16*__restrict__ V,bf16*O,float sl,int T0,char*shm){
  int tid_=threadIdx.x; asm volatile("":"+v"(tid_)); const int tid=tid_,lane=tid&63,r32=lane&31,hi=lane>>5; const int wid=__builtin_amdgcn_readfirstlane(tid>>6);
  const int q0=qb*QB; const float sl64=64.f*sl, sl32=32.f*sl;
  const bf16*Qw=Q+(rowbase+q0+wid*QBLK)*PQ;
  const bf16*Kh=K+(rowbase+(long)T0*KVBLK)*PQ,*Vh=V+(rowbase+(long)T0*KVBLK)*PQ;
  const unsigned lds0=(unsigned)(uintptr_t)shm;
  float*wsf=(float*)(shm+LDS_WS)+wid*64;
  const unsigned koff=(unsigned)(lane*PQ+wid*8)*2u, voff=(unsigned)((16*(wid&3)+(lane>>2))*PQ+(wid>>2)*32+(lane&3)*8)*2u;
  const unsigned kdst=lds0+LDS_K+wid*1024, vdst=lds0+LDS_V+wid*1024;
  #define DMA_K(t,slot) glds16s<0>(Kh+(long)(t)*KVBLK*PQ,koff,(unsigned)__builtin_amdgcn_readfirstlane(kdst+(slot)))
  #define DMA_V(t,slot) do{ glds16s<0>(Vh+(long)(t)*KVBLK*PQ,voff,(unsigned)__builtin_amdgcn_readfirstlane(vdst+2*(slot))); glds16s<0>(Vh+(long)(t)*KVBLK*PQ+64,voff,(unsigned)__builtin_amdgcn_readfirstlane(vdst+2*(slot)+8192)); }while(0)
  const int vb0=(int)(lds0+LDS_V)+((lane>>4)&1)*32+(lane&3)*8+(4*hi+((lane&15)>>2))*64;
  const char*Kbase=shm+LDS_K; bf16x8 kf[8];
  const lds_cptr shm3=(lds_cptr)shm; const lds_cptr kp0=shm3+LDS_K+hi*1024+r32*16; const lds_cptr vp0=shm3+LDS_V+((lane>>4)&1)*32+(lane&3)*8+(4*hi+((lane&15)>>2))*64;
  const int NT=(q0+QB)/KVBLK-T0;
  DMA_K(0,0);DMA_V(0,0);DMA_K(1,SLOTB);
  bf16x8 qr[4];
  #pragma unroll
  for(int d0=0;d0<4;++d0)qr[d0]=*reinterpret_cast<const bf16x8*>(&Qw[(long)r32*PQ+d0*16+hi*8]);
  typedef __attribute__((address_space(3))) bf16x8* lds_q8; const lds_q8 qpark=(lds_q8)((__attribute__((address_space(3))) char*)shm+LDS_OST+wid*8192+lane*16);
  #pragma unroll
  for(int d0=0;d0<4;++d0)qpark[d0*64]=qr[d0];
  #define QLD(d0) (qpark[(d0)*64])
  float mhat=0.f,l_reg=0.f;f32x16 o[4];o[0]=f32x16{};o[1]=f32x16{};o[2]=f32x16{};o[3]=f32x16{};const int qrel=wid*QBLK+r32;
  f32x16 negm;
  #pragma unroll
  for(int r=0;r<16;++r)negm[r]=sl*(float)(T0*KVBLK+crow(r,hi)-(q0+qrel));
  asm volatile("":"+v"(negm));
  #define CMASK(P0,P1,t) do{int jb_=(t)-(NT-4); if(jb_>=0)cmask(P0,P1,jb_,qrel,hi);}while(0)
  bool resc=false;
  #define START(P0,P1) do{ const float rm=rowmax(P0,P1); resc=false; \
    { const float dl=rm; mhat=fadd_s(mhat,dl); \
      _Pragma("unroll") for(int r=0;r<16;++r){P0[r]=fsub_s(P0[r],dl);P1[r]=fsub_s(P1[r],dl);} \
      { const float adj_=sl64-dl; _Pragma("unroll") for(int r=0;r<16;++r)negm[r]+=adj_; } asm volatile("":"+v"(negm)); } \
    _Pragma("unroll") for(int r=0;r<16;++r)P0[r]=__builtin_amdgcn_exp2f(P0[r]); }while(0)
  #define RESC() do{ if(resc){ asm volatile("s_waitcnt lgkmcnt(0)":::"memory"); \
      _Pragma("unroll") for(int d_=0;d_<4;++d_) _Pragma("unroll") for(int r=0;r<16;++r)o[d_][r]*=wsf[crow(r,hi)]; } }while(0)
  f32x16 pA0,pA1,pB0,pB1;
  int sl_prev=0,sl_cur=0,sl_next=SLOTB;
  #define ROT() do{sl_prev=sl_cur;sl_cur=sl_next;sl_next=(sl_next==(NSLOT-1)*SLOTB)?0:sl_next+SLOTB;}while(0)
  DMA_K(2,2*SLOTB);
  WAIT_BAR(3);
  qkt(pA0,pA1,Kbase,qr,negm,r32,hi);asm volatile("s_nop 15\n\ts_nop 7":"+v"(pA0),"+v"(pA1));
  _Pragma("unroll") for(int r=0;r<16;++r)pA1[r]+=sl32;
  CMASK(pA0,pA1,0);
  START(pA0,pA1);
  _Pragma("unroll") for(int r=0;r<16;++r)pA1[r]=__builtin_amdgcn_exp2f(pA1[r]);
  WAIT_BAR(0);
  DMA_K(3,0);DMA_V(1,SLOTB);
  ROT();
  kload8(kf,kp0+sl_cur);
  WAIT_BAR(3);
  s16x4 vlo[8],vhi[8]; u32x4 pw0,pw1,pw2,pw3;
  #define PKW(P,B) cvtpk_s(P[B],P[B+1])
  #define PAF(k) __builtin_bit_cast(bf16x8,pw##k)
  #define VFR(i) (bf16x8){vlo[i][0],vlo[i][1],vlo[i][2],vlo[i][3],vhi[i][0],vhi[i][1],vhi[i][2],vhi[i][3]}
  #define PIN(x) asm volatile("":"+v"(x))
  #define MX3(a,b,c) __builtin_fmaxf(__builtin_fmaxf((a),(b)),(c))
  #define GAPA(MF,A0,A1,A2,A3,W0,W1,PW) do{ MF; sacc+=A0; sacc+=A1; sacc+=A2; sacc+=A3; PIN(sacc); W0; W1; PIN(PW); SBAR(); }while(0)
  #define EX(v) __builtin_amdgcn_exp2f(v)
  #define GAPB2(MF,X,B) do{ MF; X[B]=EX(X[B]); X[B+1]=EX(X[B+1]); PIN(X); SBAR(); }while(0)
  #define VRD(i) do{ vlo[i]=vtr(vp_+(((i)>>2)*4096+((i)&3)*1024)); vhi[i]=vtr(vp_+(((i)>>2)*4096+((i)&3)*1024+512)); }while(0)
  #define VRD2(i) do{ vlo[i]=vtr(vp_+((2+((i)>>2))*4096+((i)&3)*1024)); vhi[i]=vtr(vp_+((2+((i)>>2))*4096+((i)&3)*1024+512)); }while(0)
  #define KRD(G,j) do{ if(G){ kload2(kf,kp0+sl_next,j); SBAR(); } }while(0)
  #define STEP(C0,C1,P0,P1,t,GK,GV,GL) do{ SBAR(); \
    const lds_cptr vp_=vp0+2*sl_prev; \
    const bf16x8 q0_=QLD(0),q1_=QLD(1); \
    VRD(0); SBAR(); float sacc=(P0[0]+P0[1]); \
    GAPA(C0=__builtin_amdgcn_mfma_f32_32x32x16_bf16(kf[0],q0_,negm,0,0,0), P0[2],P0[3],P0[4],P0[5],     pw0[0]=PKW(P0,0), pw0[1]=PKW(P0,2), pw0); \
    VRD(4); SBAR(); GAPA(C1=__builtin_amdgcn_mfma_f32_32x32x16_bf16(kf[1],q0_,negm,0,0,0), P0[6],P0[7],P0[8],P0[9],     pw0[2]=PKW(P0,4), pw0[3]=PKW(P0,6), pw0); \
    const bf16x8 q2_=QLD(2); VRD(1); SBAR(); GAPA(C0=__builtin_amdgcn_mfma_f32_32x32x16_bf16(kf[2],q1_,C0,0,0,0),   P0[10],P0[11],P0[12],P0[13], pw1[0]=PKW(P0,8), pw1[1]=PKW(P0,10), pw1); \
    VRD(5); SBAR(); GAPA(C1=__builtin_amdgcn_mfma_f32_32x32x16_bf16(kf[3],q1_,C1,0,0,0),   P0[14],P0[15],P1[0],P1[1],   pw1[2]=PKW(P0,12),pw1[3]=PKW(P0,14), pw1); \
    const bf16x8 q3_=QLD(3); VRD(2); SBAR(); GAPA(C0=__builtin_amdgcn_mfma_f32_32x32x16_bf16(kf[4],q2_,C0,0,0,0),   P1[2],P1[3],P1[4],P1[5],     pw2[0]=PKW(P1,0), pw2[1]=PKW(P1,2), pw2); \
    VRD(6); SBAR(); GAPA(C1=__builtin_amdgcn_mfma_f32_32x32x16_bf16(kf[5],q2_,C1,0,0,0),   P1[6],P1[7],P1[8],P1[9],     pw2[2]=PKW(P1,4), pw2[3]=PKW(P1,6), pw2); \
    VRD(3); SBAR(); GAPA(C0=__builtin_amdgcn_mfma_f32_32x32x16_bf16(kf[6],q3_,C0,0,0,0),   P1[10],P1[11],P1[12],P1[13], pw3[0]=PKW(P1,8), pw3[1]=PKW(P1,10), pw3); \
    VRD(7); SBAR(); GAPA(C1=__builtin_amdgcn_mfma_f32_32x32x16_bf16(kf[7],q3_,C1,0,0,0),   P1[14],P1[15],0.f,0.f,       pw3[2]=PKW(P1,12),pw3[3]=PKW(P1,14), pw3); \
    l_reg+=sacc; \
    if(GK){DMA_K((t)+3,sl_cur);} if(GV){DMA_V((t)+1,sl_next);} \
    _Pragma("unroll") for(int r=0;r<16;++r)C1[r]+=sl32; \
    CMASK(C0,C1,t); \
    { float a=MX3(C0[0],C0[1],C1[0]),b=MX3(C0[2],C0[3],C1[1]); a=MX3(a,C1[2],C1[3]); \
      _Pragma("unroll") for(int r=4;r<16;r+=4){a=MX3(a,C0[r],C0[r+1]);b=MX3(b,C0[r+2],C0[r+3]);a=MX3(a,C1[r],C1[r+1]);b=MX3(b,C1[r+2],C1[r+3]);} \
      float rm=__builtin_fmaxf(a,b); { auto rr=__builtin_amdgcn_permlane32_swap(__float_as_uint(rm),__float_as_uint(rm),false,false); rm=__builtin_fmaxf(__uint_as_float(rr[0]),__uint_as_float(rr[1])); } \
      resc=false; float adj_=sl64; \
      if(__builtin_expect(__any(rm>(float)THRL),0)){ const float dl=__builtin_fmaxf(rm,0.f); mhat+=dl; adj_-=dl; \
        _Pragma("unroll") for(int r=0;r<16;++r){C0[r]-=dl;C1[r]-=dl;} \
        const float f=__builtin_amdgcn_exp2f(-dl); l_reg*=f; if(hi==0)wsf[r32]=f; resc=true; } \
      _Pragma("unroll") for(int r=0;r<16;++r)negm[r]+=adj_; asm volatile("":"+v"(negm)); } \
    SBAR(); \
    GAPB2(o[0]=__builtin_amdgcn_mfma_f32_32x32x16_bf16(PAF(0),VFR(0),o[0],0,0,0), C0,0); VRD2(0); SBAR(); \
    GAPB2(o[1]=__builtin_amdgcn_mfma_f32_32x32x16_bf16(PAF(0),VFR(4),o[1],0,0,0), C0,2); VRD2(4); SBAR(); \
    KRD(GL,0); GAPB2(o[0]=__builtin_amdgcn_mfma_f32_32x32x16_bf16(PAF(1),VFR(1),o[0],0,0,0), C0,4); VRD2(1); SBAR(); \
    KRD(GL,1); GAPB2(o[1]=__builtin_amdgcn_mfma_f32_32x32x16_bf16(PAF(1),VFR(5),o[1],0,0,0), C0,6); VRD2(5); SBAR(); \
    KRD(GL,2); GAPB2(o[0]=__builtin_amdgcn_mfma_f32_32x32x16_bf16(PAF(2),VFR(2),o[0],0,0,0), C0,8); VRD2(2); SBAR(); \
    KRD(GL,3); GAPB2(o[1]=__builtin_amdgcn_mfma_f32_32x32x16_bf16(PAF(2),VFR(6),o[1],0,0,0), C0,10); VRD2(6); SBAR(); \
    GAPB2(o[0]=__builtin_amdgcn_mfma_f32_32x32x16_bf16(PAF(3),VFR(3),o[0],0,0,0), C0,12); VRD2(3); SBAR(); \
    GAPB2(o[1]=__builtin_amdgcn_mfma_f32_32x32x16_bf16(PAF(3),VFR(7),o[1],0,0,0), C0,14); VRD2(7); SBAR(); \
    GAPB2(o[2]=__builtin_amdgcn_mfma_f32_32x32x16_bf16(PAF(0),VFR(0),o[2],0,0,0), C1,0); \
    GAPB2(o[3]=__builtin_amdgcn_mfma_f32_32x32x16_bf16(PAF(0),VFR(4),o[3],0,0,0), C1,2); \
    GAPB2(o[2]=__builtin_amdgcn_mfma_f32_32x32x16_bf16(PAF(1),VFR(1),o[2],0,0,0), C1,4); \
    GAPB2(o[3]=__builtin_amdgcn_mfma_f32_32x32x16_bf16(PAF(1),VFR(5),o[3],0,0,0), C1,6); \
    GAPB2(o[2]=__builtin_amdgcn_mfma_f32_32x32x16_bf16(PAF(2),VFR(2),o[2],0,0,0), C1,8); \
    GAPB2(o[3]=__builtin_amdgcn_mfma_f32_32x32x16_bf16(PAF(2),VFR(6),o[3],0,0,0), C1,10); \
    GAPB2(o[2]=__builtin_amdgcn_mfma_f32_32x32x16_bf16(PAF(3),VFR(3),o[2],0,0,0), C1,12); \
    GAPB2(o[3]=__builtin_amdgcn_mfma_f32_32x32x16_bf16(PAF(3),VFR(7),o[3],0,0,0), C1,14); \
    }while(0)
  int t=1;
  #undef CMASK
  #define CMASK(P0,P1,t) do{}while(0)
  for(;t+5<NT;t+=2){
    STEP(pB0,pB1,pA0,pA1,t,true,true,true);     WAIT_BAR(3); RESC(); ROT();
    STEP(pA0,pA1,pB0,pB1,t+1,true,true,true);   WAIT_BAR(3); RESC(); ROT();
  }
  #undef CMASK
  #define CMASK(P0,P1,t) do{int jb_=(t)-(NT-4); if(jb_>=0)cmask(P0,P1,jb_,qrel,hi);}while(0)
  #define ENDW(tt) do{ if((tt)+3<NT){WAIT_BAR(3);} else if((tt)+2<NT){WAIT_BAR(2);} else {WAIT_BAR(0);} }while(0)
  for(;t+1<NT;t+=2){
    STEP(pB0,pB1,pA0,pA1,t,(t+3<NT),(t+1<NT),(t+1<NT));       ENDW(t);   RESC(); ROT();
    STEP(pA0,pA1,pB0,pB1,t+1,(t+4<NT),(t+2<NT),(t+2<NT));     ENDW(t+1); RESC(); ROT();
  }
  STEP(pB0,pB1,pA0,pA1,NT-1,false,false,false); RESC();
  { float sacc=pB0[0]+pB0[1]; _Pragma("unroll") for(int r=2;r<16;++r)sacc+=pB0[r]; _Pragma("unroll") for(int r=0;r<16;++r)sacc+=pB1[r]; l_reg+=sacc;
    pw0=(u32x4){PKW(pB0,0),PKW(pB0,2),PKW(pB0,4),PKW(pB0,6)};pw1=(u32x4){PKW(pB0,8),PKW(pB0,10),PKW(pB0,12),PKW(pB0,14)};pw2=(u32x4){PKW(pB1,0),PKW(pB1,2),PKW(pB1,4),PKW(pB1,6)};pw3=(u32x4){PKW(pB1,8),PKW(pB1,10),PKW(pB1,12),PKW(pB1,14)};
    SBAR(); pv(o,vb0+2*sl_cur,PAF(0),PAF(1),PAF(2),PAF(3)); }
  #undef PKW
  #undef PAF
  #undef VFR
  #undef PIN
  #undef MX3
  #undef GAPA
  #undef GAPB2
  #undef VRD2
  #undef EX
  #undef VRD
  #undef KRD
  #undef STEP
  #undef ENDW
  {auto rr=__builtin_amdgcn_permlane32_swap(__float_as_uint(l_reg),__float_as_uint(l_reg),false,false);l_reg=__uint_as_float(rr[0])+__uint_as_float(rr[1]);}
  if(hi==0)wsf[32+r32]=l_reg;asm volatile("s_waitcnt lgkmcnt(0)":::"memory");
  float rli[16];
  #pragma unroll
  for(int r=0;r<16;++r)rli[r]=__builtin_amdgcn_rcpf(wsf[32+crow(r,hi)]);
  bf16*Ow=O+(rowbase+q0+wid*QBLK)*PO;
  { bf16*stg=(bf16*)(shm+LDS_OST)+wid*4096;
    #pragma unroll
    for(int r=0;r<16;++r){const int orow=crow(r,hi);
      #pragma unroll
      for(int d0=0;d0<4;++d0)stg[orow*128+d0*32+r32]=__float2bfloat16(o[d0][r]*rli[r]);}
    asm volatile("s_waitcnt lgkmcnt(0)":::"memory");
    #pragma unroll
    for(int i=0;i<8;++i){const int row=i*4+(lane>>4),ch=lane&15; const u32x4 v=*(const u32x4*)(stg+row*128+ch*8); ATTN_STORE16(Ow+(long)row*PO+ch*8,v);} }
  asm volatile("s_waitcnt lgkmcnt(0)\n\ts_barrier":::"memory");
  #undef QLD
  #undef DMA_K
  #undef DMA_V
  #undef CMASK
  #undef START
  #undef RESC
  #undef ROT
}
constexpr int ATTN_LDS_BYTES=LDS_BYTES;
template<int THRL=8> __device__ __forceinline__ void attn_phase(char*lds,const bf16*QKV,bf16*OP,unsigned*ctl){
  volatile __attribute__((address_space(3))) unsigned* qword=(volatile __attribute__((address_space(3))) unsigned*)(__attribute__((address_space(3))) char*)lds+(140*1024/4);
  const int x0=(int)(__builtin_amdgcn_s_getreg((3<<11)|20)&7u);
  for(int qi=0;qi<8;++qi){ const int b=(x0+qi)&7;
  for(;;){
    if(threadIdx.x==0){ const unsigned i=__hip_atomic_fetch_add(ctl+256+16*b,1u,__ATOMIC_RELAXED,__HIP_MEMORY_SCOPE_AGENT); *qword=i; }
    asm volatile("s_waitcnt lgkmcnt(0)\n\ts_barrier":::"memory");
    const int idx=__builtin_amdgcn_readfirstlane((int)*qword);
    asm volatile("s_waitcnt lgkmcnt(0)\n\ts_barrier":::"memory");
    if(idx>=16*NQB)break;
    const int grp=idx>>5,h=7-(grp>>1),mp=grp&1,qb=NQB-1-(idx&31);
    const float sl=__builtin_ldexpf(1.4426950408889634f,-(h+1));
    const unsigned*tq=ctl+1024+b*64+(mp*8+h)*2,*tk=tq+32;
    const float qn2=__uint_as_float(__hip_atomic_load(tq,__ATOMIC_RELAXED,__HIP_MEMORY_SCOPE_AGENT))+__uint_as_float(__hip_atomic_load(tq+1,__ATOMIC_RELAXED,__HIP_MEMORY_SCOPE_AGENT)),kn2=__uint_as_float(__hip_atomic_load(tk,__ATOMIC_RELAXED,__HIP_MEMORY_SCOPE_AGENT))+__uint_as_float(__hip_atomic_load(tk+1,__ATOMIC_RELAXED,__HIP_MEMORY_SCOPE_AGENT));
    const float thr=2.04f*sqrtf(qn2*kn2)+152.f, xs=(float)(qb*QB-63)-thr/sl;
    int T0=0; if(xs>=0.f){ T0=((int)(xs*(1.f/64.f))+1)&~1; if(T0>4*qb)T0=4*qb; }
    T0=__builtin_amdgcn_readfirstlane(T0);
    attn_unit<THRL>((long)b*SEQ,qb,QKV+mp*512+h*64,QKV+1024+mp*512+h*64,QKV+2048+h*128,OP+mp*1024+h*128,sl,T0,lds);
  } }
}
#undef SBAR
#undef WAIT_BAR
}
constexpr int NWAVES = 8;
constexpr int BATCH = 8, SEQL = 8192, DMODEL = 1024, DFF = 2816, NQKV = 3072;
constexpr int MROWS = BATCH * SEQL;
constexpr float LN_EPS = 1e-5f, RMS_EPS = 1e-5f;
constexpr float DN_ALPHA = 1.41421356237309515f;
constexpr float LAMBDA_INIT = 0.35550906759096927f;
constexpr size_t MiB = 1u << 20;
constexpr size_t WS_WIN = 2 * MiB, WIN_BYTES = 11 * MiB;
constexpr size_t WS_WOUT = 46 * MiB, WOUT_BYTES = 11 * MiB / 2;
constexpr size_t WS_WQKV = 68 * MiB, WS_WO = 74 * MiB, WS_PW = 76 * MiB;
constexpr size_t WS_Z = 80 * MiB;
constexpr size_t WS_XB = 336 * MiB;
constexpr size_t WS_H = 464 * MiB;
constexpr size_t WS_XL = 848 * MiB;
constexpr size_t WS_END = 912 * MiB;
constexpr int LDS_BYTES = 147456;
#define GAS __attribute__((address_space(1)))
#define LAS __attribute__((address_space(3)))
typedef unsigned short bf16;
typedef unsigned v4u __attribute__((ext_vector_type(4)));
typedef unsigned v2u __attribute__((ext_vector_type(2)));
typedef float f32x4 __attribute__((ext_vector_type(4)));
#define LDS_WAIT() asm volatile("s_waitcnt lgkmcnt(0)" ::: "memory")
__device__ __forceinline__ unsigned pk2(float lo, float hi) { return pg8::cvt_pk_bf16(lo, hi); }
__device__ __forceinline__ float wave_sum(float v) {
#pragma unroll
    for (int o = 1; o < 64; o <<= 1) v += __shfl_xor(v, o);
    return v;
}
__device__ __forceinline__ void p0_transpose_item(const float* W, int K, int N, bf16* WT, int mode, int row_off, LAS float* scr, int item, int lane) {
    const int nblk = N / 32, kb = item / nblk, nb = item % nblk, k0 = 64 * kb, n0 = 32 * nb;
    int r0 = row_off + n0;
    if (mode == 1) { const int j = n0 < DFF ? n0 : n0 - DFF; r0 = (j >> 7) * 256 + (j & 127) + (n0 < DFF ? 0 : 128); }
#pragma unroll 8
    for (int i = 0; i < 32; ++i) { const int kk = 2 * i + (lane >> 5); scr[kk * 33 + (lane & 31)] = W[(size_t)(k0 + kk) * N + n0 + (lane & 31)]; }
    LDS_WAIT(); asm volatile("" ::: "memory");
    const int c = lane & 7;
#pragma unroll
    for (int j = 0; j < 4; ++j) { const int n = (lane >> 3) + 8 * j; const LAS float* s = scr + (8 * c) * 33 + n;
        v4u o; o.x = pk2(s[0 * 33], s[1 * 33]); o.y = pk2(s[2 * 33], s[3 * 33]); o.z = pk2(s[4 * 33], s[5 * 33]); o.w = pk2(s[6 * 33], s[7 * 33]);
        *(GAS v4u*)(WT + (size_t)(r0 + n) * K + k0 + 8 * c) = o; }
    LDS_WAIT(); asm volatile("" ::: "memory");
}
struct Args { const float* in[30]; float* out; unsigned char* ws; };

__device__ __forceinline__ void prologue(const Args& a, LAS unsigned char* lds, int gw, int NGW, int wave, int lane) {
    LAS float* scr = (LAS float*)(lds + wave * 16384);
    unsigned char* ws = a.ws;
    constexpr int I_IN = (DMODEL / 64) * (2 * DFF / 32), I_OUT = (DFF / 64) * (DMODEL / 32), I_QKV = (DMODEL / 64) * (NQKV / 32), I_O = (DMODEL / 64) * (DMODEL / 32), I_P = (256 / 64) * (256 / 32);
    constexpr int NITEMS = 4 * I_IN + 4 * I_OUT + I_QKV + I_O + 4 * I_P;
    for (int it = gw; it < NITEMS; it += NGW) {
        int r = it;
        if (r < 4 * I_IN) { const int f = r / I_IN; const int idx = f == 0 ? 1 : f == 1 ? 9 : f == 2 ? 13 : 26;
            p0_transpose_item(a.in[idx], DMODEL, 2 * DFF, (bf16*)(ws + WS_WIN + f * WIN_BYTES), 1, 0, scr, r % I_IN, lane); continue; } r -= 4 * I_IN;
        if (r < 4 * I_OUT) { const int f = r / I_OUT; const int idx = f == 0 ? 2 : f == 1 ? 10 : f == 2 ? 14 : 27;
            p0_transpose_item(a.in[idx], DFF, DMODEL, (bf16*)(ws + WS_WOUT + f * WOUT_BYTES), 0, 0, scr, r % I_OUT, lane); continue; } r -= 4 * I_OUT;
        if (r < I_QKV) { p0_transpose_item(a.in[17], DMODEL, NQKV, (bf16*)(ws + WS_WQKV), 0, 0, scr, r, lane); continue; } r -= I_QKV;
        if (r < I_O) { p0_transpose_item(a.in[23], DMODEL, DMODEL, (bf16*)(ws + WS_WO), 0, 0, scr, r, lane); continue; } r -= I_O;
        { const int g = r / I_P; p0_transpose_item(a.in[5] + (size_t)g * 65536, 256, 256, (bf16*)(ws + WS_PW), 0, g * 256, scr, r % I_P, lane); }
    }
    const GAS f32x4* x4 = (const GAS f32x4*)a.in[0]; GAS v4u* xb = (GAS v4u*)(ws + WS_XB);
    const size_t n8 = (size_t)MROWS * DMODEL / 8, nthr = (size_t)NGW * 64;
#pragma unroll 4
    for (size_t i = (size_t)gw * 64 + lane; i < n8; i += nthr) { const f32x4 p = x4[2 * i], q = x4[2 * i + 1];
        v4u o; o.x = pk2(p.x, p.y); o.y = pk2(p.z, p.w); o.z = pk2(q.x, q.y); o.w = pk2(q.z, q.w); xb[i] = o; }
}
template <int R, bool IN_F32, bool OUT_F32> __device__ __forceinline__ void ln_pass(const float* xin, const bf16* Y, const float* g, const float* b, float* xout, bf16* XB, unsigned char* XL, int gw, int NGW, int lane) {
    f32x4 gv[4], bv[4];
#pragma unroll
    for (int j = 0; j < 4; ++j) { const int c4 = (j >> 1) * 128 + lane * 2 + (j & 1); gv[j] = ((const GAS f32x4*)g)[c4]; bv[j] = ((const GAS f32x4*)b)[c4]; }
    for (int m0 = gw * R; m0 < MROWS; m0 += NGW * R) {
        f32x4 v[R][4]; v4u yy[R][2]; float s[R], s2[R];
        if (IN_F32) {
#pragma unroll
            for (int r = 0; r < R; ++r) { const GAS f32x4* xr = (const GAS f32x4*)(xin + (size_t)(m0 + r) * DMODEL) + lane * 2; const GAS v4u* yr = (const GAS v4u*)(Y + (size_t)(m0 + r) * DMODEL) + lane;
                v[r][0] = xr[0]; v[r][1] = xr[1]; v[r][2] = xr[128]; v[r][3] = xr[129]; yy[r][0] = yr[0]; yy[r][1] = yr[64]; }
        } else {
            v4u hh[R][2]; v2u ll[R][2];
#pragma unroll
            for (int r = 0; r < R; ++r) { const GAS v4u* hr = (const GAS v4u*)(XB + (size_t)(m0 + r) * DMODEL) + lane; const GAS v2u* lr = (const GAS v2u*)(XL + (size_t)(m0 + r) * DMODEL) + lane; const GAS v4u* yr = (const GAS v4u*)(Y + (size_t)(m0 + r) * DMODEL) + lane;
                hh[r][0] = hr[0]; hh[r][1] = hr[64]; ll[r][0] = lr[0]; ll[r][1] = lr[64]; yy[r][0] = yr[0]; yy[r][1] = yr[64]; }
#pragma unroll
            for (int r = 0; r < R; ++r)
#pragma unroll
                for (int h = 0; h < 2; ++h) { const unsigned hw[4] = {hh[r][h].x, hh[r][h].y, hh[r][h].z, hh[r][h].w}; const int lw[2] = {(int)ll[r][h].x, (int)ll[r][h].y};
#pragma unroll
                    for (int q = 0; q < 2; ++q) { const float c = 1.0f / 512.0f;
                        v[r][2 * h + q] = (f32x4){__uint_as_float(hw[2 * q] << 16) + __builtin_amdgcn_cvt_f32_fp8(lw[q], 0) * c, __uint_as_float(hw[2 * q] & 0xffff0000u) + __builtin_amdgcn_cvt_f32_fp8(lw[q], 1) * c,
                                                  __uint_as_float(hw[2 * q + 1] << 16) + __builtin_amdgcn_cvt_f32_fp8(lw[q], 2) * c, __uint_as_float(hw[2 * q + 1] & 0xffff0000u) + __builtin_amdgcn_cvt_f32_fp8(lw[q], 3) * c}; } }
        }
#pragma unroll
        for (int r = 0; r < R; ++r) { const unsigned yw[8] = {yy[r][0].x, yy[r][0].y, yy[r][0].z, yy[r][0].w, yy[r][1].x, yy[r][1].y, yy[r][1].z, yy[r][1].w}; s[r] = 0.f;
#pragma unroll
            for (int j = 0; j < 4; ++j) { const f32x4 yv = (f32x4){__uint_as_float(yw[2 * j] << 16), __uint_as_float(yw[2 * j] & 0xffff0000u), __uint_as_float(yw[2 * j + 1] << 16), __uint_as_float(yw[2 * j + 1] & 0xffff0000u)};
                v[r][j] = v[r][j] * DN_ALPHA + yv; s[r] += (v[r][j].x + v[r][j].y) + (v[r][j].z + v[r][j].w); } }
#pragma unroll
        for (int o = 1; o < 64; o <<= 1)
#pragma unroll
            for (int r = 0; r < R; ++r) s[r] += __shfl_xor(s[r], o);
#pragma unroll
        for (int r = 0; r < R; ++r) { const float mean = s[r] * (1.f / DMODEL); s2[r] = 0.f;
#pragma unroll
            for (int j = 0; j < 4; ++j) { v[r][j] = v[r][j] - mean; s2[r] += (v[r][j].x * v[r][j].x + v[r][j].y * v[r][j].y) + (v[r][j].z * v[r][j].z + v[r][j].w * v[r][j].w); } }
#pragma unroll
        for (int o = 1; o < 64; o <<= 1)
#pragma unroll
            for (int r = 0; r < R; ++r) s2[r] += __shfl_xor(s2[r], o);
#pragma unroll
        for (int r = 0; r < R; ++r) { const float rstd = 1.f / sqrtf(s2[r] * (1.f / DMODEL) + LN_EPS);
#pragma unroll
            for (int j = 0; j < 4; ++j) v[r][j] = v[r][j] * rstd * gv[j] + bv[j];
            if (OUT_F32) { GAS f32x4* xo = (GAS f32x4*)(xout + (size_t)(m0 + r) * DMODEL) + lane * 2; xo[0] = v[r][0]; xo[1] = v[r][1]; xo[128] = v[r][2]; xo[129] = v[r][3]; }
            else { GAS v4u* o8 = (GAS v4u*)(XB + (size_t)(m0 + r) * DMODEL) + lane; GAS v2u* l8 = (GAS v2u*)(XL + (size_t)(m0 + r) * DMODEL) + lane;
#pragma unroll
                for (int h = 0; h < 2; ++h) { unsigned hw[4]; int lw[2];
#pragma unroll
                    for (int q = 0; q < 2; ++q) { const f32x4 x = v[r][2 * h + q]; hw[2 * q] = pk2(x.x, x.y); hw[2 * q + 1] = pk2(x.z, x.w);
                        const float l0 = (x.x - __uint_as_float(hw[2 * q] << 16)) * 512.f, l1 = (x.y - __uint_as_float(hw[2 * q] & 0xffff0000u)) * 512.f, l2 = (x.z - __uint_as_float(hw[2 * q + 1] << 16)) * 512.f, l3 = (x.w - __uint_as_float(hw[2 * q + 1] & 0xffff0000u)) * 512.f;
                        int p = __builtin_amdgcn_cvt_pk_fp8_f32(l0, l1, 0, false); lw[q] = __builtin_amdgcn_cvt_pk_fp8_f32(l2, l3, p, true); }
                    o8[64 * h] = (v4u){hw[0], hw[1], hw[2], hw[3]}; l8[64 * h] = (v2u){(unsigned)lw[0], (unsigned)lw[1]}; } }
        }
    }
}
__device__ __forceinline__ void ln_pool_pass(const bf16* Zp, const float* pscale, const float* g, const float* b, bf16* XB, unsigned char* XL, int gw, int NGW, int lane) {
    f32x4 gv[4], bv[4], pv[4];
#pragma unroll
    for (int j = 0; j < 4; ++j) { const int c4 = (j >> 1) * 128 + lane * 2 + (j & 1); gv[j] = ((const GAS f32x4*)g)[c4]; bv[j] = ((const GAS f32x4*)b)[c4]; pv[j] = ((const GAS f32x4*)pscale)[c4]; }
    const int wA = lane < 32 ? 2 : 4, wB = lane < 32 ? 8 : 16;
#define BF4LO(q) ((f32x4){__uint_as_float((q).x << 16), __uint_as_float((q).x & 0xffff0000u), __uint_as_float((q).y << 16), __uint_as_float((q).y & 0xffff0000u)})
#define BF4HI(q) ((f32x4){__uint_as_float((q).z << 16), __uint_as_float((q).z & 0xffff0000u), __uint_as_float((q).w << 16), __uint_as_float((q).w & 0xffff0000u)})
    for (int c = gw; c < MROWS / 32; c += NGW) {
        const int r0 = c * 32, t0 = r0 & (SEQL - 1);
        const GAS v4u* zp = (const GAS v4u*)(Zp + (size_t)r0 * DMODEL) + lane;
        f32x4 s[4] = {(f32x4){0.f, 0.f, 0.f, 0.f}, (f32x4){0.f, 0.f, 0.f, 0.f}, (f32x4){0.f, 0.f, 0.f, 0.f}, (f32x4){0.f, 0.f, 0.f, 0.f}};
        if (t0 > 0) for (int i = 1; i <= 16; ++i) { const v4u qa = zp[-(long)(i <= wA ? i : 1) * 128], qb = zp[-(long)(i <= wB ? i : 1) * 128 + 64]; const float ma = i <= wA ? 1.f : 0.f, mb = i <= wB ? 1.f : 0.f;
            s[0] += BF4LO(qa) * ma; s[1] += BF4HI(qa) * ma; s[2] += BF4LO(qb) * mb; s[3] += BF4HI(qb) * mb; }
        for (int j0 = 0; j0 < 32; j0 += 2) {
            v4u hh[2][2], zc[2][2], zo[2][2]; v2u ll[2][2]; f32x4 v[2][4]; float sm[2], s2[2];
#pragma unroll
            for (int r = 0; r < 2; ++r) { const int j = j0 + r, t = t0 + j; const size_t m = (size_t)(r0 + j);
                const GAS v4u* hr = (const GAS v4u*)(XB + m * DMODEL) + lane; const GAS v2u* lr = (const GAS v2u*)(XL + m * DMODEL) + lane;
                hh[r][0] = hr[0]; hh[r][1] = hr[64]; ll[r][0] = lr[0]; ll[r][1] = lr[64];
                zc[r][0] = zp[(long)j * 128]; zc[r][1] = zp[(long)j * 128 + 64];
                zo[r][0] = zp[(long)(t >= wA ? j - wA : j) * 128]; zo[r][1] = zp[(long)(t >= wB ? j - wB : j) * 128 + 64]; }
#pragma unroll
            for (int r = 0; r < 2; ++r) { const int t = t0 + j0 + r; const float ma = t >= wA ? 1.f : 0.f, mb = t >= wB ? 1.f : 0.f;
                const float rca = 1.0f / (float)(t + 1 < wA ? t + 1 : wA), rcb = 1.0f / (float)(t + 1 < wB ? t + 1 : wB);
                const f32x4 z0 = BF4LO(zc[r][0]), z1 = BF4HI(zc[r][0]), z2 = BF4LO(zc[r][1]), z3 = BF4HI(zc[r][1]);
                s[0] += z0 - BF4LO(zo[r][0]) * ma; s[1] += z1 - BF4HI(zo[r][0]) * ma; s[2] += z2 - BF4LO(zo[r][1]) * mb; s[3] += z3 - BF4HI(zo[r][1]) * mb;
                const f32x4 y[4] = {(s[0] * rca - z0) * pv[0], (s[1] * rca - z1) * pv[1], (s[2] * rcb - z2) * pv[2], (s[3] * rcb - z3) * pv[3]};
                sm[r] = 0.f;
#pragma unroll
                for (int h = 0; h < 2; ++h) { const unsigned hw[4] = {hh[r][h].x, hh[r][h].y, hh[r][h].z, hh[r][h].w}; const int lw[2] = {(int)ll[r][h].x, (int)ll[r][h].y};
#pragma unroll
                    for (int q = 0; q < 2; ++q) { const float cc = 1.0f / 512.0f;
                        const f32x4 x = (f32x4){__uint_as_float(hw[2 * q] << 16) + __builtin_amdgcn_cvt_f32_fp8(lw[q], 0) * cc, __uint_as_float(hw[2 * q] & 0xffff0000u) + __builtin_amdgcn_cvt_f32_fp8(lw[q], 1) * cc,
                                                 __uint_as_float(hw[2 * q + 1] << 16) + __builtin_amdgcn_cvt_f32_fp8(lw[q], 2) * cc, __uint_as_float(hw[2 * q + 1] & 0xffff0000u) + __builtin_amdgcn_cvt_f32_fp8(lw[q], 3) * cc};
                        v[r][2 * h + q] = x * DN_ALPHA + y[2 * h + q]; sm[r] += (v[r][2 * h + q].x + v[r][2 * h + q].y) + (v[r][2 * h + q].z + v[r][2 * h + q].w); } } }
#pragma unroll
            for (int o = 1; o < 64; o <<= 1)
#pragma unroll
                for (int r = 0; r < 2; ++r) sm[r] += __shfl_xor(sm[r], o);
#pragma unroll
            for (int r = 0; r < 2; ++r) { const float mean = sm[r] * (1.f / DMODEL); s2[r] = 0.f;
#pragma unroll
                for (int j = 0; j < 4; ++j) { v[r][j] = v[r][j] - mean; s2[r] += (v[r][j].x * v[r][j].x + v[r][j].y * v[r][j].y) + (v[r][j].z * v[r][j].z + v[r][j].w * v[r][j].w); } }
#pragma unroll
            for (int o = 1; o < 64; o <<= 1)
#pragma unroll
                for (int r = 0; r < 2; ++r) s2[r] += __shfl_xor(s2[r], o);
#pragma unroll
            for (int r = 0; r < 2; ++r) { const float rstd = 1.f / sqrtf(s2[r] * (1.f / DMODEL) + LN_EPS); const size_t m = (size_t)(r0 + j0 + r);
#pragma unroll
                for (int j = 0; j < 4; ++j) v[r][j] = v[r][j] * rstd * gv[j] + bv[j];
                GAS v4u* o8 = (GAS v4u*)(XB + m * DMODEL) + lane; GAS v2u* l8 = (GAS v2u*)(XL + m * DMODEL) + lane;
#pragma unroll
                for (int h = 0; h < 2; ++h) { unsigned hw[4]; int lw[2];
#pragma unroll
                    for (int q = 0; q < 2; ++q) { const f32x4 x = v[r][2 * h + q]; hw[2 * q] = pk2(x.x, x.y); hw[2 * q + 1] = pk2(x.z, x.w);
                        const float l0 = (x.x - __uint_as_float(hw[2 * q] << 16)) * 512.f, l1 = (x.y - __uint_as_float(hw[2 * q] & 0xffff0000u)) * 512.f, l2 = (x.z - __uint_as_float(hw[2 * q + 1] << 16)) * 512.f, l3 = (x.w - __uint_as_float(hw[2 * q + 1] & 0xffff0000u)) * 512.f;
                        int p = __builtin_amdgcn_cvt_pk_fp8_f32(l0, l1, 0, false); lw[q] = __builtin_amdgcn_cvt_pk_fp8_f32(l2, l3, p, true); }
                    o8[64 * h] = (v4u){hw[0], hw[1], hw[2], hw[3]}; l8[64 * h] = (v2u){(unsigned)lw[0], (unsigned)lw[1]}; } }
        }
    }
#undef BF4LO
#undef BF4HI
}
__device__ __forceinline__ void pool_diff_pass(const bf16* XB, const unsigned char* XL, bf16* DB, int gw, int NGW, int lane) {
#define XLOAD(roff) ({ const v2u h_ = hc[(long)(roff) * 256]; const int l_ = (int)lc[(long)(roff) * 256]; const float c_ = 1.0f / 512.0f; \
        (f32x4){__uint_as_float(h_.x << 16) + __builtin_amdgcn_cvt_f32_fp8(l_, 0) * c_, __uint_as_float(h_.x & 0xffff0000u) + __builtin_amdgcn_cvt_f32_fp8(l_, 1) * c_, \
                __uint_as_float(h_.y << 16) + __builtin_amdgcn_cvt_f32_fp8(l_, 2) * c_, __uint_as_float(h_.y & 0xffff0000u) + __builtin_amdgcn_cvt_f32_fp8(l_, 3) * c_}; })
    for (int it = gw; it < (MROWS / 32) * 4; it += NGW) {
        const int g = it & 3, r0 = (it >> 2) * 32, t0 = r0 & (SEQL - 1), w = 2 << g;
        const GAS v2u* hc = (const GAS v2u*)(XB + (size_t)r0 * DMODEL + g * 256) + lane;
        const GAS unsigned* lc = (const GAS unsigned*)(XL + (size_t)r0 * DMODEL + g * 256) + lane;
        GAS v2u* dc = (GAS v2u*)(DB + (size_t)r0 * DMODEL + g * 256) + lane;
        f32x4 s = (f32x4){0.f, 0.f, 0.f, 0.f};
        if (t0 > 0) for (int i = 1; i <= w; ++i) s += XLOAD(-i);
        const float rw = 1.0f / (float)w;
        for (int j0 = 0; j0 < 32; j0 += 8) { f32x4 xv[8], xo[8];
#pragma unroll
            for (int k = 0; k < 8; ++k) { const int j = j0 + k, t = t0 + j; xv[k] = XLOAD(j); xo[k] = XLOAD(t >= w ? j - w : j); }
#pragma unroll
            for (int k = 0; k < 8; ++k) { const int j = j0 + k, t = t0 + j; s += xv[k]; if (t >= w) s -= xo[k];
                const float rc = t + 1 < w ? 1.0f / (float)(t + 1) : rw;
                const f32x4 d = s * rc - xv[k]; v2u o; o.x = pk2(d.x, d.y); o.y = pk2(d.z, d.w); dc[(long)j * 256] = o; } }
    }
#undef XLOAD
}
__device__ __forceinline__ void attn_combine_pass(const bf16* OP, const float* lq1, const float* lk1, const float* lq2, const float* lk2, const float* sg, bf16* OB, int gw, int NGW, int lane) {
    const float lam = __expf(wave_sum(lq1[lane] * lk1[lane])) - __expf(wave_sum(lq2[lane] * lk2[lane])) + LAMBDA_INIT;
    float gl[16];
#pragma unroll
    for (int i = 0; i < 16; ++i) gl[i] = sg[(lane & 7) * 16 + i] * (1.0f - LAMBDA_INIT);
    for (int m0 = gw * 4; m0 < MROWS; m0 += NGW * 4) {
        v4u A0[4], A1[4], B0[4], B1[4];
#pragma unroll
        for (int r = 0; r < 4; ++r) { const GAS v4u* p1 = (const GAS v4u*)(OP + (size_t)(m0 + r) * 2048) + lane * 2; const GAS v4u* p2 = p1 + 128; A0[r] = p1[0]; A1[r] = p1[1]; B0[r] = p2[0]; B1[r] = p2[1]; }
#pragma unroll
        for (int r = 0; r < 4; ++r) { const int m = m0 + r; const v4u a0 = A0[r], a1 = A1[r], b0 = B0[r], b1 = B1[r];
        unsigned aw[8] = {a0.x, a0.y, a0.z, a0.w, a1.x, a1.y, a1.z, a1.w}, bw[8] = {b0.x, b0.y, b0.z, b0.w, b1.x, b1.y, b1.z, b1.w};
        float o[16]; float ss = 0.f;
#pragma unroll
        for (int i = 0; i < 8; ++i) { const float x0 = __uint_as_float(aw[i] << 16), x1 = __uint_as_float(aw[i] & 0xffff0000u), y0 = __uint_as_float(bw[i] << 16), y1 = __uint_as_float(bw[i] & 0xffff0000u);
            o[2 * i] = x0 - lam * y0; o[2 * i + 1] = x1 - lam * y1; ss += o[2 * i] * o[2 * i] + o[2 * i + 1] * o[2 * i + 1]; }
        ss += __shfl_xor(ss, 1); ss += __shfl_xor(ss, 2); ss += __shfl_xor(ss, 4);
        const float rs = 1.0f / sqrtf(ss * (1.0f / 128.0f) + RMS_EPS);
        v4u w0, w1;
        w0.x = pk2(o[0] * rs * gl[0], o[1] * rs * gl[1]); w0.y = pk2(o[2] * rs * gl[2], o[3] * rs * gl[3]); w0.z = pk2(o[4] * rs * gl[4], o[5] * rs * gl[5]); w0.w = pk2(o[6] * rs * gl[6], o[7] * rs * gl[7]);
        w1.x = pk2(o[8] * rs * gl[8], o[9] * rs * gl[9]); w1.y = pk2(o[10] * rs * gl[10], o[11] * rs * gl[11]); w1.z = pk2(o[12] * rs * gl[12], o[13] * rs * gl[13]); w1.w = pk2(o[14] * rs * gl[14], o[15] * rs * gl[15]);
        GAS v4u* q = (GAS v4u*)(OB + (size_t)m * DMODEL) + lane * 2; q[0] = w0; q[1] = w1; }
    }
}

#define XB_TMO      128
#define XB_XCNT(j)  (256  + 64 * (j))
#define XB_XSUB(j)  (1280 + 64 * (j))
#define XB_XGEN(j)  (2304 + 64 * (j))
#define XB_TOP      3328
#define XB_TOPGEN   3392
#define XCD_BAR_WORDS 3456
#define XB_SPIN_CAP (1u << 18)

__device__ __forceinline__ unsigned xb_ld(unsigned* p)              { return __hip_atomic_load(p, __ATOMIC_RELAXED, __HIP_MEMORY_SCOPE_AGENT); }
__device__ __forceinline__ unsigned xb_add(unsigned* p, unsigned v) { return __hip_atomic_fetch_add(p, v, __ATOMIC_RELAXED, __HIP_MEMORY_SCOPE_AGENT); }
__device__ __forceinline__ unsigned xb_xcc_id() { return (unsigned)__builtin_amdgcn_s_getreg((3 << 11) | 20) & 0xFu; }
#define XB_SPIN(cond, bar) do { unsigned _sp = 0; while (cond) { __builtin_amdgcn_s_sleep(1); \
    if ((++_sp & 255u) == 0u) { if (xb_ld(&(bar)[XB_TMO])) break; if (_sp > XB_SPIN_CAP) { atomicAdd(&(bar)[XB_TMO], 1u); break; } } } } while (0)

struct XcdBarrier {
    unsigned* bar; unsigned x;
    volatile LAS unsigned* st;
};

__device__ __forceinline__ XcdBarrier xcd_barrier_post(unsigned* bar, volatile LAS unsigned* st) {
    XcdBarrier b; b.bar = bar; b.x = xb_xcc_id(); b.st = st;
    if (threadIdx.x == 0) (void)xb_add(&bar[XB_XCNT(b.x)], 1u);
    return b;
}
__device__ __forceinline__ void xcd_barrier_complete(unsigned* bar, unsigned x, unsigned& nloc, unsigned& nx) {
    const unsigned G = gridDim.x * gridDim.y * gridDim.z;
    unsigned sum, cnt, mine, sp = 0u;
    for (;;) {
        sum = 0u; cnt = 0u; mine = 0u;
#pragma unroll
        for (unsigned j = 0; j < 16; ++j) { const unsigned c = xb_ld(&bar[XB_XCNT(j)]); sum += c; cnt += (c > 0u) ? 1u : 0u; mine = (j == x) ? c : mine; }
        if (sum == G) break;
        __builtin_amdgcn_s_sleep(1);
        if ((++sp & 255u) == 0u) { if (xb_ld(&bar[XB_TMO])) break; if (sp > XB_SPIN_CAP) { atomicAdd(&bar[XB_TMO], 1u); break; } }
    }
    nloc = mine > 0u ? mine : 1u; nx = cnt > 0u ? cnt : 1u;
}

__device__ __forceinline__ void xcd_barrier(const XcdBarrier& b) {
    asm volatile("s_waitcnt vmcnt(0)" ::: "memory");
    __syncthreads();
    if (threadIdx.x == 0) {
        unsigned* bar = b.bar;
        __builtin_amdgcn_s_waitcnt(0);
        unsigned nloc = b.st[0], nx = b.st[1];
        if (nloc == 0u) { xcd_barrier_complete(bar, b.x, nloc, nx); b.st[0] = nloc; b.st[1] = nx; }
        const unsigned old = xb_add(&bar[XB_XSUB(b.x)], 1u);
        const unsigned gen = old / nloc;
        if (old + 1u == (gen + 1u) * nloc) {
            __builtin_amdgcn_fence(__ATOMIC_RELEASE, "agent");
            asm volatile("s_waitcnt vmcnt(0)" ::: "memory");
            const unsigned og = xb_add(&bar[XB_TOP], 1u);
            const unsigned tg = og / nx;
            if (og + 1u == (tg + 1u) * nx) xb_add(&bar[XB_TOPGEN], 1u);
            else XB_SPIN(xb_ld(&bar[XB_TOPGEN]) == tg, bar);
            __builtin_amdgcn_fence(__ATOMIC_ACQUIRE, "agent");
            xb_add(&bar[XB_XGEN(b.x)], 1u);
            asm volatile("s_waitcnt vmcnt(0)" ::: "memory");
        } else {
            XB_SPIN(xb_ld(&bar[XB_XGEN(b.x)]) == gen, bar);
            __builtin_amdgcn_fence(__ATOMIC_ACQUIRE, "agent");
            asm volatile("s_waitcnt vmcnt(0)" ::: "memory");
        }
    }
    __syncthreads();
}

__device__ __forceinline__ void norm_pass(const bf16* QKV, unsigned* tab, int gw, int NGW, int lane) {
    for (int c = gw; c < MROWS / 32; c += NGW) {
        const int r0 = c * 32, b = r0 / SEQL; float mx[4] = {0.f, 0.f, 0.f, 0.f};
#pragma unroll 4
        for (int i = 0; i < 32; ++i) { const GAS v4u* p = (const GAS v4u*)(QKV + (size_t)(r0 + i) * NQKV) + lane;
#pragma unroll
            for (int j = 0; j < 4; ++j) { const v4u w = p[64 * j]; float ss = 0.f; const unsigned ww[4] = {w.x, w.y, w.z, w.w};
#pragma unroll
                for (int k = 0; k < 4; ++k) { const float lo = __uint_as_float(ww[k] << 16), hi = __uint_as_float(ww[k] & 0xffff0000u); ss += lo * lo + hi * hi; }
                ss += __shfl_xor(ss, 1); ss += __shfl_xor(ss, 2); ss += __shfl_xor(ss, 4); mx[j] = fmaxf(mx[j], ss); } }
        if ((lane & 7) == 0) {
#pragma unroll
            for (int j = 0; j < 4; ++j) atomicMax(tab + b * 32 + j * 8 + (lane >> 3), __float_as_uint(mx[j])); }
    }
}

__global__ void __launch_bounds__(NWAVES * 64, 2) mk_fwd(Args args) {
    extern __shared__ __attribute__((aligned(16))) unsigned char lds[];
    cg::grid_group grid = cg::this_grid();
    LAS unsigned char* L = (LAS unsigned char*)lds;
    const int wave = __builtin_amdgcn_readfirstlane((int)threadIdx.x >> 6);
#define lane ({ int t_ = threadIdx.x; asm volatile("" : "+v"(t_)); t_ & 63; })
    const int G = gridDim.x, bx = blockIdx.x, vcu = (G % 8 == 0) ? (bx % 8) * (G / 8) + bx / 8 : bx;
    const int gw = vcu * NWAVES + wave, NGW = G * NWAVES;
    unsigned char* ws = args.ws;
    unsigned char* XL = ws + WS_XL; bf16* Y = (bf16*)(ws + WS_Z); bf16* XB = (bf16*)(ws + WS_XB); bf16* H = (bf16*)(ws + WS_H);
#define GEMM_SWIGLU(f) do { pg8::Gemm g_{XB, (const bf16*)(ws + WS_WIN + (f) * WIN_BYTES), MROWS, 2 * DFF, DMODEL, DMODEL, DMODEL, 0}; pg8::StaticOrder S_; S_.init(MROWS, 2 * DFF, G, bx); \
        pg8::EpiSwiglu E_{H, DFF}; pg8::gemm_phase<pg8::EpiSwiglu, pg8::StaticOrder, PG8_ALIGN, PG8_SP2>(L, g_, S_, E_); } while (0)
#define GEMM_DOWN(f) do { pg8::Gemm g_{H, (const bf16*)(ws + WS_WOUT + (f) * WOUT_BYTES), MROWS, DMODEL, DFF, DFF, DFF, 0}; pg8::StaticOrder S_; S_.init(MROWS, DMODEL, G, bx, 1); \
        pg8::EpiScaleBf16 E_{Y, nullptr, 0.5f}; pg8::gemm_phase<pg8::EpiScaleBf16, pg8::StaticOrder, PG8_ALIGN, PG8_SP2>(L, g_, S_, E_); } while (0)
#define FFN(f, ig, ib, INF, OUTF) do { GEMM_SWIGLU(f); SYNC(); GEMM_DOWN(f); SYNC(); ln_pass<4, INF, OUTF>(args.in[0], Y, args.in[ig], args.in[ib], args.out, XB, XL, gw, NGW, lane); SYNC(); } while (0)

    unsigned* ctl = (unsigned*)ws;
    volatile LAS unsigned* bst = (volatile LAS unsigned*)(L + 141 * 1024);
    if (threadIdx.x < 2) bst[threadIdx.x] = 0u;
    if (bx == 0) for (int i = threadIdx.x; i < 8192; i += NWAVES * 64) ctl[i] = 0u;
    prologue(args, L, gw, NGW, wave, lane);
    __syncthreads(); grid.sync();
    const XcdBarrier xbar = xcd_barrier_post(ctl + 4096, bst);
#define SYNC() xcd_barrier(xbar)
    FFN(0, 3, 4, true, false);
    { pg8::Gemm g_{XB, (const bf16*)(ws + WS_PW), MROWS, DMODEL, 256, DMODEL, 256, 512}; pg8::StaticOrder S_; S_.init(MROWS, DMODEL, G, bx);
      pg8::EpiScaleBf16 E_{Y, nullptr, 1.0f}; pg8::gemm_phase<pg8::EpiScaleBf16, pg8::StaticOrder, PG8_ALIGN, PG8_SP2>(L, g_, S_, E_); }
    SYNC(); ln_pool_pass(Y, args.in[6], args.in[7], args.in[8], XB, XL, gw, NGW, lane); SYNC();
    FFN(1, 11, 12, false, false);
    FFN(2, 15, 16, false, false);
    { pg8::Gemm g_{XB, (const bf16*)(ws + WS_WQKV), MROWS, NQKV, DMODEL, DMODEL, DMODEL, 0}; pg8::StaticOrder S_; S_.init(MROWS, NQKV, G, bx);
      pg8::EpiQKV E_{H, attn_body::C2, ctl + 1024}; pg8::gemm_phase<pg8::EpiQKV, pg8::StaticOrder, PG8_ALIGN, PG8_SP2>(L, g_, S_, E_); }
    SYNC();
    attn_body::attn_phase<16>((char*)lds, (const attn_body::bf16*)H, (attn_body::bf16*)Y, ctl);
    SYNC();
    attn_combine_pass((const bf16*)Y, args.in[18], args.in[19], args.in[20], args.in[21], args.in[22], H, gw, NGW, lane);
    SYNC();
    { pg8::Gemm g_{H, (const bf16*)(ws + WS_WO), MROWS, DMODEL, DMODEL, DMODEL, DMODEL, 0}; pg8::StaticOrder S_; S_.init(MROWS, DMODEL, G, bx);
      pg8::EpiScaleBf16 E_{Y, nullptr, 1.0f}; pg8::gemm_phase<pg8::EpiScaleBf16, pg8::StaticOrder, PG8_ALIGN, PG8_SP2>(L, g_, S_, E_); }
    SYNC(); ln_pass<4, false, false>(nullptr, Y, args.in[24], args.in[25], nullptr, XB, XL, gw, NGW, lane); SYNC();
    FFN(3, 28, 29, false, true);
#undef lane
}

extern "C" void kernel_launch(void* const* d_in, const int* in_sizes, int n_in, void* d_out, int out_size, void* d_ws, size_t ws_size, hipStream_t stream) {
    static int grid = 0;
    if (grid == 0) {
        if (n_in != 30 || in_sizes[0] != MROWS * DMODEL || out_size != MROWS * DMODEL || ws_size < WS_END) { fprintf(stderr, "kernel_launch: unexpected shapes: n_in %d in0 %d out %d ws %zu\n", n_in, n_in > 0 ? in_sizes[0] : -1, out_size, ws_size); grid = -1; return; }
        int dev = 0, cus = 0, per_cu = 0;
        hipGetDevice(&dev); hipDeviceGetAttribute(&cus, hipDeviceAttributeMultiprocessorCount, dev);
        if (hipFuncSetAttribute((const void*)mk_fwd, hipFuncAttributeMaxDynamicSharedMemorySize, LDS_BYTES) != hipSuccess) { fprintf(stderr, "kernel_launch: hipFuncSetAttribute failed\n"); grid = -1; return; }
        if (hipOccupancyMaxActiveBlocksPerMultiprocessor(&per_cu, (const void*)mk_fwd, NWAVES * 64, LDS_BYTES) != hipSuccess || per_cu < 1) { fprintf(stderr, "kernel_launch: occupancy query says %d blocks per CU\n", per_cu); per_cu = 1; }
        (void)hipGetLastError();
        grid = cus * per_cu;
    }
    if (grid < 0) return;
    Args a{};
    for (int i = 0; i < 30; ++i) a.in[i] = (const float*)d_in[i];
    a.out = (float*)d_out; a.ws = (unsigned char*)d_ws;
    void* kargs[] = {&a};
    hipError_t e = hipLaunchCooperativeKernel((const void*)mk_fwd, dim3(grid), dim3(NWAVES * 64), kargs, LDS_BYTES, stream);
    if (e != hipSuccess) fprintf(stderr, "cooperative launch failed: %s (grid %d)\n", hipGetErrorString(e), grid);
}
```

```cpp
#include <hip/hip_runtime.h>
#include <hip/hip_cooperative_groups.h>
#include <cstdio>
#include <cstdint>
namespace cg = cooperative_groups;
template <int M> __device__ __forceinline__ float lane_xor(float v) { static_assert(M >= 1 && M <= 16, "lane_xor: within a 32-lane half"); return __uint_as_float((unsigned)__builtin_amdgcn_ds_swizzle((int)__float_as_uint(v), (M << 10) | 0x1f)); }
__device__ __forceinline__ float half_sum(float v) { auto rr = __builtin_amdgcn_permlane32_swap(__float_as_uint(v), __float_as_uint(v), false, false); return __uint_as_float(rr[0]) + __uint_as_float(rr[1]); }
__device__ __forceinline__ float half_max(float v) { auto rr = __builtin_amdgcn_permlane32_swap(__float_as_uint(v), __float_as_uint(v), false, false); return fmaxf(__uint_as_float(rr[0]), __uint_as_float(rr[1])); }
__device__ __forceinline__ float wave_sum64(float v) { v += lane_xor<1>(v); v += lane_xor<2>(v); v += lane_xor<4>(v); v += lane_xor<8>(v); v += lane_xor<16>(v); return half_sum(v); }
namespace pg8 {
#define PG8_LAS __attribute__((address_space(3)))
typedef unsigned short bf16_t;
typedef short bf16x8 __attribute__((ext_vector_type(8)));
typedef float f32x4 __attribute__((ext_vector_type(4)));
typedef unsigned u32x4 __attribute__((ext_vector_type(4)));
constexpr int BM = 256, BK = 64, HALF = 128, HTB = HALF * BK * 2  , STAGE_BYTES = 8 * HTB, NXCD = 8, WGM = 8;

__host__ __device__ __forceinline__ int lds_byte(int r, int c) { const int st = (r >> 4) * 2 + (c >> 5), rr = r & 15, cc = c & 31, ob = rr * 64 + cc * 2; return st * 1024 + (ob ^ (((ob >> 9) & 1) << 5)); }
__host__ __device__ __forceinline__ void stage_rc(int b, int& R, int& C) { const int st = b / 1024, sb = b % 1024, swz = sb ^ (((sb >> 9) & 1) << 5); R = (st >> 1) * 16 + swz / 64; C = (st & 1) * 32 + (swz % 64) / 2; }
__host__ __device__ __forceinline__ int perm32(int rho) { const int n = rho >> 4, i = rho & 15; return 8 * (i >> 2) + 4 * n + (i & 3); }

struct Unit { int pm, pn; };
struct Gemm { const bf16_t* A; const bf16_t* Bt; int M, N, K, lda, ldb, apn; };

struct StaticOrder {
    int nM, nN, nwg, G, c, rev;
    __host__ __device__ void init(int M, int N, int G_, int c_, int rev_ = 0) { nM = M / BM; nN = N / BM; nwg = nM * nN; G = G_; c = c_; rev = rev_; }
    __host__ __device__ bool next(int i, Unit& u) const {
        const long L = (long)i * G + c; if (L >= nwg) return false;
        int wgid = rev ? nwg - 1 - (int)L : (int)L; { const int q = nwg / NXCD, r = nwg % NXCD, xcd = wgid % NXCD, off = wgid / NXCD; wgid = (xcd < r ? xcd * (q + 1) : r * (q + 1) + (xcd - r) * q) + off; }
        const int nig = WGM * nN, gid = wgid / nig, fm = gid * WGM, gsz = (nM - fm) < WGM ? (nM - fm) : WGM;
        u.pm = fm + ((wgid % nig) % gsz); u.pn = (wgid % nig) / gsz; return true;
    }
    __device__ __forceinline__ void a_ready(const Unit&) const {}
    __device__ __forceinline__ void done(const Unit&) const {}
};

__device__ __forceinline__ unsigned cvt_pk_bf16(float lo, float hi) { unsigned r; asm volatile("v_cvt_pk_bf16_f32 %0, %1, %2" : "=v"(r) : "v"(lo), "v"(hi)); return r; }
typedef float f32x2 __attribute__((ext_vector_type(2)));
__device__ __forceinline__ f32x2 gelu_pk(f32x2 v) {
    const f32x2 av = __builtin_elementwise_abs(v), d = av * 0.2316418882f + 1.0f;
    f32x2 t; t.x = __builtin_amdgcn_rcpf(d.x); t.y = __builtin_amdgcn_rcpf(d.y);
    f32x2 q = t * 0.5307027145f + (-0.7265760135f); q = q * t + 0.7107068705f; q = q * t + (-0.142248368f); q = q * t + 0.127414796f; q = q * t;
    const f32x2 s = (v * v) * (-0.72134752044f);
    f32x2 e; e.x = __builtin_amdgcn_exp2f(s.x); e.y = __builtin_amdgcn_exp2f(s.y);
    const f32x2 m = v * (q * e), r = v - m;
    f32x2 o; o.x = v.x < 0.f ? m.x : r.x; o.y = v.y < 0.f ? m.y : r.y; return o;
}

template <int ACT  > struct EpiBf16 {
    static constexpr bool PERM = true, AFTER_DRAIN = false; static_assert(ACT == 0 || ACT == 1, "EpiBf16: ACT is 0 (none) or 1 (gelu_pk)");
    bf16_t* O; int ldc; const float* bias; int split_cols; size_t split_stride; float scale0;
    __device__ __forceinline__ void operator()(const f32x4 (&acc)[2][2][4][2], const Unit& u, int wr, int wc, int fr, int fq) const {
        const int row0 = u.pm * BM + wr * 64 + fr; int colt = u.pn * BM; bf16_t* base = O;
        float sc = 1.f; if (split_cols) { const int t = colt / split_cols; base += (size_t)t * split_stride; colt -= t * split_cols; if (t == 0) sc = scale0; }
        const int col0 = colt + wc * 32 + 8 * fq, bcol0 = u.pn * BM + wc * 32 + 8 * fq;
        f32x4 bv[2][2];
#pragma unroll
        for (int bj = 0; bj < 2; ++bj)
#pragma unroll
            for (int n = 0; n < 2; ++n) bv[bj][n] = bias ? *(const f32x4*)(bias + bcol0 + bj * HALF + 4 * n) : (f32x4){0.f, 0.f, 0.f, 0.f};
#pragma unroll
        for (int ai = 0; ai < 2; ++ai)
#pragma unroll
            for (int m = 0; m < 4; ++m) { bf16_t* rowp = base + (size_t)(row0 + ai * HALF + m * 16) * ldc + col0;
#pragma unroll
                for (int bj = 0; bj < 2; ++bj) { f32x4 v0 = acc[ai][bj][m][0] + bv[bj][0], v1 = acc[ai][bj][m][1] + bv[bj][1];
                    if (ACT == 1) { f32x2 a = gelu_pk((f32x2){v0[0], v0[1]}), b = gelu_pk((f32x2){v0[2], v0[3]}), c = gelu_pk((f32x2){v1[0], v1[1]}), d = gelu_pk((f32x2){v1[2], v1[3]});
                        v0 = (f32x4){a.x, a.y, b.x, b.y}; v1 = (f32x4){c.x, c.y, d.x, d.y}; }
                    v0 = v0 * sc; v1 = v1 * sc; u32x4 w; w.x = cvt_pk_bf16(v0[0], v0[1]); w.y = cvt_pk_bf16(v0[2], v0[3]); w.z = cvt_pk_bf16(v1[0], v1[1]); w.w = cvt_pk_bf16(v1[2], v1[3]);
                    *(u32x4*)(rowp + bj * HALF) = w; } }
    }
};
template <class Epi, class Sched, bool ALIGN_EPI = false, bool SP2 = false>
__device__ __forceinline__ void gemm_phase(PG8_LAS unsigned char* lds, const Gemm g, const Sched& S, const Epi& E) {
    int tid_ = threadIdx.x; asm volatile("" : "+v"(tid_));
    const int tid = tid_, wid = __builtin_amdgcn_readfirstlane(tid >> 6), lane = tid & 63, wr = wid >> 2, wc = wid & 3, fr = lane & 15, fq = lane >> 4;
    const int K = g.K, nt = K / BK;
    unsigned voffA[2], voffB[2];
#pragma unroll
    for (int i = 0; i < 2; ++i) { int R, C; stage_rc(tid * 16 + i * 8192, R, C); const int Rb = Epi::PERM ? ((R & ~31) + perm32(R & 31)) : R;
        voffA[i] = (unsigned)(R * g.lda + C) * 2u; voffB[i] = (unsigned)(Rb * g.ldb + C) * 2u; }
    const size_t kstep = (size_t)(BK * 2);
    const size_t hstepA = (size_t)HALF * g.lda * 2, hstepB = (size_t)HALF * g.ldb * 2;
    const size_t tstepA = 2 * hstepA, tstepB = 2 * hstepB;
    const unsigned ldsw = (unsigned)wid * 1024u;
    const int aoff = lds_byte(wr * 64 + fr, fq * 8), boff = lds_byte(wc * 32 + fr, fq * 8);
#define PG8_SA(b, h) (((b) * 2 + (h)) * HTB)
#define PG8_SB(b, h) ((4 + (b) * 2 + (h)) * HTB)
#define PG8_STAGE(bufoff, gbase, voff) do { _Pragma("unroll") for (int _i = 0; _i < 2; ++_i) \
        __builtin_amdgcn_global_load_lds((const unsigned*)((const char*)(gbase) + (voff)[_i]), (PG8_LAS unsigned*)(lds + (bufoff) + ldsw + _i * 8192), 16, 0, 0); } while (0)
#define PG8_LDA(dst, b, h) do { _Pragma("unroll") for (int m = 0; m < 4; ++m) _Pragma("unroll") for (int k = 0; k < 2; ++k) dst[m][k] = *(const PG8_LAS bf16x8*)(lds + PG8_SA(b, h) + aoff + m * 2048 + k * 1024); } while (0)
#define PG8_LDB(dst, b, h) do { _Pragma("unroll") for (int n = 0; n < 2; ++n) _Pragma("unroll") for (int k = 0; k < 2; ++k) dst[n][k] = *(const PG8_LAS bf16x8*)(lds + PG8_SB(b, h) + boff + n * 2048 + k * 1024); } while (0)
#define PG8_MMA(ai, bj, At, Bt) do { __builtin_amdgcn_s_setprio(1); _Pragma("unroll") for (int m = 0; m < 4; ++m) _Pragma("unroll") for (int n = 0; n < 2; ++n) _Pragma("unroll") for (int k = 0; k < 2; ++k) \
        acc[ai][bj][m][n] = __builtin_amdgcn_mfma_f32_16x16x32_bf16(Bt[n][k], At[m][k], acc[ai][bj][m][n], 0, 0, 0); __builtin_amdgcn_s_setprio(0); } while (0)
#define PG8_WAIT_V(n) asm volatile("s_waitcnt vmcnt(" #n ")" ::: "memory")
#define PG8_WAIT_L(n) asm volatile("s_waitcnt lgkmcnt(" #n ")" ::: "memory")
#define PG8_BAR __builtin_amdgcn_s_barrier()
#define PG8_SCHED __builtin_amdgcn_sched_barrier(0)
    Unit cur, nxt; int ui = 0;
    if (!S.next(0, cur)) return;
    f32x4 acc[2][2][4][2];
#pragma unroll
    for (int a = 0; a < 2; ++a)
#pragma unroll
        for (int b = 0; b < 2; ++b)
#pragma unroll
            for (int m = 0; m < 4; ++m)
#pragma unroll
                for (int n = 0; n < 2; ++n) acc[a][b][m][n] = (f32x4){0.f, 0.f, 0.f, 0.f};
    bf16x8 At[4][2], B0[2][2], B1[2][2];
    const char* cA = (const char*)g.A + (size_t)cur.pm * tstepA + (size_t)cur.pn * g.apn; const char* cB = (const char*)g.Bt + (size_t)cur.pn * tstepB;
    S.a_ready(cur);
    if constexpr (SP2) {
        PG8_STAGE(PG8_SB(0, 0), cB, voffB); PG8_STAGE(PG8_SB(0, 1), cB + hstepB, voffB); PG8_STAGE(PG8_SA(0, 0), cA, voffA); PG8_STAGE(PG8_SA(0, 1), cA + hstepA, voffA);
        if (wr == 1) PG8_BAR;
        PG8_WAIT_V(2); PG8_BAR;
        PG8_STAGE(PG8_SB(1, 0), cB + kstep, voffB); PG8_STAGE(PG8_SA(1, 0), cA + kstep, voffA); PG8_STAGE(PG8_SB(1, 1), cB + hstepB + kstep, voffB);
        PG8_WAIT_V(6); PG8_BAR;
    } else {
        PG8_STAGE(PG8_SB(0, 0), cB, voffB); PG8_STAGE(PG8_SA(0, 0), cA, voffA); PG8_STAGE(PG8_SB(0, 1), cB + hstepB, voffB); PG8_STAGE(PG8_SA(0, 1), cA + hstepA, voffA);
        if (wr == 1) PG8_BAR;
        PG8_WAIT_V(4); PG8_BAR;
        PG8_STAGE(PG8_SB(1, 0), cB + kstep, voffB); PG8_STAGE(PG8_SA(1, 0), cA + kstep, voffA); PG8_STAGE(PG8_SB(1, 1), cB + hstepB + kstep, voffB);
        PG8_WAIT_V(6); PG8_BAR;
    }
    for (;;) {
        const bool has_next = S.next(ui + 1, nxt);
        const char* nA = has_next ? (const char*)g.A + (size_t)nxt.pm * tstepA + (size_t)nxt.pn * g.apn : cA; const char* nB = has_next ? (const char*)g.Bt + (size_t)nxt.pn * tstepB : cB;
        for (int t = 0; t < nt; t += 2) {
            const bool last = (t == nt - 2);
            const char* a1 = cA + (size_t)(t + 1) * kstep;
            const char* a2 = last ? nA : cA + (size_t)(t + 2) * kstep; const char* b2 = last ? nB : cB + (size_t)(t + 2) * kstep;
            const char* a3 = a2 + kstep; const char* b3 = b2 + kstep;
            if (last && has_next) S.a_ready(nxt);
            if constexpr (SP2) {
            PG8_LDB(B0, 0, 0); PG8_LDB(B1, 0, 1); PG8_SCHED; PG8_LDA(At, 0, 0); PG8_STAGE(PG8_SA(1, 1), a1 + hstepA, voffA);
            PG8_WAIT_V(8); PG8_WAIT_L(0); PG8_BAR; PG8_MMA(0, 0, At, B0); PG8_MMA(0, 1, At, B1); PG8_BAR; PG8_SCHED;
            PG8_LDA(At, 0, 1); PG8_STAGE(PG8_SB(0, 0), b2, voffB); PG8_STAGE(PG8_SB(0, 1), b2 + hstepB, voffB); PG8_STAGE(PG8_SA(0, 0), a2, voffA);
            PG8_WAIT_V(8); PG8_WAIT_L(0); PG8_BAR; PG8_MMA(1, 0, At, B0); PG8_MMA(1, 1, At, B1); PG8_BAR; PG8_SCHED;
            PG8_LDB(B0, 1, 0); PG8_LDB(B1, 1, 1); PG8_SCHED; PG8_LDA(At, 1, 0); PG8_STAGE(PG8_SA(0, 1), a2 + hstepA, voffA);
            PG8_WAIT_V(8); PG8_WAIT_L(0); PG8_BAR; PG8_MMA(0, 0, At, B0); PG8_MMA(0, 1, At, B1); PG8_BAR; PG8_SCHED;
            PG8_LDA(At, 1, 1); PG8_STAGE(PG8_SB(1, 0), b3, voffB); PG8_STAGE(PG8_SB(1, 1), b3 + hstepB, voffB); PG8_STAGE(PG8_SA(1, 0), a3, voffA);
            PG8_WAIT_V(8); PG8_WAIT_L(0); PG8_BAR; PG8_MMA(1, 0, At, B0); PG8_MMA(1, 1, At, B1); PG8_BAR; PG8_SCHED;
            } else {
            PG8_LDB(B0, 0, 0); PG8_SCHED; PG8_LDA(At, 0, 0); PG8_STAGE(PG8_SA(1, 1), a1 + hstepA, voffA);
            PG8_WAIT_L(8); PG8_BAR; PG8_WAIT_L(0); PG8_MMA(0, 0, At, B0); PG8_BAR; PG8_SCHED;
            PG8_LDB(B1, 0, 1); PG8_STAGE(PG8_SB(0, 0), b2, voffB);
            PG8_BAR; PG8_WAIT_L(0); PG8_MMA(0, 1, At, B1); PG8_BAR;
            PG8_LDA(At, 0, 1); PG8_STAGE(PG8_SA(0, 0), a2, voffA);
            PG8_BAR; PG8_WAIT_L(0); PG8_MMA(1, 0, At, B0); PG8_BAR; PG8_SCHED;
            PG8_STAGE(PG8_SB(0, 1), b2 + hstepB, voffB);
            PG8_WAIT_V(6); PG8_BAR; PG8_MMA(1, 1, At, B1); PG8_BAR;
            PG8_LDB(B0, 1, 0); PG8_SCHED; PG8_LDA(At, 1, 0); PG8_STAGE(PG8_SA(0, 1), a2 + hstepA, voffA);
            PG8_WAIT_L(8); PG8_BAR; PG8_WAIT_L(0); PG8_MMA(0, 0, At, B0); PG8_BAR; PG8_SCHED;
            PG8_LDB(B1, 1, 1); PG8_STAGE(PG8_SB(1, 0), b3, voffB);
            PG8_BAR; PG8_WAIT_L(0); PG8_MMA(0, 1, At, B1); PG8_BAR;
            PG8_LDA(At, 1, 1); PG8_STAGE(PG8_SA(1, 0), a3, voffA);
            PG8_BAR; PG8_WAIT_L(0); PG8_MMA(1, 0, At, B0); PG8_BAR; PG8_SCHED;
            PG8_STAGE(PG8_SB(1, 1), b3 + hstepB, voffB);
            PG8_WAIT_V(6); PG8_BAR; PG8_MMA(1, 1, At, B1); PG8_BAR;
            }
        }
        if constexpr (ALIGN_EPI) { if (wr == 0) PG8_BAR; }
        if constexpr (!Epi::AFTER_DRAIN) { E(acc, cur, wr, wc, fr, fq); S.done(cur); }
        if (!has_next) break;
#pragma unroll
        for (int a = 0; a < 2; ++a)
#pragma unroll
            for (int b = 0; b < 2; ++b)
#pragma unroll
                for (int m = 0; m < 4; ++m)
#pragma unroll
                    for (int n = 0; n < 2; ++n) acc[a][b][m][n] = (f32x4){0.f, 0.f, 0.f, 0.f};
        cur = nxt; cA = nA; cB = nB; ++ui;
        if constexpr (ALIGN_EPI) { if (wr == 1) PG8_BAR; }
    }
    PG8_WAIT_V(0);
    if constexpr (!ALIGN_EPI) { if (wr == 0) PG8_BAR; }
    PG8_BAR;
    if constexpr (Epi::AFTER_DRAIN) { E.fused(acc, cur, wr, wc, fr, fq, lds, wid, lane); S.done(cur); }
#undef PG8_SA
#undef PG8_SB
#undef PG8_STAGE
#undef PG8_LDA
#undef PG8_LDB
#undef PG8_MMA
#undef PG8_WAIT_V
#undef PG8_WAIT_L
#undef PG8_BAR
#undef PG8_SCHED
}
}
namespace pg8 {
struct EpiSwiglu {
    static constexpr bool PERM = true, AFTER_DRAIN = false;
    bf16_t* H; int ldh;
    __device__ __forceinline__ void operator()(const f32x4 (&acc)[2][2][4][2], const Unit& u, int wr, int wc, int fr, int fq) const {
        const int row0 = u.pm * BM + wr * 64 + fr, col0 = u.pn * HALF + wc * 32 + 8 * fq;
#pragma unroll
        for (int ai = 0; ai < 2; ++ai)
#pragma unroll
            for (int m = 0; m < 4; ++m) { bf16_t* rowp = H + (size_t)(row0 + ai * HALF + m * 16) * ldh + col0;
                float hv[8];
#pragma unroll
                for (int n = 0; n < 2; ++n)
#pragma unroll
                    for (int i = 0; i < 4; ++i) { const float g = acc[ai][0][m][n][i], up = acc[ai][1][m][n][i];
                        const float e = __builtin_amdgcn_exp2f(g * -1.4426950408889634f); hv[n * 4 + i] = g * __builtin_amdgcn_rcpf(1.0f + e) * up; }
                u32x4 w; w.x = cvt_pk_bf16(hv[0], hv[1]); w.y = cvt_pk_bf16(hv[2], hv[3]); w.z = cvt_pk_bf16(hv[4], hv[5]); w.w = cvt_pk_bf16(hv[6], hv[7]);
                *(u32x4*)rowp = w; }
    }
};
struct EpiScaleBf16 {
    static constexpr bool PERM = true, AFTER_DRAIN = false;
    bf16_t* Y; const float* cscale; float cs;
    __device__ __forceinline__ void operator()(const f32x4 (&acc)[2][2][4][2], const Unit& u, int wr, int wc, int fr, int fq) const {
        const int row0 = u.pm * BM + wr * 64 + fr, col0 = u.pn * BM + wc * 32 + 8 * fq;
        f32x4 sc[2][2];
#pragma unroll
        for (int bj = 0; bj < 2; ++bj)
#pragma unroll
            for (int n = 0; n < 2; ++n) sc[bj][n] = cscale ? *(const f32x4*)(cscale + col0 + bj * HALF + 4 * n) : (f32x4){cs, cs, cs, cs};
#pragma unroll
        for (int ai = 0; ai < 2; ++ai)
#pragma unroll
            for (int m = 0; m < 4; ++m) { bf16_t* rowp = Y + (size_t)(row0 + ai * HALF + m * 16) * 1024 + col0;
#pragma unroll
                for (int bj = 0; bj < 2; ++bj) { const f32x4 v0 = acc[ai][bj][m][0] * sc[bj][0], v1 = acc[ai][bj][m][1] * sc[bj][1];
                    u32x4 w; w.x = cvt_pk_bf16(v0[0], v0[1]); w.y = cvt_pk_bf16(v0[2], v0[3]); w.z = cvt_pk_bf16(v1[0], v1[1]); w.w = cvt_pk_bf16(v1[2], v1[3]);
                    *(u32x4*)(rowp + bj * HALF) = w; } }
    }
};
struct EpiQKV {
    static constexpr bool PERM = true, AFTER_DRAIN = false;
    bf16_t* O; float qscale; unsigned* tab;
    __device__ __forceinline__ void operator()(const f32x4 (&acc)[2][2][4][2], const Unit& u, int wr, int wc, int fr, int fq) const {
        const int row0 = u.pm * BM + wr * 64 + fr, col0 = u.pn * BM + wc * 32 + 8 * fq; const float sc = u.pn < 4 ? qscale : 1.f; const bool nrm = u.pn < 8;
        float mx[2] = {0.f, 0.f};
#pragma unroll
        for (int ai = 0; ai < 2; ++ai)
#pragma unroll
            for (int m = 0; m < 4; ++m) { bf16_t* rowp = O + (size_t)(row0 + ai * HALF + m * 16) * 3072 + col0;
#pragma unroll
                for (int bj = 0; bj < 2; ++bj) { const f32x4 v0 = acc[ai][bj][m][0] * sc, v1 = acc[ai][bj][m][1] * sc;
                    u32x4 w; w.x = cvt_pk_bf16(v0[0], v0[1]); w.y = cvt_pk_bf16(v0[2], v0[3]); w.z = cvt_pk_bf16(v1[0], v1[1]); w.w = cvt_pk_bf16(v1[2], v1[3]);
                    *(u32x4*)(rowp + bj * HALF) = w;
                    if (nrm) { const unsigned ww[4] = {w.x, w.y, w.z, w.w}; float ss = 0.f;
#pragma unroll
                        for (int k = 0; k < 4; ++k) { const float lo = __uint_as_float(ww[k] << 16), hi = __uint_as_float(ww[k] & 0xffff0000u); ss += lo * lo + hi * hi; }
                        ss += lane_xor<16>(ss); ss = half_sum(ss); mx[bj] = fmaxf(mx[bj], ss); } } }
        if (nrm) {
#pragma unroll
            for (int bj = 0; bj < 2; ++bj) { float m = mx[bj]; m = fmaxf(m, lane_xor<1>(m)); m = fmaxf(m, lane_xor<2>(m)); m = fmaxf(m, lane_xor<4>(m)); m = fmaxf(m, lane_xor<8>(m));
                if ((fr | fq) == 0) atomicMax(tab + (u.pm >> 5) * 64 + (4 * u.pn + 2 * bj + (wc >> 1)) * 2 + (wc & 1), __float_as_uint(m)); } }
    }
};
}
#define PG8_SP2 true
#define PG8_ALIGN true
#include <hip/hip_bf16.h>
#include <cmath>
#include <hip/hip_bf16.h>
#include <cmath>
namespace attn_body {
using bf16=__hip_bfloat16;
using bf16x8=__attribute__((ext_vector_type(8)))short;
using s16x4=__attribute__((ext_vector_type(4)))short;
using f32x16=__attribute__((ext_vector_type(16)))float;
using u32x4=__attribute__((ext_vector_type(4)))unsigned;
constexpr int SEQ=8192,D=64,PQ=3072,PO=1024;
constexpr int NW=8,QBLK=32,QB=QBLK*NW,KVBLK=64,NQB=SEQ/QB;
constexpr int ATTN_UNIT_ROWS=QB;
__device__ __forceinline__ int crow(int r,int hi){return (r&3)+8*(r>>2)+4*hi;}
#define SBAR() __builtin_amdgcn_sched_barrier(0)
__device__ __forceinline__ void cmask(f32x16&p0,f32x16&p1,int jb,int qrel,int hi){
  const float NEG=-INFINITY; int kb=64*jb+4*hi;
  #pragma unroll
  for(int r=0;r<16;++r){int kv=kb+(r&3)+8*(r>>2); if(kv>qrel)p0[r]=NEG; if(kv+32>qrel)p1[r]=NEG;}
}

constexpr int NSLOT=3, SLOTB=8192;
constexpr int LDS_K=0, LDS_V=NSLOT*SLOTB, LDS_WS=3*NSLOT*SLOTB, LDS_OST=LDS_WS+NW*64*4, LDS_BYTES=LDS_OST+NW*8192;
constexpr float C2=0.125f*1.4426950408889634f;
__device__ __forceinline__ void glds16(const void*gsrc,unsigned lds_dst){unsigned keep;
  asm volatile("s_mov_b32 %0, m0\n\ts_mov_b32 m0, %2\n\ts_nop 0\n\tglobal_load_lds_dwordx4 %1, off\n\ts_mov_b32 m0, %0":"=&s"(keep):"v"(gsrc),"s"(lds_dst):"memory");}
template<int IMM> __device__ __forceinline__ void glds16s(const void*sbase,unsigned voff,unsigned lds_dst){unsigned keep;
  asm volatile("s_mov_b32 %0, m0\n\ts_mov_b32 m0, %3\n\ts_nop 0\n\tglobal_load_lds_dwordx4 %1, %2 offset:%c4\n\ts_mov_b32 m0, %0":"=&s"(keep):"v"(voff),"s"(sbase),"s"(lds_dst),"i"(IMM):"memory");}
__device__ __forceinline__ float max3f(float a,float b,float c){float r;asm("v_max3_f32 %0, %1, %2, %3":"=v"(r):"v"(a),"v"(b),"v"(c));return r;}
__device__ __forceinline__ float max2f(float a,float b){float r;asm("v_max_f32_e32 %0, %1, %2":"=v"(r):"v"(a),"v"(b));return r;}
__device__ __forceinline__ float fadd_s(float a,float b){float r;asm("v_add_f32_e32 %0, %1, %2":"=v"(r):"v"(a),"v"(b));return r;}
__device__ __forceinline__ float fsub_s(float a,float b){float r;asm("v_sub_f32_e32 %0, %1, %2":"=v"(r):"v"(a),"v"(b));return r;}
typedef float f32x2_t __attribute__((ext_vector_type(2))); typedef __bf16 bf16x2_t __attribute__((ext_vector_type(2)));
__device__ __forceinline__ unsigned cvtpk_s(float lo,float hi){f32x2_t v={lo,hi};bf16x2_t b=__builtin_convertvector(v,bf16x2_t);return __builtin_bit_cast(unsigned,b);}
#define WAIT_BAR(N) asm volatile("s_waitcnt vmcnt(" #N ") lgkmcnt(0)\n\ts_barrier":::"memory")

__device__ __forceinline__ void qkt(f32x16&p0,f32x16&p1,const char*Kslot,const bf16x8*qr,const f32x16&negm,int r32,int hi){
  const char*kb=Kslot+hi*1024+r32*16;
  #pragma unroll
  for(int d0=0;d0<4;++d0){
    const bf16x8 b0=*reinterpret_cast<const bf16x8*>(kb+d0*2048);
    const bf16x8 b1=*reinterpret_cast<const bf16x8*>(kb+d0*2048+512);
    if(d0==0){p0=__builtin_amdgcn_mfma_f32_32x32x16_bf16(b0,qr[0],negm,0,0,0);p1=__builtin_amdgcn_mfma_f32_32x32x16_bf16(b1,qr[0],negm,0,0,0);}
    else{p0=__builtin_amdgcn_mfma_f32_32x32x16_bf16(b0,qr[d0],p0,0,0,0);p1=__builtin_amdgcn_mfma_f32_32x32x16_bf16(b1,qr[d0],p1,0,0,0);}}
}
typedef __attribute__((address_space(3))) const char* lds_cptr;
typedef short v4i16_t __attribute__((ext_vector_type(4)));
__device__ __forceinline__ void kload8(bf16x8*kf,lds_cptr kp){
  kf[0]=*(const __attribute__((address_space(3))) bf16x8*)(kp);      kf[1]=*(const __attribute__((address_space(3))) bf16x8*)(kp+512);
  kf[2]=*(const __attribute__((address_space(3))) bf16x8*)(kp+2048); kf[3]=*(const __attribute__((address_space(3))) bf16x8*)(kp+2560);
  kf[4]=*(const __attribute__((address_space(3))) bf16x8*)(kp+4096); kf[5]=*(const __attribute__((address_space(3))) bf16x8*)(kp+4608);
  kf[6]=*(const __attribute__((address_space(3))) bf16x8*)(kp+6144); kf[7]=*(const __attribute__((address_space(3))) bf16x8*)(kp+6656);
}
__device__ __forceinline__ void kload2(bf16x8*kf,lds_cptr kp,int j){ kf[2*j]=*(const __attribute__((address_space(3))) bf16x8*)(kp+j*2048); kf[2*j+1]=*(const __attribute__((address_space(3))) bf16x8*)(kp+j*2048+512); }
__device__ __forceinline__ s16x4 vtr(lds_cptr p){ return __builtin_bit_cast(s16x4,__builtin_amdgcn_ds_read_tr16_b64_v4i16((__attribute__((address_space(3))) v4i16_t*)p)); }
__device__ __forceinline__ float rowmax(const f32x16&p0,const f32x16&p1){
  float a=max3f(p0[0],p0[1],p1[0]),b=max3f(p0[2],p0[3],p1[1]);a=max3f(a,p1[2],p1[3]);
  #pragma unroll
  for(int r=4;r<16;r+=4){a=max3f(a,p0[r],p0[r+1]);b=max3f(b,p0[r+2],p0[r+3]);a=max3f(a,p1[r],p1[r+1]);b=max3f(b,p1[r+2],p1[r+3]);}
  const float m=max2f(a,b);
  auto rr=__builtin_amdgcn_permlane32_swap(__float_as_uint(m),__float_as_uint(m),false,false);
  return max2f(__uint_as_float(rr[0]),__uint_as_float(rr[1]));
}
__device__ __forceinline__ void pv(f32x16*o,int vb,bf16x8 pa0,bf16x8 pa1,bf16x8 pa2,bf16x8 pa3){
  #pragma unroll
  for(int d0=0;d0<4;++d0){s16x4 lo[4],hi[4];
    #pragma unroll
    for(int ks=0;ks<4;++ks){
      asm volatile("ds_read_b64_tr_b16 %0,%1 offset:%c2":"=&v"(lo[ks]):"v"(vb),"i"(d0*4096+ks*1024):"memory");
      asm volatile("ds_read_b64_tr_b16 %0,%1 offset:%c2":"=&v"(hi[ks]):"v"(vb),"i"(d0*4096+ks*1024+512):"memory");}
    asm volatile("s_waitcnt lgkmcnt(0)":::"memory");SBAR();
    #define PK(k) (bf16x8){lo[k][0],lo[k][1],lo[k][2],lo[k][3],hi[k][0],hi[k][1],hi[k][2],hi[k][3]}
    o[d0]=__builtin_amdgcn_mfma_f32_32x32x16_bf16(pa0,PK(0),o[d0],0,0,0);
    o[d0]=__builtin_amdgcn_mfma_f32_32x32x16_bf16(pa1,PK(1),o[d0],0,0,0);
    o[d0]=__builtin_amdgcn_mfma_f32_32x32x16_bf16(pa2,PK(2),o[d0],0,0,0);
    o[d0]=__builtin_amdgcn_mfma_f32_32x32x16_bf16(pa3,PK(3),o[d0],0,0,0);
    #undef PK
  }
}

#ifndef ATTN_STORE16
#define ATTN_STORE16(p,v) (*(u32x4*)(p)=(v))
#endif
template<int THRL,int MODE> __device__ __forceinline__ void attn_unit(long rowbase,int qb,const bf16*Q,const bf16*__restrict__ K,const bf16*__restrict__ V,bf16*O,const bf16*O1,float lam,const float*gsc,float sl,int T0,char*shm){
  int tid_=threadIdx.x; asm volatile("":"+v"(tid_)); const int tid=tid_,lane=tid&63,r32=lane&31,hi=lane>>5; const int wid=__builtin_amdgcn_readfirstlane(tid>>6);
  const int q0=qb*QB; const float sl64=__uint_as_float(__builtin_amdgcn_readfirstlane(__float_as_uint(64.f*sl))), sl32=__uint_as_float(__builtin_amdgcn_readfirstlane(__float_as_uint(32.f*sl)));
  const bf16*Qw=Q+(rowbase+q0+wid*QBLK)*PQ;
  const bf16*Kh=K+(rowbase+(long)T0*KVBLK)*PQ,*Vh=V+(rowbase+(long)T0*KVBLK)*PQ;
  const unsigned lds0=(unsigned)(uintptr_t)shm;
  float*wsf=(float*)(shm+LDS_WS)+wid*64;
  const unsigned koff=(unsigned)(lane*PQ+wid*8)*2u, voff=(unsigned)((16*(wid&3)+(lane>>2))*PQ+(wid>>2)*32+(lane&3)*8)*2u;
  const unsigned kdst=lds0+LDS_K+wid*1024, vdst=lds0+LDS_V+wid*1024;
  #define DMA_K(t,slot) glds16s<0>(Kh+(long)(t)*KVBLK*PQ,koff,(unsigned)__builtin_amdgcn_readfirstlane(kdst+(slot)))
  #define DMA_V(t,slot) do{ glds16s<0>(Vh+(long)(t)*KVBLK*PQ,voff,(unsigned)__builtin_amdgcn_readfirstlane(vdst+2*(slot))); glds16s<0>(Vh+(long)(t)*KVBLK*PQ+64,voff,(unsigned)__builtin_amdgcn_readfirstlane(vdst+2*(slot)+8192)); }while(0)
  const char*Kbase=shm+LDS_K; bf16x8 kf[8];
  const lds_cptr shm3=(lds_cptr)shm; const lds_cptr kp0=shm3+LDS_K+hi*1024+r32*16; const lds_cptr vp0=shm3+LDS_V+((lane>>4)&1)*32+(lane&3)*8+(4*hi+((lane&15)>>2))*64;
  const int NT=(q0+QB)/KVBLK-T0;
  DMA_K(0,0);DMA_V(0,0);DMA_K(1,SLOTB);
  bf16x8 qr[4];
  #pragma unroll
  for(int d0=0;d0<4;++d0)qr[d0]=*reinterpret_cast<const bf16x8*>(&Qw[(long)r32*PQ+d0*16+hi*8]);
  typedef __attribute__((address_space(3))) bf16x8* lds_q8; const lds_q8 qpark=(lds_q8)((__attribute__((address_space(3))) char*)shm+LDS_OST+wid*8192+lane*16);
  #pragma unroll
  for(int d0=0;d0<4;++d0)qpark[d0*64]=qr[d0];
  #define QLD(d0) (qpark[(d0)*64])
  float mhat=0.f,l_reg=0.f;f32x16 o[4];o[0]=f32x16{};o[1]=f32x16{};o[2]=f32x16{};o[3]=f32x16{};const int qrel=wid*QBLK+r32;
  f32x16 negm;
  #pragma unroll
  for(int r=0;r<16;++r)negm[r]=sl*(float)(T0*KVBLK+crow(r,hi)-(q0+qrel));
  asm volatile("":"+v"(negm));
  #define CMASK(P0,P1,t) do{int jb_=(t)-(NT-4); if(jb_>=0)cmask(P0,P1,jb_,qrel,hi);}while(0)
  bool resc=false;
  #define START(P0,P1) do{ const float rm=rowmax(P0,P1); resc=false; \
    { const float dl=rm; mhat=fadd_s(mhat,dl); \
      _Pragma("unroll") for(int r=0;r<16;++r){P0[r]=fsub_s(P0[r],dl);P1[r]=fsub_s(P1[r],dl);} \
      { const float adj_=sl64-dl; _Pragma("unroll") for(int r=0;r<16;++r)negm[r]+=adj_; } asm volatile("":"+v"(negm)); } \
    _Pragma("unroll") for(int r=0;r<16;++r)P0[r]=__builtin_amdgcn_exp2f(P0[r]); }while(0)
  #define RESC() do{ if(resc){ asm volatile("s_waitcnt lgkmcnt(0)":::"memory"); \
      _Pragma("unroll") for(int d_=0;d_<4;++d_) _Pragma("unroll") for(int r=0;r<16;++r)o[d_][r]*=wsf[crow(r,hi)]; } }while(0)
  f32x16 pA0,pA1,pB0,pB1;
  int sl_prev=0,sl_cur=0,sl_next=SLOTB;
  #define ROT() do{sl_prev=sl_cur;sl_cur=sl_next;sl_next=(sl_next==(NSLOT-1)*SLOTB)?0:sl_next+SLOTB;}while(0)
  DMA_K(2,2*SLOTB);
  WAIT_BAR(3);
  qkt(pA0,pA1,Kbase,qr,negm,r32,hi);asm volatile("s_nop 15\n\ts_nop 7":"+v"(pA0),"+v"(pA1));
  _Pragma("unroll") for(int r=0;r<16;++r)pA1[r]+=sl32;
  CMASK(pA0,pA1,0);
  START(pA0,pA1);
  _Pragma("unroll") for(int r=0;r<16;++r)pA1[r]=__builtin_amdgcn_exp2f(pA1[r]);
  WAIT_BAR(0);
  DMA_K(3,0);DMA_V(1,SLOTB);
  ROT();
  kload8(kf,kp0+sl_cur);
  WAIT_BAR(3);
  s16x4 vlo[8],vhi[8]; u32x4 pw0,pw1,pw2,pw3;
  #define PKW(P,B) cvtpk_s(P[B],P[B+1])
  #define PAF(k) __builtin_bit_cast(bf16x8,pw##k)
  #define VFR(i) (bf16x8){vlo[i][0],vlo[i][1],vlo[i][2],vlo[i][3],vhi[i][0],vhi[i][1],vhi[i][2],vhi[i][3]}
  #define PIN(x) asm volatile("":"+v"(x))
  #define MX3(a,b,c) __builtin_fmaxf(__builtin_fmaxf((a),(b)),(c))
  #define GAPA(MF,A0,A1,A2,A3,W0,W1,PW) do{ MF; sacc+=A0; sacc+=A1; sacc+=A2; sacc+=A3; PIN(sacc); W0; W1; PIN(PW); SBAR(); }while(0)
  #define EX(v) __builtin_amdgcn_exp2f(v)
  #define GAPB2(MF,X,B) do{ MF; X[B]=EX(X[B]); X[B+1]=EX(X[B+1]); PIN(X); SBAR(); }while(0)
  #define VRD(i) do{ vlo[i]=vtr(vp_+(((i)>>2)*4096+((i)&3)*1024)); vhi[i]=vtr(vp_+(((i)>>2)*4096+((i)&3)*1024+512)); }while(0)
  #define VRD2(i) do{ vlo[i]=vtr(vp_+((2+((i)>>2))*4096+((i)&3)*1024)); vhi[i]=vtr(vp_+((2+((i)>>2))*4096+((i)&3)*1024+512)); }while(0)
  #define KRD(G,j) do{ if(G){ kload2(kf,kp0+sl_next,j); SBAR(); } }while(0)
  #define STEP(C0,C1,P0,P1,t,GK,GV,GL) do{ SBAR(); \
    const lds_cptr vp_=vp0+2*sl_prev; \
    const bf16x8 q0_=QLD(0),q1_=QLD(1); \
    VRD(0); SBAR(); float sacc=(P0[0]+P0[1]); \
    GAPA(C0=__builtin_amdgcn_mfma_f32_32x32x16_bf16(kf[0],q0_,negm,0,0,0), P0[2],P0[3],P0[4],P0[5],     pw0[0]=PKW(P0,0), pw0[1]=PKW(P0,2), pw0); \
    VRD(4); SBAR(); GAPA(C1=__builtin_amdgcn_mfma_f32_32x32x16_bf16(kf[1],q0_,negm,0,0,0), P0[6],P0[7],P0[8],P0[9],     pw0[2]=PKW(P0,4), pw0[3]=PKW(P0,6), pw0); \
    const bf16x8 q2_=QLD(2); VRD(1); SBAR(); GAPA(C0=__builtin_amdgcn_mfma_f32_32x32x16_bf16(kf[2],q1_,C0,0,0,0),   P0[10],P0[11],P0[12],P0[13], pw1[0]=PKW(P0,8), pw1[1]=PKW(P0,10), pw1); \
    VRD(5); SBAR(); GAPA(C1=__builtin_amdgcn_mfma_f32_32x32x16_bf16(kf[3],q1_,C1,0,0,0),   P0[14],P0[15],P1[0],P1[1],   pw1[2]=PKW(P0,12),pw1[3]=PKW(P0,14), pw1); \
    const bf16x8 q3_=QLD(3); VRD(2); SBAR(); GAPA(C0=__builtin_amdgcn_mfma_f32_32x32x16_bf16(kf[4],q2_,C0,0,0,0),   P1[2],P1[3],P1[4],P1[5],     pw2[0]=PKW(P1,0), pw2[1]=PKW(P1,2), pw2); \
    VRD(6); SBAR(); GAPA(C1=__builtin_amdgcn_mfma_f32_32x32x16_bf16(kf[5],q2_,C1,0,0,0),   P1[6],P1[7],P1[8],P1[9],     pw2[2]=PKW(P1,4), pw2[3]=PKW(P1,6), pw2); \
    VRD(3); SBAR(); GAPA(C0=__builtin_amdgcn_mfma_f32_32x32x16_bf16(kf[6],q3_,C0,0,0,0),   P1[10],P1[11],P1[12],P1[13], pw3[0]=PKW(P1,8), pw3[1]=PKW(P1,10), pw3); \
    VRD(7); SBAR(); GAPA(C1=__builtin_amdgcn_mfma_f32_32x32x16_bf16(kf[7],q3_,C1,0,0,0),   P1[14],P1[15],0.f,0.f,       pw3[2]=PKW(P1,12),pw3[3]=PKW(P1,14), pw3); \
    l_reg+=sacc; \
    if(GK){DMA_K((t)+3,sl_cur);} if(GV){DMA_V((t)+1,sl_next);} \
    _Pragma("unroll") for(int r=0;r<16;++r)C1[r]+=sl32; \
    CMASK(C0,C1,t); \
    { float a=MX3(C0[0],C0[1],C1[0]),b=MX3(C0[2],C0[3],C1[1]); a=MX3(a,C1[2],C1[3]); \
      _Pragma("unroll") for(int r=4;r<16;r+=4){a=MX3(a,C0[r],C0[r+1]);b=MX3(b,C0[r+2],C0[r+3]);a=MX3(a,C1[r],C1[r+1]);b=MX3(b,C1[r+2],C1[r+3]);} \
      float rm=__builtin_fmaxf(a,b); { auto rr=__builtin_amdgcn_permlane32_swap(__float_as_uint(rm),__float_as_uint(rm),false,false); rm=__builtin_fmaxf(__uint_as_float(rr[0]),__uint_as_float(rr[1])); } \
      resc=false; float adj_=sl64; \
      if(__builtin_expect(__any(rm>(float)THRL),0)){ const float dl=__builtin_fmaxf(rm,0.f); mhat+=dl; adj_-=dl; \
        _Pragma("unroll") for(int r=0;r<16;++r){C0[r]-=dl;C1[r]-=dl;} \
        const float f=__builtin_amdgcn_exp2f(-dl); l_reg*=f; if(hi==0)wsf[r32]=f; resc=true; } \
      _Pragma("unroll") for(int r=0;r<16;++r)negm[r]+=adj_; asm volatile("":"+v"(negm)); } \
    SBAR(); \
    GAPB2(o[0]=__builtin_amdgcn_mfma_f32_32x32x16_bf16(PAF(0),VFR(0),o[0],0,0,0), C0,0); VRD2(0); SBAR(); \
    GAPB2(o[1]=__builtin_amdgcn_mfma_f32_32x32x16_bf16(PAF(0),VFR(4),o[1],0,0,0), C0,2); VRD2(4); SBAR(); \
    KRD(GL,0); GAPB2(o[0]=__builtin_amdgcn_mfma_f32_32x32x16_bf16(PAF(1),VFR(1),o[0],0,0,0), C0,4); VRD2(1); SBAR(); \
    KRD(GL,1); GAPB2(o[1]=__builtin_amdgcn_mfma_f32_32x32x16_bf16(PAF(1),VFR(5),o[1],0,0,0), C0,6); VRD2(5); SBAR(); \
    KRD(GL,2); GAPB2(o[0]=__builtin_amdgcn_mfma_f32_32x32x16_bf16(PAF(2),VFR(2),o[0],0,0,0), C0,8); VRD2(2); SBAR(); \
    KRD(GL,3); GAPB2(o[1]=__builtin_amdgcn_mfma_f32_32x32x16_bf16(PAF(2),VFR(6),o[1],0,0,0), C0,10); VRD2(6); SBAR(); \
    GAPB2(o[0]=__builtin_amdgcn_mfma_f32_32x32x16_bf16(PAF(3),VFR(3),o[0],0,0,0), C0,12); VRD2(3); SBAR(); \
    GAPB2(o[1]=__builtin_amdgcn_mfma_f32_32x32x16_bf16(PAF(3),VFR(7),o[1],0,0,0), C0,14); VRD2(7); SBAR(); \
    GAPB2(o[2]=__builtin_amdgcn_mfma_f32_32x32x16_bf16(PAF(0),VFR(0),o[2],0,0,0), C1,0); \
    GAPB2(o[3]=__builtin_amdgcn_mfma_f32_32x32x16_bf16(PAF(0),VFR(4),o[3],0,0,0), C1,2); \
    GAPB2(o[2]=__builtin_amdgcn_mfma_f32_32x32x16_bf16(PAF(1),VFR(1),o[2],0,0,0), C1,4); \
    GAPB2(o[3]=__builtin_amdgcn_mfma_f32_32x32x16_bf16(PAF(1),VFR(5),o[3],0,0,0), C1,6); \
    GAPB2(o[2]=__builtin_amdgcn_mfma_f32_32x32x16_bf16(PAF(2),VFR(2),o[2],0,0,0), C1,8); \
    GAPB2(o[3]=__builtin_amdgcn_mfma_f32_32x32x16_bf16(PAF(2),VFR(6),o[3],0,0,0), C1,10); \
    GAPB2(o[2]=__builtin_amdgcn_mfma_f32_32x32x16_bf16(PAF(3),VFR(3),o[2],0,0,0), C1,12); \
    GAPB2(o[3]=__builtin_amdgcn_mfma_f32_32x32x16_bf16(PAF(3),VFR(7),o[3],0,0,0), C1,14); \
    }while(0)
  int t=1;
  #undef CMASK
  #define CMASK(P0,P1,t) do{}while(0)
  for(;t+5<NT;t+=2){
    STEP(pB0,pB1,pA0,pA1,t,true,true,true);     WAIT_BAR(3); RESC(); ROT();
    STEP(pA0,pA1,pB0,pB1,t+1,true,true,true);   WAIT_BAR(3); RESC(); ROT();
  }
  #undef CMASK
  #define CMASK(P0,P1,t) do{int jb_=(t)-(NT-4); if(jb_>=0)cmask(P0,P1,jb_,qrel,hi);}while(0)
  #define ENDW(tt) do{ if((tt)+3<NT){WAIT_BAR(3);} else if((tt)+2<NT){WAIT_BAR(2);} else {WAIT_BAR(0);} }while(0)
  for(;t+1<NT;t+=2){
    STEP(pB0,pB1,pA0,pA1,t,(t+3<NT),(t+1<NT),(t+1<NT));       ENDW(t);   RESC(); ROT();
    STEP(pA0,pA1,pB0,pB1,t+1,(t+4<NT),(t+2<NT),(t+2<NT));     ENDW(t+1); RESC(); ROT();
  }
  STEP(pB0,pB1,pA0,pA1,NT-1,false,false,false); RESC();
  { float sacc=pB0[0]+pB0[1]; _Pragma("unroll") for(int r=2;r<16;++r)sacc+=pB0[r]; _Pragma("unroll") for(int r=0;r<16;++r)sacc+=pB1[r]; l_reg+=sacc;
    pw0=(u32x4){PKW(pB0,0),PKW(pB0,2),PKW(pB0,4),PKW(pB0,6)};pw1=(u32x4){PKW(pB0,8),PKW(pB0,10),PKW(pB0,12),PKW(pB0,14)};pw2=(u32x4){PKW(pB1,0),PKW(pB1,2),PKW(pB1,4),PKW(pB1,6)};pw3=(u32x4){PKW(pB1,8),PKW(pB1,10),PKW(pB1,12),PKW(pB1,14)};
    SBAR(); pv(o,(int)(unsigned)(uintptr_t)vp0+2*sl_cur,PAF(0),PAF(1),PAF(2),PAF(3)); }
  #undef PKW
  #undef PAF
  #undef VFR
  #undef PIN
  #undef MX3
  #undef GAPA
  #undef GAPB2
  #undef VRD2
  #undef EX
  #undef VRD
  #undef KRD
  #undef STEP
  #undef ENDW
  {auto rr=__builtin_amdgcn_permlane32_swap(__float_as_uint(l_reg),__float_as_uint(l_reg),false,false);l_reg=__uint_as_float(rr[0])+__uint_as_float(rr[1]);}
  if(hi==0)wsf[32+r32]=l_reg;asm volatile("s_waitcnt lgkmcnt(0)":::"memory");
  float rli[16];
  #pragma unroll
  for(int r=0;r<16;++r)rli[r]=__builtin_amdgcn_rcpf(wsf[32+crow(r,hi)]);
  bf16*Ow=O+(rowbase+q0+wid*QBLK)*PO;
  { bf16*stg=(bf16*)(shm+LDS_OST)+wid*4096;
    #pragma unroll
    for(int r=0;r<16;++r){const int orow=crow(r,hi);
      #pragma unroll
      for(int d0=0;d0<4;++d0)stg[orow*128+d0*32+r32]=__float2bfloat16(o[d0][r]*rli[r]);}
    asm volatile("s_waitcnt lgkmcnt(0)":::"memory");
    if(MODE==0){
    #pragma unroll
    for(int i=0;i<8;++i){const int row=i*4+(lane>>4),ch=lane&15; const u32x4 v=*(const u32x4*)(stg+row*128+ch*8); ATTN_STORE16(Ow+(long)row*PO+ch*8,v);}
    } else {
    const int ch=lane&15; const bf16*O1w=O1+(rowbase+q0+wid*QBLK)*PO; u32x4 a1[8]; float gl[8];
    #pragma unroll
    for(int i=0;i<8;++i)a1[i]=*(const u32x4*)(O1w+(long)(i*4+(lane>>4))*PO+ch*8);
    #pragma unroll
    for(int k=0;k<8;++k)gl[k]=gsc[ch*8+k];
    #pragma unroll
    for(int i=0;i<8;++i){const int row=i*4+(lane>>4); const u32x4 v2=*(const u32x4*)(stg+row*128+ch*8);
      const unsigned w1[4]={a1[i].x,a1[i].y,a1[i].z,a1[i].w},w2[4]={v2.x,v2.y,v2.z,v2.w}; float ov[8]; float ss=0.f;
      #pragma unroll
      for(int k=0;k<4;++k){ ov[2*k]=__uint_as_float(w1[k]<<16)-lam*__uint_as_float(w2[k]<<16); ov[2*k+1]=__uint_as_float(w1[k]&0xffff0000u)-lam*__uint_as_float(w2[k]&0xffff0000u); ss+=ov[2*k]*ov[2*k]+ov[2*k+1]*ov[2*k+1]; }
      ss+=lane_xor<1>(ss);ss+=lane_xor<2>(ss);ss+=lane_xor<4>(ss);ss+=lane_xor<8>(ss);
      const float rs=1.0f/sqrtf(ss*(1.0f/128.0f)+1e-5f);
      u32x4 w; w.x=cvtpk_s(ov[0]*rs*gl[0],ov[1]*rs*gl[1]); w.y=cvtpk_s(ov[2]*rs*gl[2],ov[3]*rs*gl[3]); w.z=cvtpk_s(ov[4]*rs*gl[4],ov[5]*rs*gl[5]); w.w=cvtpk_s(ov[6]*rs*gl[6],ov[7]*rs*gl[7]);
      ATTN_STORE16(Ow+(long)row*PO+ch*8,w);}
    } }
  asm volatile("s_waitcnt lgkmcnt(0)\n\ts_barrier":::"memory");
  #undef QLD
  #undef DMA_K
  #undef DMA_V
  #undef CMASK
  #undef START
  #undef RESC
  #undef ROT
}
constexpr int ATTN_LDS_BYTES=LDS_BYTES;
template<int THRL=8> __device__ __forceinline__ void attn_phase(char*lds,const bf16*QKV,bf16*O1,bf16*OB,const float*lq1,const float*lk1,const float*lq2,const float*lk2,const float*gsub,float*gsc_ws,float lambda_init,unsigned*ctl){
  volatile __attribute__((address_space(3))) unsigned* qword=(volatile __attribute__((address_space(3))) unsigned*)(__attribute__((address_space(3))) char*)lds+(140*1024/4);
  const int x0=(int)(__builtin_amdgcn_s_getreg((3<<11)|20)&7u);
  float lam; { const int l_=threadIdx.x&63; float a=lq1[l_]*lk1[l_],c=lq2[l_]*lk2[l_];
    a=wave_sum64(a); c=wave_sum64(c);
    lam=__expf(a)-__expf(c)+lambda_init; lam=__uint_as_float(__builtin_amdgcn_readfirstlane(__float_as_uint(lam))); }
  float*gsc=gsc_ws+blockIdx.x*128;
  if(threadIdx.x<128)gsc[threadIdx.x]=gsub[threadIdx.x]*(1.0f-lambda_init);
  asm volatile("s_waitcnt vmcnt(0)":::"memory");
  for(int qi=0;qi<8;++qi){ const int b=(x0+qi)&7;
  for(;;){
    if(threadIdx.x==0){ const unsigned i=__hip_atomic_fetch_add(ctl+256+16*b,1u,__ATOMIC_RELAXED,__HIP_MEMORY_SCOPE_AGENT); *qword=i; }
    asm volatile("s_waitcnt lgkmcnt(0)\n\ts_barrier":::"memory");
    const int idx=__builtin_amdgcn_readfirstlane((int)*qword);
    asm volatile("s_waitcnt lgkmcnt(0)\n\ts_barrier":::"memory");
    if(idx>=8*NQB)break;
    const int h=7-(idx>>5),qb=NQB-1-(idx&31);
    const float sl=__uint_as_float(__builtin_amdgcn_readfirstlane(__float_as_uint(__builtin_ldexpf(1.4426950408889634f,-(h+1)))));
    int T0m[2];
    #pragma unroll
    for(int mp=0;mp<2;++mp){
      const unsigned*tq=ctl+1024+b*64+(mp*8+h)*2,*tk=tq+32;
      const float qn2=__uint_as_float(__hip_atomic_load(tq,__ATOMIC_RELAXED,__HIP_MEMORY_SCOPE_AGENT))+__uint_as_float(__hip_atomic_load(tq+1,__ATOMIC_RELAXED,__HIP_MEMORY_SCOPE_AGENT)),kn2=__uint_as_float(__hip_atomic_load(tk,__ATOMIC_RELAXED,__HIP_MEMORY_SCOPE_AGENT))+__uint_as_float(__hip_atomic_load(tk+1,__ATOMIC_RELAXED,__HIP_MEMORY_SCOPE_AGENT));
      const float thr=2.04f*sqrtf(qn2*kn2)+152.f, xs=(float)(qb*QB-63)-thr/sl;
      int T0=0; if(xs>=0.f){ T0=((int)(xs*(1.f/64.f))+1)&~1; if(T0>4*qb)T0=4*qb; }
      T0m[mp]=__builtin_amdgcn_readfirstlane(T0); }
    attn_unit<THRL,0>((long)b*SEQ,qb,QKV+h*64,QKV+1024+h*64,QKV+2048+h*128,O1+h*128,nullptr,0.f,nullptr,sl,T0m[0],lds);
    attn_unit<THRL,1>((long)b*SEQ,qb,QKV+512+h*64,QKV+1536+h*64,QKV+2048+h*128,OB+h*128,O1+h*128,lam,gsc,sl,T0m[1],lds);
  } }
}
#undef SBAR
#undef WAIT_BAR
}
constexpr int NWAVES = 8;
constexpr int BATCH = 8, SEQL = 8192, DMODEL = 1024, DFF = 2816, NQKV = 3072;
constexpr int MROWS = BATCH * SEQL;
constexpr float LN_EPS = 1e-5f, RMS_EPS = 1e-5f;
constexpr float DN_ALPHA = 1.41421356237309515f;
constexpr float LAMBDA_INIT = 0.35550906759096927f;
constexpr size_t MiB = 1u << 20;
constexpr size_t WS_WIN = 2 * MiB, WIN_BYTES = 11 * MiB;
constexpr size_t WS_WOUT = 46 * MiB, WOUT_BYTES = 11 * MiB / 2;
constexpr size_t WS_WQKV = 68 * MiB, WS_WO = 74 * MiB, WS_PW = 76 * MiB, WS_GSC = 77 * MiB;
constexpr size_t WS_Z = 80 * MiB;
constexpr size_t WS_XB = 336 * MiB;
constexpr size_t WS_H = 464 * MiB;
constexpr size_t WS_XL = 848 * MiB;
constexpr size_t WS_END = 912 * MiB;
constexpr int LDS_BYTES = 147456;
#define GAS __attribute__((address_space(1)))
#define LAS __attribute__((address_space(3)))
typedef unsigned short bf16;
typedef unsigned v4u __attribute__((ext_vector_type(4)));
typedef unsigned v2u __attribute__((ext_vector_type(2)));
typedef float f32x4 __attribute__((ext_vector_type(4)));
#define LDS_WAIT() asm volatile("s_waitcnt lgkmcnt(0)" ::: "memory")
__device__ __forceinline__ unsigned pk2(float lo, float hi) { return pg8::cvt_pk_bf16(lo, hi); }
__device__ __forceinline__ float wave_sum(float v) { return wave_sum64(v); }
__device__ __forceinline__ void p0_transpose_item(const float* W, int K, int N, bf16* WT, int mode, int row_off, LAS float* scr, int item, int lane) {
    const int nblk = N / 32, kb = item / nblk, nb = item % nblk, k0 = 64 * kb, n0 = 32 * nb;
    int r0 = row_off + n0;
    if (mode == 1) { const int j = n0 < DFF ? n0 : n0 - DFF; r0 = (j >> 7) * 256 + (j & 127) + (n0 < DFF ? 0 : 128); }
#pragma unroll 8
    for (int i = 0; i < 32; ++i) { const int kk = 2 * i + (lane >> 5); scr[kk * 33 + (lane & 31)] = W[(size_t)(k0 + kk) * N + n0 + (lane & 31)]; }
    LDS_WAIT(); asm volatile("" ::: "memory");
    const int c = lane & 7;
#pragma unroll
    for (int j = 0; j < 4; ++j) { const int n = (lane >> 3) + 8 * j; const LAS float* s = scr + (8 * c) * 33 + n;
        v4u o; o.x = pk2(s[0 * 33], s[1 * 33]); o.y = pk2(s[2 * 33], s[3 * 33]); o.z = pk2(s[4 * 33], s[5 * 33]); o.w = pk2(s[6 * 33], s[7 * 33]);
        *(GAS v4u*)(WT + (size_t)(r0 + n) * K + k0 + 8 * c) = o; }
    LDS_WAIT(); asm volatile("" ::: "memory");
}
struct Args { const float* in[30]; float* out; unsigned char* ws; };

__device__ __forceinline__ void prologue(const Args& a, LAS unsigned char* lds, int gw, int NGW, int wave, int lane) {
    LAS float* scr = (LAS float*)(lds + wave * 16384);
    unsigned char* ws = a.ws;
    constexpr int I_IN = (DMODEL / 64) * (2 * DFF / 32), I_OUT = (DFF / 64) * (DMODEL / 32), I_QKV = (DMODEL / 64) * (NQKV / 32), I_O = (DMODEL / 64) * (DMODEL / 32), I_P = (256 / 64) * (256 / 32);
    constexpr int NITEMS = 4 * I_IN + 4 * I_OUT + I_QKV + I_O + 4 * I_P;
    for (int it = gw; it < NITEMS; it += NGW) {
        int r = it;
        if (r < 4 * I_IN) { const int f = r / I_IN; const int idx = f == 0 ? 1 : f == 1 ? 9 : f == 2 ? 13 : 26;
            p0_transpose_item(a.in[idx], DMODEL, 2 * DFF, (bf16*)(ws + WS_WIN + f * WIN_BYTES), 1, 0, scr, r % I_IN, lane); continue; } r -= 4 * I_IN;
        if (r < 4 * I_OUT) { const int f = r / I_OUT; const int idx = f == 0 ? 2 : f == 1 ? 10 : f == 2 ? 14 : 27;
            p0_transpose_item(a.in[idx], DFF, DMODEL, (bf16*)(ws + WS_WOUT + f * WOUT_BYTES), 0, 0, scr, r % I_OUT, lane); continue; } r -= 4 * I_OUT;
        if (r < I_QKV) { p0_transpose_item(a.in[17], DMODEL, NQKV, (bf16*)(ws + WS_WQKV), 0, 0, scr, r, lane); continue; } r -= I_QKV;
        if (r < I_O) { p0_transpose_item(a.in[23], DMODEL, DMODEL, (bf16*)(ws + WS_WO), 0, 0, scr, r, lane); continue; } r -= I_O;
        { const int g = r / I_P; p0_transpose_item(a.in[5] + (size_t)g * 65536, 256, 256, (bf16*)(ws + WS_PW), 0, g * 256, scr, r % I_P, lane); }
    }
    const GAS f32x4* x4 = (const GAS f32x4*)a.in[0]; GAS v4u* xb = (GAS v4u*)(ws + WS_XB);
    const size_t n8 = (size_t)MROWS * DMODEL / 8, nthr = (size_t)NGW * 64;
#pragma unroll 4
    for (size_t i = (size_t)gw * 64 + lane; i < n8; i += nthr) { const f32x4 p = x4[2 * i], q = x4[2 * i + 1];
        v4u o; o.x = pk2(p.x, p.y); o.y = pk2(p.z, p.w); o.z = pk2(q.x, q.y); o.w = pk2(q.z, q.w); xb[i] = o; }
}
template <int R, bool IN_F32, bool OUT_F32> __device__ __forceinline__ void ln_pass(const float* xin, const bf16* Y, const float* g, const float* b, float* xout, bf16* XB, unsigned char* XL, int gw, int NGW, int lane) {
    f32x4 gv[4], bv[4];
#pragma unroll
    for (int j = 0; j < 4; ++j) { const int c4 = (j >> 1) * 128 + lane * 2 + (j & 1); gv[j] = ((const GAS f32x4*)g)[c4]; bv[j] = ((const GAS f32x4*)b)[c4]; }
    for (int m0 = gw * R; m0 < MROWS; m0 += NGW * R) {
        f32x4 v[R][4]; v4u yy[R][2]; float s[R], s2[R];
        if (IN_F32) {
#pragma unroll
            for (int r = 0; r < R; ++r) { const GAS f32x4* xr = (const GAS f32x4*)(xin + (size_t)(m0 + r) * DMODEL) + lane * 2; const GAS v4u* yr = (const GAS v4u*)(Y + (size_t)(m0 + r) * DMODEL) + lane;
                v[r][0] = xr[0]; v[r][1] = xr[1]; v[r][2] = xr[128]; v[r][3] = xr[129]; yy[r][0] = yr[0]; yy[r][1] = yr[64]; }
        } else {
            v4u hh[R][2]; v2u ll[R][2];
#pragma unroll
            for (int r = 0; r < R; ++r) { const GAS v4u* hr = (const GAS v4u*)(XB + (size_t)(m0 + r) * DMODEL) + lane; const GAS v2u* lr = (const GAS v2u*)(XL + (size_t)(m0 + r) * DMODEL) + lane; const GAS v4u* yr = (const GAS v4u*)(Y + (size_t)(m0 + r) * DMODEL) + lane;
                hh[r][0] = hr[0]; hh[r][1] = hr[64]; ll[r][0] = lr[0]; ll[r][1] = lr[64]; yy[r][0] = yr[0]; yy[r][1] = yr[64]; }
#pragma unroll
            for (int r = 0; r < R; ++r)
#pragma unroll
                for (int h = 0; h < 2; ++h) { const unsigned hw[4] = {hh[r][h].x, hh[r][h].y, hh[r][h].z, hh[r][h].w}; const int lw[2] = {(int)ll[r][h].x, (int)ll[r][h].y};
#pragma unroll
                    for (int q = 0; q < 2; ++q) { const float c = 1.0f / 512.0f;
                        v[r][2 * h + q] = (f32x4){__uint_as_float(hw[2 * q] << 16) + __builtin_amdgcn_cvt_f32_fp8(lw[q], 0) * c, __uint_as_float(hw[2 * q] & 0xffff0000u) + __builtin_amdgcn_cvt_f32_fp8(lw[q], 1) * c,
                                                  __uint_as_float(hw[2 * q + 1] << 16) + __builtin_amdgcn_cvt_f32_fp8(lw[q], 2) * c, __uint_as_float(hw[2 * q + 1] & 0xffff0000u) + __builtin_amdgcn_cvt_f32_fp8(lw[q], 3) * c}; } }
        }
#pragma unroll
        for (int r = 0; r < R; ++r) { const unsigned yw[8] = {yy[r][0].x, yy[r][0].y, yy[r][0].z, yy[r][0].w, yy[r][1].x, yy[r][1].y, yy[r][1].z, yy[r][1].w}; s[r] = 0.f;
#pragma unroll
            for (int j = 0; j < 4; ++j) { const f32x4 yv = (f32x4){__uint_as_float(yw[2 * j] << 16), __uint_as_float(yw[2 * j] & 0xffff0000u), __uint_as_float(yw[2 * j + 1] << 16), __uint_as_float(yw[2 * j + 1] & 0xffff0000u)};
                v[r][j] = v[r][j] * DN_ALPHA + yv; s[r] += (v[r][j].x + v[r][j].y) + (v[r][j].z + v[r][j].w); } }
#pragma unroll
        for (int r = 0; r < R; ++r) s[r] = wave_sum64(s[r]);
#pragma unroll
        for (int r = 0; r < R; ++r) { const float mean = s[r] * (1.f / DMODEL); s2[r] = 0.f;
#pragma unroll
            for (int j = 0; j < 4; ++j) { v[r][j] = v[r][j] - mean; s2[r] += (v[r][j].x * v[r][j].x + v[r][j].y * v[r][j].y) + (v[r][j].z * v[r][j].z + v[r][j].w * v[r][j].w); } }
#pragma unroll
        for (int r = 0; r < R; ++r) s2[r] = wave_sum64(s2[r]);
#pragma unroll
        for (int r = 0; r < R; ++r) { const float rstd = 1.f / sqrtf(s2[r] * (1.f / DMODEL) + LN_EPS);
#pragma unroll
            for (int j = 0; j < 4; ++j) v[r][j] = v[r][j] * rstd * gv[j] + bv[j];
            if (OUT_F32) { GAS f32x4* xo = (GAS f32x4*)(xout + (size_t)(m0 + r) * DMODEL) + lane * 2; xo[0] = v[r][0]; xo[1] = v[r][1]; xo[128] = v[r][2]; xo[129] = v[r][3]; }
            else { GAS v4u* o8 = (GAS v4u*)(XB + (size_t)(m0 + r) * DMODEL) + lane; GAS v2u* l8 = (GAS v2u*)(XL + (size_t)(m0 + r) * DMODEL) + lane;
#pragma unroll
                for (int h = 0; h < 2; ++h) { unsigned hw[4]; int lw[2];
#pragma unroll
                    for (int q = 0; q < 2; ++q) { const f32x4 x = v[r][2 * h + q]; hw[2 * q] = pk2(x.x, x.y); hw[2 * q + 1] = pk2(x.z, x.w);
                        const float l0 = (x.x - __uint_as_float(hw[2 * q] << 16)) * 512.f, l1 = (x.y - __uint_as_float(hw[2 * q] & 0xffff0000u)) * 512.f, l2 = (x.z - __uint_as_float(hw[2 * q + 1] << 16)) * 512.f, l3 = (x.w - __uint_as_float(hw[2 * q + 1] & 0xffff0000u)) * 512.f;
                        int p = __builtin_amdgcn_cvt_pk_fp8_f32(l0, l1, 0, false); lw[q] = __builtin_amdgcn_cvt_pk_fp8_f32(l2, l3, p, true); }
                    o8[64 * h] = (v4u){hw[0], hw[1], hw[2], hw[3]}; l8[64 * h] = (v2u){(unsigned)lw[0], (unsigned)lw[1]}; } }
        }
    }
}
__device__ __forceinline__ void ln_pool_pass(const bf16* Zp, const float* pscale, const float* g, const float* b, bf16* XB, unsigned char* XL, int gw, int NGW, int lane) {
    f32x4 gv[4], bv[4], pv[4];
#pragma unroll
    for (int j = 0; j < 4; ++j) { const int c4 = (j >> 1) * 128 + lane * 2 + (j & 1); gv[j] = ((const GAS f32x4*)g)[c4]; bv[j] = ((const GAS f32x4*)b)[c4]; pv[j] = ((const GAS f32x4*)pscale)[c4]; }
    const int wA = lane < 32 ? 2 : 4, wB = lane < 32 ? 8 : 16;
#define BF4LO(q) ((f32x4){__uint_as_float((q).x << 16), __uint_as_float((q).x & 0xffff0000u), __uint_as_float((q).y << 16), __uint_as_float((q).y & 0xffff0000u)})
#define BF4HI(q) ((f32x4){__uint_as_float((q).z << 16), __uint_as_float((q).z & 0xffff0000u), __uint_as_float((q).w << 16), __uint_as_float((q).w & 0xffff0000u)})
    for (int c = gw; c < MROWS / 32; c += NGW) {
        const int r0 = c * 32, t0 = r0 & (SEQL - 1);
        const GAS v4u* zp = (const GAS v4u*)(Zp + (size_t)r0 * DMODEL) + lane;
        f32x4 s[4] = {(f32x4){0.f, 0.f, 0.f, 0.f}, (f32x4){0.f, 0.f, 0.f, 0.f}, (f32x4){0.f, 0.f, 0.f, 0.f}, (f32x4){0.f, 0.f, 0.f, 0.f}};
        if (t0 > 0) for (int i = 1; i <= 16; ++i) { const v4u qa = zp[-(long)(i <= wA ? i : 1) * 128], qb = zp[-(long)(i <= wB ? i : 1) * 128 + 64]; const float ma = i <= wA ? 1.f : 0.f, mb = i <= wB ? 1.f : 0.f;
            s[0] += BF4LO(qa) * ma; s[1] += BF4HI(qa) * ma; s[2] += BF4LO(qb) * mb; s[3] += BF4HI(qb) * mb; }
        for (int j0 = 0; j0 < 32; j0 += 2) {
            v4u hh[2][2], zc[2][2], zo[2][2]; v2u ll[2][2]; f32x4 v[2][4]; float sm[2], s2[2];
#pragma unroll
            for (int r = 0; r < 2; ++r) { const int j = j0 + r, t = t0 + j; const size_t m = (size_t)(r0 + j);
                const GAS v4u* hr = (const GAS v4u*)(XB + m * DMODEL) + lane; const GAS v2u* lr = (const GAS v2u*)(XL + m * DMODEL) + lane;
                hh[r][0] = hr[0]; hh[r][1] = hr[64]; ll[r][0] = lr[0]; ll[r][1] = lr[64];
                zc[r][0] = zp[(long)j * 128]; zc[r][1] = zp[(long)j * 128 + 64];
                zo[r][0] = zp[(long)(t >= wA ? j - wA : j) * 128]; zo[r][1] = zp[(long)(t >= wB ? j - wB : j) * 128 + 64]; }
#pragma unroll
            for (int r = 0; r < 2; ++r) { const int t = t0 + j0 + r; const float ma = t >= wA ? 1.f : 0.f, mb = t >= wB ? 1.f : 0.f;
                const float rca = 1.0f / (float)(t + 1 < wA ? t + 1 : wA), rcb = 1.0f / (float)(t + 1 < wB ? t + 1 : wB);
                const f32x4 z0 = BF4LO(zc[r][0]), z1 = BF4HI(zc[r][0]), z2 = BF4LO(zc[r][1]), z3 = BF4HI(zc[r][1]);
                s[0] += z0 - BF4LO(zo[r][0]) * ma; s[1] += z1 - BF4HI(zo[r][0]) * ma; s[2] += z2 - BF4LO(zo[r][1]) * mb; s[3] += z3 - BF4HI(zo[r][1]) * mb;
                const f32x4 y[4] = {(s[0] * rca - z0) * pv[0], (s[1] * rca - z1) * pv[1], (s[2] * rcb - z2) * pv[2], (s[3] * rcb - z3) * pv[3]};
                sm[r] = 0.f;
#pragma unroll
                for (int h = 0; h < 2; ++h) { const unsigned hw[4] = {hh[r][h].x, hh[r][h].y, hh[r][h].z, hh[r][h].w}; const int lw[2] = {(int)ll[r][h].x, (int)ll[r][h].y};
#pragma unroll
                    for (int q = 0; q < 2; ++q) { const float cc = 1.0f / 512.0f;
                        const f32x4 x = (f32x4){__uint_as_float(hw[2 * q] << 16) + __builtin_amdgcn_cvt_f32_fp8(lw[q], 0) * cc, __uint_as_float(hw[2 * q] & 0xffff0000u) + __builtin_amdgcn_cvt_f32_fp8(lw[q], 1) * cc,
                                                 __uint_as_float(hw[2 * q + 1] << 16) + __builtin_amdgcn_cvt_f32_fp8(lw[q], 2) * cc, __uint_as_float(hw[2 * q + 1] & 0xffff0000u) + __builtin_amdgcn_cvt_f32_fp8(lw[q], 3) * cc};
                        v[r][2 * h + q] = x * DN_ALPHA + y[2 * h + q]; sm[r] += (v[r][2 * h + q].x + v[r][2 * h + q].y) + (v[r][2 * h + q].z + v[r][2 * h + q].w); } } }
#pragma unroll
            for (int r = 0; r < 2; ++r) sm[r] = wave_sum64(sm[r]);
#pragma unroll
            for (int r = 0; r < 2; ++r) { const float mean = sm[r] * (1.f / DMODEL); s2[r] = 0.f;
#pragma unroll
                for (int j = 0; j < 4; ++j) { v[r][j] = v[r][j] - mean; s2[r] += (v[r][j].x * v[r][j].x + v[r][j].y * v[r][j].y) + (v[r][j].z * v[r][j].z + v[r][j].w * v[r][j].w); } }
#pragma unroll
            for (int r = 0; r < 2; ++r) s2[r] = wave_sum64(s2[r]);
#pragma unroll
            for (int r = 0; r < 2; ++r) { const float rstd = 1.f / sqrtf(s2[r] * (1.f / DMODEL) + LN_EPS); const size_t m = (size_t)(r0 + j0 + r);
#pragma unroll
                for (int j = 0; j < 4; ++j) v[r][j] = v[r][j] * rstd * gv[j] + bv[j];
                GAS v4u* o8 = (GAS v4u*)(XB + m * DMODEL) + lane; GAS v2u* l8 = (GAS v2u*)(XL + m * DMODEL) + lane;
#pragma unroll
                for (int h = 0; h < 2; ++h) { unsigned hw[4]; int lw[2];
#pragma unroll
                    for (int q = 0; q < 2; ++q) { const f32x4 x = v[r][2 * h + q]; hw[2 * q] = pk2(x.x, x.y); hw[2 * q + 1] = pk2(x.z, x.w);
                        const float l0 = (x.x - __uint_as_float(hw[2 * q] << 16)) * 512.f, l1 = (x.y - __uint_as_float(hw[2 * q] & 0xffff0000u)) * 512.f, l2 = (x.z - __uint_as_float(hw[2 * q + 1] << 16)) * 512.f, l3 = (x.w - __uint_as_float(hw[2 * q + 1] & 0xffff0000u)) * 512.f;
                        int p = __builtin_amdgcn_cvt_pk_fp8_f32(l0, l1, 0, false); lw[q] = __builtin_amdgcn_cvt_pk_fp8_f32(l2, l3, p, true); }
                    o8[64 * h] = (v4u){hw[0], hw[1], hw[2], hw[3]}; l8[64 * h] = (v2u){(unsigned)lw[0], (unsigned)lw[1]}; } }
        }
    }
#undef BF4LO
#undef BF4HI
}
__device__ __forceinline__ void pool_diff_pass(const bf16* XB, const unsigned char* XL, bf16* DB, int gw, int NGW, int lane) {
#define XLOAD(roff) ({ const v2u h_ = hc[(long)(roff) * 256]; const int l_ = (int)lc[(long)(roff) * 256]; const float c_ = 1.0f / 512.0f; \
        (f32x4){__uint_as_float(h_.x << 16) + __builtin_amdgcn_cvt_f32_fp8(l_, 0) * c_, __uint_as_float(h_.x & 0xffff0000u) + __builtin_amdgcn_cvt_f32_fp8(l_, 1) * c_, \
                __uint_as_float(h_.y << 16) + __builtin_amdgcn_cvt_f32_fp8(l_, 2) * c_, __uint_as_float(h_.y & 0xffff0000u) + __builtin_amdgcn_cvt_f32_fp8(l_, 3) * c_}; })
    for (int it = gw; it < (MROWS / 32) * 4; it += NGW) {
        const int g = it & 3, r0 = (it >> 2) * 32, t0 = r0 & (SEQL - 1), w = 2 << g;
        const GAS v2u* hc = (const GAS v2u*)(XB + (size_t)r0 * DMODEL + g * 256) + lane;
        const GAS unsigned* lc = (const GAS unsigned*)(XL + (size_t)r0 * DMODEL + g * 256) + lane;
        GAS v2u* dc = (GAS v2u*)(DB + (size_t)r0 * DMODEL + g * 256) + lane;
        f32x4 s = (f32x4){0.f, 0.f, 0.f, 0.f};
        if (t0 > 0) for (int i = 1; i <= w; ++i) s += XLOAD(-i);
        const float rw = 1.0f / (float)w;
        for (int j0 = 0; j0 < 32; j0 += 8) { f32x4 xv[8], xo[8];
#pragma unroll
            for (int k = 0; k < 8; ++k) { const int j = j0 + k, t = t0 + j; xv[k] = XLOAD(j); xo[k] = XLOAD(t >= w ? j - w : j); }
#pragma unroll
            for (int k = 0; k < 8; ++k) { const int j = j0 + k, t = t0 + j; s += xv[k]; if (t >= w) s -= xo[k];
                const float rc = t + 1 < w ? 1.0f / (float)(t + 1) : rw;
                const f32x4 d = s * rc - xv[k]; v2u o; o.x = pk2(d.x, d.y); o.y = pk2(d.z, d.w); dc[(long)j * 256] = o; } }
    }
#undef XLOAD
}
__device__ __forceinline__ void attn_combine_pass(const bf16* OP, const float* lq1, const float* lk1, const float* lq2, const float* lk2, const float* sg, bf16* OB, int gw, int NGW, int lane) {
    const float lam = __expf(wave_sum(lq1[lane] * lk1[lane])) - __expf(wave_sum(lq2[lane] * lk2[lane])) + LAMBDA_INIT;
    float gl[16];
#pragma unroll
    for (int i = 0; i < 16; ++i) gl[i] = sg[(lane & 7) * 16 + i] * (1.0f - LAMBDA_INIT);
    for (int m0 = gw * 4; m0 < MROWS; m0 += NGW * 4) {
        v4u A0[4], A1[4], B0[4], B1[4];
#pragma unroll
        for (int r = 0; r < 4; ++r) { const GAS v4u* p1 = (const GAS v4u*)(OP + (size_t)(m0 + r) * 2048) + lane * 2; const GAS v4u* p2 = p1 + 128; A0[r] = p1[0]; A1[r] = p1[1]; B0[r] = p2[0]; B1[r] = p2[1]; }
#pragma unroll
        for (int r = 0; r < 4; ++r) { const int m = m0 + r; const v4u a0 = A0[r], a1 = A1[r], b0 = B0[r], b1 = B1[r];
        unsigned aw[8] = {a0.x, a0.y, a0.z, a0.w, a1.x, a1.y, a1.z, a1.w}, bw[8] = {b0.x, b0.y, b0.z, b0.w, b1.x, b1.y, b1.z, b1.w};
        float o[16]; float ss = 0.f;
#pragma unroll
        for (int i = 0; i < 8; ++i) { const float x0 = __uint_as_float(aw[i] << 16), x1 = __uint_as_float(aw[i] & 0xffff0000u), y0 = __uint_as_float(bw[i] << 16), y1 = __uint_as_float(bw[i] & 0xffff0000u);
            o[2 * i] = x0 - lam * y0; o[2 * i + 1] = x1 - lam * y1; ss += o[2 * i] * o[2 * i] + o[2 * i + 1] * o[2 * i + 1]; }
        ss += lane_xor<1>(ss); ss += lane_xor<2>(ss); ss += lane_xor<4>(ss);
        const float rs = 1.0f / sqrtf(ss * (1.0f / 128.0f) + RMS_EPS);
        v4u w0, w1;
        w0.x = pk2(o[0] * rs * gl[0], o[1] * rs * gl[1]); w0.y = pk2(o[2] * rs * gl[2], o[3] * rs * gl[3]); w0.z = pk2(o[4] * rs * gl[4], o[5] * rs * gl[5]); w0.w = pk2(o[6] * rs * gl[6], o[7] * rs * gl[7]);
        w1.x = pk2(o[8] * rs * gl[8], o[9] * rs * gl[9]); w1.y = pk2(o[10] * rs * gl[10], o[11] * rs * gl[11]); w1.z = pk2(o[12] * rs * gl[12], o[13] * rs * gl[13]); w1.w = pk2(o[14] * rs * gl[14], o[15] * rs * gl[15]);
        GAS v4u* q = (GAS v4u*)(OB + (size_t)m * DMODEL) + lane * 2; q[0] = w0; q[1] = w1; }
    }
}

#define XB_TMO      128
#define XB_XCNT(j)  (256  + 64 * (j))
#define XB_XSUB(j)  (1280 + 64 * (j))
#define XB_XGEN(j)  (2304 + 64 * (j))
#define XB_TOP      3328
#define XB_TOPGEN   3392
#define XCD_BAR_WORDS 3456
#define XB_SPIN_CAP (1u << 18)

__device__ __forceinline__ unsigned xb_ld(unsigned* p)              { return __hip_atomic_load(p, __ATOMIC_RELAXED, __HIP_MEMORY_SCOPE_AGENT); }
__device__ __forceinline__ unsigned xb_add(unsigned* p, unsigned v) { return __hip_atomic_fetch_add(p, v, __ATOMIC_RELAXED, __HIP_MEMORY_SCOPE_AGENT); }
__device__ __forceinline__ unsigned xb_xcc_id() { return (unsigned)__builtin_amdgcn_s_getreg((3 << 11) | 20) & 0xFu; }
#define XB_SPIN(cond, bar) do { unsigned _sp = 0; while (cond) { __builtin_amdgcn_s_sleep(1); \
    if ((++_sp & 255u) == 0u) { if (xb_ld(&(bar)[XB_TMO])) break; if (_sp > XB_SPIN_CAP) { atomicAdd(&(bar)[XB_TMO], 1u); break; } } } } while (0)

struct XcdBarrier {
    unsigned* bar; unsigned x;
    volatile LAS unsigned* st;
};

__device__ __forceinline__ XcdBarrier xcd_barrier_post(unsigned* bar, volatile LAS unsigned* st) {
    XcdBarrier b; b.bar = bar; b.x = xb_xcc_id(); b.st = st;
    if (threadIdx.x == 0) (void)xb_add(&bar[XB_XCNT(b.x)], 1u);
    return b;
}
__device__ __forceinline__ void xcd_barrier_complete(unsigned* bar, unsigned x, unsigned& nloc, unsigned& nx) {
    const unsigned G = gridDim.x * gridDim.y * gridDim.z;
    unsigned sum, cnt, mine, sp = 0u;
    for (;;) {
        sum = 0u; cnt = 0u; mine = 0u;
#pragma unroll
        for (unsigned j = 0; j < 16; ++j) { const unsigned c = xb_ld(&bar[XB_XCNT(j)]); sum += c; cnt += (c > 0u) ? 1u : 0u; mine = (j == x) ? c : mine; }
        if (sum == G) break;
        __builtin_amdgcn_s_sleep(1);
        if ((++sp & 255u) == 0u) { if (xb_ld(&bar[XB_TMO])) break; if (sp > XB_SPIN_CAP) { atomicAdd(&bar[XB_TMO], 1u); break; } }
    }
    nloc = mine > 0u ? mine : 1u; nx = cnt > 0u ? cnt : 1u;
}

__device__ __forceinline__ void xcd_barrier(const XcdBarrier& b) {
    asm volatile("s_waitcnt vmcnt(0)" ::: "memory");
    __syncthreads();
    if (threadIdx.x == 0) {
        unsigned* bar = b.bar;
        __builtin_amdgcn_s_waitcnt(0);
        unsigned nloc = b.st[0], nx = b.st[1];
        if (nloc == 0u) { xcd_barrier_complete(bar, b.x, nloc, nx); b.st[0] = nloc; b.st[1] = nx; }
        const unsigned old = xb_add(&bar[XB_XSUB(b.x)], 1u);
        const unsigned gen = old / nloc;
        if (old + 1u == (gen + 1u) * nloc) {
            __builtin_amdgcn_fence(__ATOMIC_RELEASE, "agent");
            asm volatile("s_waitcnt vmcnt(0)" ::: "memory");
            const unsigned og = xb_add(&bar[XB_TOP], 1u);
            const unsigned tg = og / nx;
            if (og + 1u == (tg + 1u) * nx) xb_add(&bar[XB_TOPGEN], 1u);
            else XB_SPIN(xb_ld(&bar[XB_TOPGEN]) == tg, bar);
            __builtin_amdgcn_fence(__ATOMIC_ACQUIRE, "agent");
            xb_add(&bar[XB_XGEN(b.x)], 1u);
            asm volatile("s_waitcnt vmcnt(0)" ::: "memory");
        } else {
            XB_SPIN(xb_ld(&bar[XB_XGEN(b.x)]) == gen, bar);
            __builtin_amdgcn_fence(__ATOMIC_ACQUIRE, "agent");
            asm volatile("s_waitcnt vmcnt(0)" ::: "memory");
        }
    }
    __syncthreads();
}

__device__ __forceinline__ void norm_pass(const bf16* QKV, unsigned* tab, int gw, int NGW, int lane) {
    for (int c = gw; c < MROWS / 32; c += NGW) {
        const int r0 = c * 32, b = r0 / SEQL; float mx[4] = {0.f, 0.f, 0.f, 0.f};
#pragma unroll 4
        for (int i = 0; i < 32; ++i) { const GAS v4u* p = (const GAS v4u*)(QKV + (size_t)(r0 + i) * NQKV) + lane;
#pragma unroll
            for (int j = 0; j < 4; ++j) { const v4u w = p[64 * j]; float ss = 0.f; const unsigned ww[4] = {w.x, w.y, w.z, w.w};
#pragma unroll
                for (int k = 0; k < 4; ++k) { const float lo = __uint_as_float(ww[k] << 16), hi = __uint_as_float(ww[k] & 0xffff0000u); ss += lo * lo + hi * hi; }
                ss += lane_xor<1>(ss); ss += lane_xor<2>(ss); ss += lane_xor<4>(ss); mx[j] = fmaxf(mx[j], ss); } }
        if ((lane & 7) == 0) {
#pragma unroll
            for (int j = 0; j < 4; ++j) atomicMax(tab + b * 32 + j * 8 + (lane >> 3), __float_as_uint(mx[j])); }
    }
}

__global__ void __launch_bounds__(NWAVES * 64, 2) mk_fwd(Args args) {
    extern __shared__ __attribute__((aligned(16))) unsigned char lds[];
    cg::grid_group grid = cg::this_grid();
    LAS unsigned char* L = (LAS unsigned char*)lds;
    const int wave = __builtin_amdgcn_readfirstlane((int)threadIdx.x >> 6);
#define lane ({ int t_ = threadIdx.x; asm volatile("" : "+v"(t_)); t_ & 63; })
    const int G = gridDim.x, bx = blockIdx.x, vcu = (G % 8 == 0) ? (bx % 8) * (G / 8) + bx / 8 : bx;
    const int gw = vcu * NWAVES + wave, NGW = G * NWAVES;
    unsigned char* ws = args.ws;
    unsigned char* XL = ws + WS_XL; bf16* Y = (bf16*)(ws + WS_Z); bf16* XB = (bf16*)(ws + WS_XB); bf16* H = (bf16*)(ws + WS_H);
#define GEMM_SWIGLU(f) do { pg8::Gemm g_{XB, (const bf16*)(ws + WS_WIN + (f) * WIN_BYTES), MROWS, 2 * DFF, DMODEL, DMODEL, DMODEL, 0}; pg8::StaticOrder S_; S_.init(MROWS, 2 * DFF, G, bx); \
        pg8::EpiSwiglu E_{H, DFF}; pg8::gemm_phase<pg8::EpiSwiglu, pg8::StaticOrder, PG8_ALIGN, PG8_SP2>(L, g_, S_, E_); } while (0)
#define GEMM_DOWN(f) do { pg8::Gemm g_{H, (const bf16*)(ws + WS_WOUT + (f) * WOUT_BYTES), MROWS, DMODEL, DFF, DFF, DFF, 0}; pg8::StaticOrder S_; S_.init(MROWS, DMODEL, G, bx, 1); \
        pg8::EpiScaleBf16 E_{Y, nullptr, 0.5f}; pg8::gemm_phase<pg8::EpiScaleBf16, pg8::StaticOrder, PG8_ALIGN, PG8_SP2>(L, g_, S_, E_); } while (0)
#define FFN(f, ig, ib, INF, OUTF) do { GEMM_SWIGLU(f); SYNC(); GEMM_DOWN(f); SYNC(); ln_pass<4, INF, OUTF>(args.in[0], Y, args.in[ig], args.in[ib], args.out, XB, XL, gw, NGW, lane); SYNC(); } while (0)

    unsigned* ctl = (unsigned*)ws;
    volatile LAS unsigned* bst = (volatile LAS unsigned*)(L + 141 * 1024);
    if (threadIdx.x < 2) bst[threadIdx.x] = 0u;
    if (bx == 0) for (int i = threadIdx.x; i < 8192; i += NWAVES * 64) ctl[i] = 0u;
    prologue(args, L, gw, NGW, wave, lane);
    __syncthreads(); grid.sync();
    const XcdBarrier xbar = xcd_barrier_post(ctl + 4096, bst);
#define SYNC() xcd_barrier(xbar)
    FFN(0, 3, 4, true, false);
    { pg8::Gemm g_{XB, (const bf16*)(ws + WS_PW), MROWS, DMODEL, 256, DMODEL, 256, 512}; pg8::StaticOrder S_; S_.init(MROWS, DMODEL, G, bx);
      pg8::EpiScaleBf16 E_{Y, nullptr, 1.0f}; pg8::gemm_phase<pg8::EpiScaleBf16, pg8::StaticOrder, PG8_ALIGN, PG8_SP2>(L, g_, S_, E_); }
    SYNC(); ln_pool_pass(Y, args.in[6], args.in[7], args.in[8], XB, XL, gw, NGW, lane); SYNC();
    FFN(1, 11, 12, false, false);
    FFN(2, 15, 16, false, false);
    { pg8::Gemm g_{XB, (const bf16*)(ws + WS_WQKV), MROWS, NQKV, DMODEL, DMODEL, DMODEL, 0}; pg8::StaticOrder S_; S_.init(MROWS, NQKV, G, bx);
      pg8::EpiQKV E_{H, attn_body::C2, ctl + 1024}; pg8::gemm_phase<pg8::EpiQKV, pg8::StaticOrder, PG8_ALIGN, PG8_SP2>(L, g_, S_, E_); }
    SYNC();
    attn_body::attn_phase<16>((char*)lds, (const attn_body::bf16*)H, (attn_body::bf16*)Y, (attn_body::bf16*)(ws + WS_Z + 128 * MiB), args.in[18], args.in[19], args.in[20], args.in[21], args.in[22], (float*)(ws + WS_GSC), LAMBDA_INIT, ctl);
    SYNC();
    { pg8::Gemm g_{(const bf16*)(ws + WS_Z + 128 * MiB), (const bf16*)(ws + WS_WO), MROWS, DMODEL, DMODEL, DMODEL, DMODEL, 0}; pg8::StaticOrder S_; S_.init(MROWS, DMODEL, G, bx);
      pg8::EpiScaleBf16 E_{Y, nullptr, 1.0f}; pg8::gemm_phase<pg8::EpiScaleBf16, pg8::StaticOrder, PG8_ALIGN, PG8_SP2>(L, g_, S_, E_); }
    SYNC(); ln_pass<4, false, false>(nullptr, Y, args.in[24], args.in[25], nullptr, XB, XL, gw, NGW, lane); SYNC();
    FFN(3, 28, 29, false, true);
#undef lane
}

extern "C" void kernel_launch(void* const* d_in, const int* in_sizes, int n_in, void* d_out, int out_size, void* d_ws, size_t ws_size, hipStream_t stream) {
    static int grid = 0;
    if (grid == 0) {
        if (n_in != 30 || in_sizes[0] != MROWS * DMODEL || out_size != MROWS * DMODEL || ws_size < WS_END) { fprintf(stderr, "kernel_launch: unexpected shapes: n_in %d in0 %d out %d ws %zu\n", n_in, n_in > 0 ? in_sizes[0] : -1, out_size, ws_size); grid = -1; return; }
        int dev = 0, cus = 0, per_cu = 0;
        hipGetDevice(&dev); hipDeviceGetAttribute(&cus, hipDeviceAttributeMultiprocessorCount, dev);
        if (hipFuncSetAttribute((const void*)mk_fwd, hipFuncAttributeMaxDynamicSharedMemorySize, LDS_BYTES) != hipSuccess) { fprintf(stderr, "kernel_launch: hipFuncSetAttribute failed\n"); grid = -1; return; }
        if (hipOccupancyMaxActiveBlocksPerMultiprocessor(&per_cu, (const void*)mk_fwd, NWAVES * 64, LDS_BYTES) != hipSuccess || per_cu < 1) { fprintf(stderr, "kernel_launch: occupancy query says %d blocks per CU\n", per_cu); per_cu = 1; }
        (void)hipGetLastError();
        grid = cus * per_cu;
    }
    if (grid < 0) return;
    Args a{};
    for (int i = 0; i < 30; ++i) a.in[i] = (const float*)d_in[i];
    a.out = (float*)d_out; a.ws = (unsigned char*)d_ws;
    void* kargs[] = {&a};
    hipError_t e = hipLaunchCooperativeKernel((const void*)mk_fwd, dim3(grid), dim3(NWAVES * 64), kargs, LDS_BYTES, stream);
    if (e != hipSuccess) fprintf(stderr, "cooperative launch failed: %s (grid %d)\n", hipGetErrorString(e), grid);
}
```
